# Optimizing an MI355X kernel written in HIP

```python
import math
import jax
import jax.numpy as jnp
from jax import lax
import numpy as np

D_MODEL = 1024
BATCH = 4
SEQ = 8192
DEPTH = 1

SSM_WIDTH = D_MODEL // 2
SSM_GROUP = 16
SSM_GROUPS = SSM_WIDTH // SSM_GROUP
SSM_STATE = 64
DT_MIN = 1e-3
DT_MAX = 1e-1
ATTN_HEADS = 8
HEAD_DIM = 64
ATTN_WIDTH = ATTN_HEADS * HEAD_DIM
MOBA_BLOCK = 256
MOBA_TOPK = 3
Q_CHUNK = 64
ROPE_THETA = 500000.0
ROT_DIM = HEAD_DIM // 4
IN_WIDTH = SSM_WIDTH + 3 * ATTN_WIDTH + 2 * D_MODEL
N_EXPERTS = 32
TOP_K = 4
D_FF = D_MODEL
SWIGLU_LIMIT = 7.0
SWIGLU_ALPHA = 1.702
EXPERT_ROWS = 256
RMS_EPS = 1e-5

kernel_name = 'hybrid_s5_moba_moe_block'


def rms_norm(x, g):
    xf = x.astype(jnp.float32)
    r = lax.rsqrt(jnp.mean(xf * xf, axis=-1, keepdims=True) + RMS_EPS)
    return (xf * r * g.astype(jnp.float32)).astype(x.dtype)


def modulate(h, shift, scale):
    return h * (1.0 + scale[:, None, :]) + shift[:, None, :]


def rotary_tables(seq):
    inv_freq = 1.0 / (ROPE_THETA ** (jnp.arange(0, ROT_DIM, 2, dtype=jnp.float32) / ROT_DIM))
    ang = jnp.arange(seq, dtype=jnp.float32)[:, None] * inv_freq[None, :]
    return jnp.cos(ang), jnp.sin(ang)


def partial_rotary(t, cos, sin):
    half = ROT_DIM // 2
    t1 = t[..., :half].astype(jnp.float32)
    t2 = t[..., half:ROT_DIM].astype(jnp.float32)
    r1 = (t1 * cos - t2 * sin).astype(t.dtype)
    r2 = (t2 * cos + t1 * sin).astype(t.dtype)
    return jnp.concatenate([r1, r2, t[..., ROT_DIM:]], axis=-1)


def to_heads(t):
    b, s, _ = t.shape
    return t.reshape(b, s, ATTN_HEADS, HEAD_DIM).transpose(0, 2, 1, 3)


def s5_mixer(u, a_re, a_im, log_dt, b_re, b_im, c_re, c_im, d_skip):
    bsz, s, _ = u.shape
    f32 = jnp.float32
    uf = u.astype(f32).reshape(bsz, s, SSM_GROUPS, SSM_GROUP)
    dt = jnp.exp(log_dt.astype(f32))[:, None]
    lr = a_re.astype(f32)
    li = a_im.astype(f32)
    mag = jnp.exp(lr * dt)
    abar_r = mag * jnp.cos(li * dt)
    abar_i = mag * jnp.sin(li * dt)
    den = lr * lr + li * li
    coef_r = ((abar_r - 1.0) * lr + abar_i * li) / den
    coef_i = (abar_i * lr - (abar_r - 1.0) * li) / den
    br = b_re.astype(f32)
    bi = b_im.astype(f32)
    bbar_r = coef_r[..., None] * br - coef_i[..., None] * bi
    bbar_i = coef_r[..., None] * bi + coef_i[..., None] * br
    bu_r = jnp.einsum('bsgc,gpc->bsgp', uf, bbar_r)
    bu_i = jnp.einsum('bsgc,gpc->bsgp', uf, bbar_i)
    a_r = jnp.broadcast_to(abar_r[None, None], (1, s, SSM_GROUPS, SSM_STATE))
    a_i = jnp.broadcast_to(abar_i[None, None], (1, s, SSM_GROUPS, SSM_STATE))

    def combine(e1, e2):
        a1r, a1i, b1r, b1i = e1
        a2r, a2i, b2r, b2i = e2
        return (a2r * a1r - a2i * a1i,
                a2r * a1i + a2i * a1r,
                a2r * b1r - a2i * b1i + b2r,
                a2r * b1i + a2i * b1r + b2i)

    _, _, xr, xi = lax.associative_scan(combine, (a_r, a_i, bu_r, bu_i), axis=1)
    y = (jnp.einsum('gcp,bsgp->bsgc', c_re.astype(f32), xr)
         - jnp.einsum('gcp,bsgp->bsgc', c_im.astype(f32), xi))
    y = y.reshape(bsz, s, SSM_WIDTH) + d_skip.astype(f32) * uf.reshape(bsz, s, SSM_WIDTH)
    return y.astype(u.dtype)


def moba_attention(q, k, v):
    bsz, nh, s, dh = q.shape
    f32 = jnp.float32
    nb = -(-s // MOBA_BLOCK)
    pad = nb * MOBA_BLOCK - s
    kb = jnp.pad(k, ((0, 0), (0, 0), (0, pad), (0, 0))).reshape(bsz, nh, nb, MOBA_BLOCK, dh)
    vb = jnp.pad(v, ((0, 0), (0, 0), (0, pad), (0, 0))).reshape(bsz, nh, nb, MOBA_BLOCK, dh)
    k_mean = jnp.mean(kb.astype(f32), axis=3)
    pos = jnp.arange(s)
    n_past = pos // MOBA_BLOCK
    gate = jnp.einsum('bhsd,bhnd->bhsn', q.astype(f32), k_mean)
    past = jnp.arange(nb)[None, :] < n_past[:, None]
    gate = jnp.where(past, gate, -jnp.inf)
    n_sel = min(MOBA_TOPK, nb)
    _, sel = lax.top_k(gate, n_sel)
    sel_ok = sel < n_past[:, None]
    n_chunks = s // Q_CHUNK

    def to_chunks(t):
        return jnp.moveaxis(t.reshape(bsz, nh, n_chunks, Q_CHUNK, t.shape[-1]), 2, 0)

    b_ix = jnp.arange(bsz)[:, None, None, None]
    h_ix = jnp.arange(nh)[None, :, None, None]
    scale = dh ** -0.5
    n_sel_keys = n_sel * MOBA_BLOCK

    def chunk(args):
        ci, qc, selc, okc = args
        q0 = ci * Q_CHUNK
        own = q0 // MOBA_BLOCK
        k_own = lax.dynamic_index_in_dim(kb, own, axis=2, keepdims=False)
        v_own = lax.dynamic_index_in_dim(vb, own, axis=2, keepdims=False)
        k_sel = kb[b_ix, h_ix, selc]
        v_sel = vb[b_ix, h_ix, selc]
        s_sel = jnp.einsum('bhqd,bhqnkd->bhqnk', qc, k_sel).astype(f32) * scale
        s_sel = jnp.where(okc[..., None], s_sel, -jnp.inf)
        s_own = jnp.einsum('bhqd,bhkd->bhqk', qc, k_own).astype(f32) * scale
        qpos = q0 + jnp.arange(Q_CHUNK)
        kpos = own * MOBA_BLOCK + jnp.arange(MOBA_BLOCK)
        s_own = jnp.where(kpos[None, :] <= qpos[:, None], s_own, -jnp.inf)
        sc = jnp.concatenate([s_sel.reshape(bsz, nh, Q_CHUNK, n_sel_keys), s_own], axis=-1)
        p = jax.nn.softmax(sc, axis=-1).astype(v.dtype)
        p_sel = p[..., :n_sel_keys].reshape(bsz, nh, Q_CHUNK, n_sel, MOBA_BLOCK)
        p_own = p[..., n_sel_keys:]
        return (jnp.einsum('bhqnk,bhqnkd->bhqd', p_sel, v_sel)
                + jnp.einsum('bhqk,bhkd->bhqd', p_own, v_own))

    out = lax.map(chunk, (jnp.arange(n_chunks), to_chunks(q), to_chunks(sel), to_chunks(sel_ok)))
    return jnp.moveaxis(out, 0, 2).reshape(bsz, nh, s, dh)


def moe_ffn(h, w_router, b_router, w_gu, b_gu, w_down, b_down):
    bsz, s, dm = h.shape
    n = bsz * s
    hf = h.reshape(n, dm)
    logits = (hf @ w_router + b_router).astype(jnp.float32)
    top_vals, top_idx = lax.top_k(logits, TOP_K)
    top_w = jax.nn.softmax(top_vals, axis=-1)
    nk = n * TOP_K
    flat_e = top_idx.reshape(nk)
    flat_t = jnp.arange(nk, dtype=jnp.int32) // TOP_K
    flat_w = top_w.reshape(nk)
    order = jnp.argsort(flat_e)
    sorted_e = flat_e[order]
    counts = jnp.bincount(flat_e, length=N_EXPERTS)
    group_start = jnp.cumsum(counts) - counts
    padded = (counts + EXPERT_ROWS - 1) // EXPERT_ROWS * EXPERT_ROWS
    padded_end = jnp.cumsum(padded)
    padded_start = padded_end - padded
    n_blocks = -(-nk // EXPERT_ROWS) + N_EXPERTS
    rows_total = n_blocks * EXPERT_ROWS
    dest = padded_start[sorted_e] + jnp.arange(nk, dtype=jnp.int32) - group_start[sorted_e]
    row_tok = jnp.full((rows_total,), n, dtype=jnp.int32).at[dest].set(flat_t[order])
    row_w = jnp.zeros((rows_total,), jnp.float32).at[dest].set(flat_w[order])
    blk_e = jnp.minimum(jnp.searchsorted(padded_end, jnp.arange(n_blocks) * EXPERT_ROWS, side='right'),
                        N_EXPERTS - 1)
    h_pad = jnp.concatenate([hf, jnp.zeros((1, dm), hf.dtype)], axis=0)

    def expert_block(args):
        e, tok, wt = args
        xb = h_pad[tok]
        gu = xb @ w_gu[e] + b_gu[e]
        gate = jnp.minimum(gu[:, :D_FF], SWIGLU_LIMIT)
        up = jnp.clip(gu[:, D_FF:], -SWIGLU_LIMIT, SWIGLU_LIMIT)
        act = (up + 1.0) * gate * jax.nn.sigmoid(SWIGLU_ALPHA * gate)
        y = act @ w_down[e] + b_down[e]
        return y * wt[:, None].astype(y.dtype)

    rows = lax.map(expert_block, (blk_e, row_tok.reshape(n_blocks, EXPERT_ROWS),
                                  row_w.reshape(n_blocks, EXPERT_ROWS)))
    out = jnp.zeros((n + 1, dm), rows.dtype).at[row_tok].add(rows.reshape(rows_total, dm))[:n]
    return out.reshape(bsz, s, dm).astype(h.dtype)


def setup_inputs(seed: int = 0) -> dict:
    key = jax.random.key(seed)
    ks = jax.random.split(key, 32)
    f32 = jnp.float32
    L, D, G, P, C = DEPTH, D_MODEL, SSM_GROUPS, SSM_STATE, SSM_GROUP

    def nrm(k, shape, scale):
        return jax.random.normal(k, shape, f32) * scale

    u01 = jax.random.uniform(ks[8], (L, G), f32)
    return {
        'x': nrm(ks[0], (BATCH, SEQ, D), 1.0),
        'c': nrm(ks[1], (BATCH, D), 1.0),
        'w_ada': nrm(ks[2], (L, D, 6 * D), D ** -0.5),
        'b_ada': nrm(ks[3], (L, 6 * D), 0.01),
        'g_mix': 1.0 + nrm(ks[4], (L, D), 0.01),
        'w_in': nrm(ks[5], (L, D, IN_WIDTH), D ** -0.5),
        'ssm_a_re': -0.5 + nrm(ks[6], (L, G, P), 0.01),
        'ssm_a_im': math.pi * jnp.arange(P, dtype=f32) + nrm(ks[7], (L, G, P), 0.01),
        'ssm_log_dt': math.log(DT_MIN) + u01 * (math.log(DT_MAX) - math.log(DT_MIN)),
        'ssm_b_re': nrm(ks[9], (L, G, P, C), (2 * C) ** -0.5),
        'ssm_b_im': nrm(ks[10], (L, G, P, C), (2 * C) ** -0.5),
        'ssm_c_re': nrm(ks[11], (L, G, C, P), (2 * P) ** -0.5),
        'ssm_c_im': nrm(ks[12], (L, G, C, P), (2 * P) ** -0.5),
        'ssm_d': nrm(ks[13], (L, SSM_WIDTH), 1.0),
        'w_glu': nrm(ks[14], (L, SSM_WIDTH, 2 * D), SSM_WIDTH ** -0.5),
        'w_attn_o': nrm(ks[15], (L, ATTN_WIDTH, D), ATTN_WIDTH ** -0.5),
        'w_out': nrm(ks[16], (L, D, D), D ** -0.5),
        'g_ffn': 1.0 + nrm(ks[17], (L, D), 0.01),
        'w_router': nrm(ks[18], (L, D, N_EXPERTS), D ** -0.5),
        'b_router': nrm(ks[19], (L, N_EXPERTS), 0.01),
        'w_gu': nrm(ks[20], (L, N_EXPERTS, D, 2 * D_FF), D ** -0.5),
        'b_gu': nrm(ks[21], (L, N_EXPERTS, 2 * D_FF), 0.01),
        'w_down': nrm(ks[22], (L, N_EXPERTS, D_FF, D), D_FF ** -0.5),
        'b_down': nrm(ks[23], (L, N_EXPERTS, D), 0.01),
        'g_final': 1.0 + nrm(ks[24], (D,), 0.01),
    }


def reference(x, c, w_ada, b_ada, g_mix, w_in, ssm_a_re, ssm_a_im, ssm_log_dt, ssm_b_re, ssm_b_im,
              ssm_c_re, ssm_c_im, ssm_d, w_glu, w_attn_o, w_out, g_ffn, w_router, b_router,
              w_gu, b_gu, w_down, b_down, g_final):
    s = x.shape[1]
    cos, sin = rotary_tables(s)
    cond = jax.nn.silu(c)
    splits = [SSM_WIDTH, SSM_WIDTH + ATTN_WIDTH, SSM_WIDTH + 2 * ATTN_WIDTH,
              SSM_WIDTH + 3 * ATTN_WIDTH, SSM_WIDTH + 3 * ATTN_WIDTH + D_MODEL]
    for l in range(DEPTH):
        mod = cond @ w_ada[l] + b_ada[l]
        sh1, sc1, gt1, sh2, sc2, gt2 = jnp.split(mod, 6, axis=-1)
        h = modulate(rms_norm(x, g_mix[l]), sh1, sc1)
        proj = h @ w_in[l]
        u, q, k, v, ga, gb = jnp.split(proj, splits, axis=-1)
        y_ssm = s5_mixer(u, ssm_a_re[l], ssm_a_im[l], ssm_log_dt[l], ssm_b_re[l], ssm_b_im[l],
                         ssm_c_re[l], ssm_c_im[l], ssm_d[l])
        glu = jax.nn.gelu(y_ssm) @ w_glu[l]
        y_a = glu[..., :D_MODEL] * jax.nn.sigmoid(glu[..., D_MODEL:])
        qh = partial_rotary(to_heads(q), cos, sin)
        kh = partial_rotary(to_heads(k), cos, sin)
        o = moba_attention(qh, kh, to_heads(v))
        o = o.transpose(0, 2, 1, 3).reshape(x.shape[0], s, ATTN_WIDTH)
        y_b = o @ w_attn_o[l]
        merged = jax.nn.sigmoid(ga) * y_a + jax.nn.sigmoid(gb) * y_b
        x = x + gt1[:, None, :] * (merged @ w_out[l])
        h2 = modulate(rms_norm(x, g_ffn[l]), sh2, sc2)
        x = x + gt2[:, None, :] * moe_ffn(h2, w_router[l], b_router[l], w_gu[l], b_gu[l],
                                          w_down[l], b_down[l])
    return rms_norm(x, g_final)
```

```cpp
#include <hip/hip_runtime.h>
#include <cstdio>
#include <cstdint>

#define GAS __attribute__((address_space(1)))
#define LAS __attribute__((address_space(3)))
typedef unsigned short bf16;
typedef unsigned v4u __attribute__((ext_vector_type(4)));
typedef unsigned v2u __attribute__((ext_vector_type(2)));
typedef float f32x4 __attribute__((ext_vector_type(4)));

constexpr int BATCH = 4, SEQ = 8192, DM = 1024, NTOK = BATCH * SEQ, INW = 4096;
constexpr int NH = 8, HD = 64, AW = 512, SW = 512, NG = 32, NP = 64, NC = 16;
constexpr int NE = 32, TOPK = 4, DFF = 1024, MAXTILES = 544, MAXROWS = MAXTILES * 256;
constexpr int NWAVES = 8, NTHR = 512;
constexpr float RMS_EPS = 1e-5f;

constexpr size_t MiB = 1u << 20;
constexpr size_t WS_CTL = 0, CTL_ZERO_BYTES = 64 * 1024;
constexpr size_t WS_MOD = 1 * MiB;
constexpr size_t WS_ROT = 2 * MiB;
constexpr size_t WS_KMEAN = 3 * MiB;
constexpr size_t WS_TOPI = 4 * MiB;
constexpr size_t WS_TOPW = 5 * MiB;
constexpr size_t WS_BLKCNT = 6 * MiB;
constexpr size_t WS_ROWTOK = 7 * MiB;
constexpr size_t WS_ROWW = 8 * MiB;
constexpr size_t WS_TILEE = 9 * MiB;
constexpr size_t WS_WIN = 16 * MiB, WS_WGLU = 24 * MiB, WS_WAO = 26 * MiB, WS_WOUT = 27 * MiB, WS_WGU = 32 * MiB, WS_WD = 160 * MiB;
constexpr size_t WS_X1 = 224 * MiB;
constexpr size_t WS_U = 352 * MiB, WS_Q = 384 * MiB, WS_K = 416 * MiB, WS_V = 448 * MiB, WS_GA = 480 * MiB, WS_GB = 544 * MiB, WS_O = 608 * MiB, WS_Y = 640 * MiB;
constexpr size_t WS_ACT = 352 * MiB;
constexpr size_t WS_H = 672 * MiB;
constexpr size_t WS_MRG = 736 * MiB;
constexpr size_t WS_YS = 672 * MiB;
constexpr size_t WS_END = 928 * MiB;

constexpr int LDS_BYTES = 147456;
constexpr int LDS_MISC = 147456 - 512;
constexpr int LDS_PAR = 147456 - 1024;

__device__ __forceinline__ float bf2f(bf16 v) { return __builtin_bit_cast(float, (unsigned)v << 16); }
__device__ __forceinline__ unsigned f2bf(float f) { unsigned u = __builtin_bit_cast(unsigned, f); return (u + 0x7fffu + ((u >> 16) & 1u)) >> 16; }
__device__ __forceinline__ unsigned pk2(float lo, float hi) { return f2bf(lo) | (f2bf(hi) << 16); }
__device__ __forceinline__ float lo16(unsigned w) { return __builtin_bit_cast(float, w << 16); }
__device__ __forceinline__ float hi16(unsigned w) { return __builtin_bit_cast(float, w & 0xffff0000u); }
__device__ __forceinline__ float sigm(float x) { return 1.f / (1.f + __expf(-x)); }
__device__ __forceinline__ float wave_sum(float v) {
#pragma unroll
    for (int o = 1; o < 64; o <<= 1) v += __shfl_xor(v, o);
    return v;
}
__device__ __forceinline__ void unpack8(v4u w, float (&f)[8]) {
    f[0] = lo16(w.x); f[1] = hi16(w.x); f[2] = lo16(w.y); f[3] = hi16(w.y); f[4] = lo16(w.z); f[5] = hi16(w.z); f[6] = lo16(w.w); f[7] = hi16(w.w);
}
__device__ __forceinline__ v4u pack8(const float (&f)[8]) { v4u w; w.x = pk2(f[0], f[1]); w.y = pk2(f[2], f[3]); w.z = pk2(f[4], f[5]); w.w = pk2(f[6], f[7]); return w; }

#define XB_TMO      128
#define XB_XCNT(j)  (256  + 64 * (j))
#define XB_XSUB(j)  (1280 + 64 * (j))
#define XB_XGEN(j)  (2304 + 64 * (j))
#define XB_TOP      3328
#define XB_TOPGEN   3392
#define XCD_BAR_WORDS 3456
#define XB_SPIN_CAP (1u << 25)
__device__ __forceinline__ unsigned xb_ld(unsigned* p)              { return __hip_atomic_load(p, __ATOMIC_RELAXED, __HIP_MEMORY_SCOPE_AGENT); }
__device__ __forceinline__ unsigned xb_add(unsigned* p, unsigned v) { return __hip_atomic_fetch_add(p, v, __ATOMIC_RELAXED, __HIP_MEMORY_SCOPE_AGENT); }
__device__ __forceinline__ unsigned xb_xcc_id() { return (unsigned)__builtin_amdgcn_s_getreg((3 << 11) | 20) & 0xFu; }
#define XB_SPIN(cond, bar) do { unsigned _sp = 0; while (cond) { __builtin_amdgcn_s_sleep(1); \
    if ((++_sp & 255u) == 0u) { if (xb_ld(&(bar)[XB_TMO])) break; if (_sp > XB_SPIN_CAP) { atomicAdd(&(bar)[XB_TMO], 1u); break; } } } } while (0)
struct XcdBarrier { unsigned* bar; unsigned x; volatile LAS unsigned* st; };
__device__ __forceinline__ XcdBarrier xcd_barrier_post(unsigned* bar, volatile LAS unsigned* st) {
    XcdBarrier b; b.bar = bar; b.x = xb_xcc_id(); b.st = st;
    if (threadIdx.x == 0) (void)xb_add(&bar[XB_XCNT(b.x)], 1u);
    return b;
}
__device__ __forceinline__ void xcd_barrier_complete(unsigned* bar, unsigned x, unsigned& nloc, unsigned& nx) {
    const unsigned G = gridDim.x * gridDim.y * gridDim.z;
    unsigned sum, cnt, mine, sp = 0u;
    for (;;) {
        sum = 0u; cnt = 0u; mine = 0u;
#pragma unroll
        for (unsigned j = 0; j < 16; ++j) { const unsigned c = xb_ld(&bar[XB_XCNT(j)]); sum += c; cnt += (c > 0u) ? 1u : 0u; mine = (j == x) ? c : mine; }
        if (sum == G) break;
        __builtin_amdgcn_s_sleep(1);
        if ((++sp & 255u) == 0u) { if (xb_ld(&bar[XB_TMO])) break; if (sp > XB_SPIN_CAP) { atomicAdd(&bar[XB_TMO], 1u); break; } }
    }
    nloc = mine > 0u ? mine : 1u; nx = cnt > 0u ? cnt : 1u;
}
__device__ __forceinline__ void xcd_barrier(const XcdBarrier& b) {
    asm volatile("s_waitcnt vmcnt(0)" ::: "memory");
    __syncthreads();
    if (threadIdx.x == 0) {
        unsigned* bar = b.bar;
        __builtin_amdgcn_s_waitcnt(0);
        unsigned nloc = b.st[0], nx = b.st[1];
        if (nloc == 0u) { xcd_barrier_complete(bar, b.x, nloc, nx); b.st[0] = nloc; b.st[1] = nx; }
        const unsigned old = xb_add(&bar[XB_XSUB(b.x)], 1u);
        const unsigned gen = old / nloc;
        if (old + 1u == (gen + 1u) * nloc) {
            __builtin_amdgcn_fence(__ATOMIC_RELEASE, "agent");
            asm volatile("s_waitcnt vmcnt(0)" ::: "memory");
            const unsigned og = xb_add(&bar[XB_TOP], 1u);
            const unsigned tg = og / nx;
            if (og + 1u == (tg + 1u) * nx) xb_add(&bar[XB_TOPGEN], 1u);
            else XB_SPIN(xb_ld(&bar[XB_TOPGEN]) == tg, bar);
            __builtin_amdgcn_fence(__ATOMIC_ACQUIRE, "agent");
            xb_add(&bar[XB_XGEN(b.x)], 1u);
            asm volatile("s_waitcnt vmcnt(0)" ::: "memory");
        } else {
            XB_SPIN(xb_ld(&bar[XB_XGEN(b.x)]) == gen, bar);
            __builtin_amdgcn_fence(__ATOMIC_ACQUIRE, "agent");
            asm volatile("s_waitcnt vmcnt(0)" ::: "memory");
        }
    }
    __syncthreads();
}

struct Params { const float* in[25]; float* out; unsigned char* ws; };
enum { I_X = 0, I_C, I_WADA, I_BADA, I_GMIX, I_WIN, I_ARE, I_AIM, I_LOGDT, I_BRE, I_BIM, I_CRE, I_CIM, I_SD, I_WGLU, I_WAO, I_WOUT, I_GFFN, I_WR, I_BR, I_WGU, I_BGU, I_WD, I_BD, I_GFIN };

__device__ __forceinline__ int ilv(int n) { return n < 1024 ? ((n >> 7) * 256 + (n & 127)) : (((n - 1024) >> 7) * 256 + 128 + ((n - 1024) & 127)); }

__device__ __forceinline__ void transpose_item(const float* W, int K, int N, bf16* WT, bool interleave, LAS float* scr, int item, int lane) {
    const int nblk = N / 32, kb = item / nblk, nb = item % nblk, k0 = 64 * kb, n0 = 32 * nb;
#pragma unroll 8
    for (int i = 0; i < 32; ++i) { const int kk = 2 * i + (lane >> 5); scr[kk * 33 + (lane & 31)] = W[(size_t)(k0 + kk) * N + n0 + (lane & 31)]; }
    asm volatile("s_waitcnt lgkmcnt(0)" ::: "memory");
    const int c = lane & 7;
    const int r0 = interleave ? ilv(n0) : n0;
#pragma unroll
    for (int j = 0; j < 4; ++j) { const int n = (lane >> 3) + 8 * j; const LAS float* s = scr + (8 * c) * 33 + n;
        v4u o; o.x = pk2(s[0 * 33], s[1 * 33]); o.y = pk2(s[2 * 33], s[3 * 33]); o.z = pk2(s[4 * 33], s[5 * 33]); o.w = pk2(s[6 * 33], s[7 * 33]);
        *(v4u*)(WT + (size_t)(r0 + n) * K + k0 + 8 * c) = o; }
    asm volatile("s_waitcnt lgkmcnt(0)" ::: "memory");
}

template <class AP, class BP, class Epi>
__device__ __forceinline__ void ngemm_unit(LAS unsigned char* lds, int K, AP ap, BP bp, Epi epi) {
    LAS float* As = (LAS float*)lds;
    LAS float* Bs = As + 32 * 65;
    LAS float* Cs = Bs + 32 * 257;
    const int tid = threadIdx.x, rp = tid >> 4, cg = tid & 15;
    float acc[2][16];
#pragma unroll
    for (int i = 0; i < 2; ++i)
#pragma unroll
        for (int j = 0; j < 16; ++j) acc[i][j] = 0.f;
    const int arow = tid >> 3, akq = (tid & 7) * 4;
    const int bn = tid >> 1, bkh = (tid & 1) * 16;
    const bf16* aptr = ap(arow) + akq;
    const bf16* bptr = bp(bn) + bkh;
    for (int k0 = 0; k0 < K; k0 += 32) {
        const v2u av = *(const v2u*)(aptr + k0);
        const v4u bv0 = *(const v4u*)(bptr + k0), bv1 = *(const v4u*)(bptr + k0 + 8);
        __syncthreads();
        As[(akq + 0) * 65 + arow] = lo16(av.x); As[(akq + 1) * 65 + arow] = hi16(av.x); As[(akq + 2) * 65 + arow] = lo16(av.y); As[(akq + 3) * 65 + arow] = hi16(av.y);
        { float f[8]; unpack8(bv0, f);
#pragma unroll
          for (int i = 0; i < 8; ++i) Bs[(bkh + i) * 257 + bn] = f[i];
          unpack8(bv1, f);
#pragma unroll
          for (int i = 0; i < 8; ++i) Bs[(bkh + 8 + i) * 257 + bn] = f[i]; }
        __syncthreads();
#pragma unroll 4
        for (int kk = 0; kk < 32; ++kk) {
            const float a0 = As[kk * 65 + 2 * rp], a1 = As[kk * 65 + 2 * rp + 1];
#pragma unroll
            for (int j = 0; j < 16; ++j) { const float b = Bs[kk * 257 + cg + 16 * j]; acc[0][j] += a0 * b; acc[1][j] += a1 * b; }
        }
    }
#pragma unroll
    for (int i = 0; i < 2; ++i)
#pragma unroll
        for (int j = 0; j < 16; ++j) Cs[(2 * rp + i) * 257 + cg + 16 * j] = acc[i][j];
    __syncthreads();
#pragma unroll
    for (int i = 0; i < 2; ++i) {
        float v0[8], v1[8];
#pragma unroll
        for (int j = 0; j < 8; ++j) { v0[j] = Cs[(2 * rp + i) * 257 + 8 * cg + j]; v1[j] = Cs[(2 * rp + i) * 257 + 128 + 8 * cg + j]; }
        epi(2 * rp + i, 8 * cg, v0, v1);
    }
    __syncthreads();
}

__device__ __forceinline__ const void* ldptr(LAS unsigned char* lds, int i) {
    const unsigned long long v = ((volatile LAS unsigned long long*)(lds + LDS_PAR))[i];
    const unsigned lo = __builtin_amdgcn_readfirstlane((unsigned)v), hi = __builtin_amdgcn_readfirstlane((unsigned)(v >> 32));
    return (const void*)(((unsigned long long)hi << 32) | lo);
}
#define INP(i) ((const float*)ldptr(lds, (i)))
#define WSB() ((unsigned char*)ldptr(lds, 26))
__global__ void __launch_bounds__(NTHR, 2) mega_fwd(Params P) {
    extern __shared__ __attribute__((aligned(16))) unsigned char lds_raw[];
    LAS unsigned char* lds = (LAS unsigned char*)lds_raw;
    volatile LAS unsigned* MISC = (volatile LAS unsigned*)(lds + LDS_MISC);
    const int tid = threadIdx.x, lane = tid & 63, wave = __builtin_amdgcn_readfirstlane(tid >> 6);
    const int G = gridDim.x, bid = blockIdx.x;
    const int gw = bid * NWAVES + wave, NGW = G * NWAVES;
    if (tid < 128) MISC[tid] = 0u;
    if (tid < 25) ((LAS unsigned long long*)(lds + LDS_PAR))[tid] = (unsigned long long)P.in[tid];
    if (tid == 25) ((LAS unsigned long long*)(lds + LDS_PAR))[25] = (unsigned long long)P.out;
    if (tid == 26) ((LAS unsigned long long*)(lds + LDS_PAR))[26] = (unsigned long long)P.ws;
    __syncthreads();
    XcdBarrier bar = xcd_barrier_post((unsigned*)(P.ws + WS_CTL) + 1024, MISC + 8);

    {
        unsigned char* ws = WSB(); float* MOD = (float*)(ws + WS_MOD); float* ROT = (float*)(ws + WS_ROT);
        for (int it = gw; it < 6144 / 64; it += NGW) {
            const int j = it * 64 + lane;
            float a0 = 0.f, a1 = 0.f, a2 = 0.f, a3 = 0.f;
            const float* c = INP(I_C); const float* w = INP(I_WADA);
#pragma unroll 8
            for (int k = 0; k < 1024; ++k) {
                const float wv = w[(size_t)k * 6144 + j];
                const float c0 = c[k], c1 = c[1024 + k], c2 = c[2048 + k], c3 = c[3072 + k];
                a0 += c0 * sigm(c0) * wv; a1 += c1 * sigm(c1) * wv; a2 += c2 * sigm(c2) * wv; a3 += c3 * sigm(c3) * wv;
            }
            const float bb = INP(I_BADA)[j];
            MOD[j] = a0 + bb; MOD[6144 + j] = a1 + bb; MOD[2 * 6144 + j] = a2 + bb; MOD[3 * 6144 + j] = a3 + bb;
        }
        for (int i = bid * NTHR + tid; i < SEQ * 8; i += G * NTHR) {
            const int s = i >> 3, d = i & 7;
            const float inv = 1.0f / powf(500000.0f, (float)(2 * d) / 16.0f);
            const float ang = (float)s * inv;
            float sn, cs; sincosf(ang, &sn, &cs);
            ROT[2 * i] = cs; ROT[2 * i + 1] = sn;
        }
        LAS float* scr = (LAS float*)(lds + wave * 16384);
        constexpr int I_IN = 16 * 128, I_GL = 8 * 64, I_AO = 8 * 32, I_OU = 16 * 32, I_GU1 = 16 * 64, I_D1 = 16 * 32;
        constexpr int NIT = I_IN + I_GL + I_AO + I_OU + NE * I_GU1 + NE * I_D1;
        for (int it = gw; it < NIT; it += NGW) {
            int r = it;
            if (r < I_IN) { transpose_item(INP(I_WIN), 1024, 4096, (bf16*)(ws + WS_WIN), false, scr, r, lane); continue; } r -= I_IN;
            if (r < I_GL) { transpose_item(INP(I_WGLU), 512, 2048, (bf16*)(ws + WS_WGLU), true, scr, r, lane); continue; } r -= I_GL;
            if (r < I_AO) { transpose_item(INP(I_WAO), 512, 1024, (bf16*)(ws + WS_WAO), false, scr, r, lane); continue; } r -= I_AO;
            if (r < I_OU) { transpose_item(INP(I_WOUT), 1024, 1024, (bf16*)(ws + WS_WOUT), false, scr, r, lane); continue; } r -= I_OU;
            if (r < NE * I_GU1) { const int e = r / I_GU1; transpose_item(INP(I_WGU) + (size_t)e * 1024 * 2048, 1024, 2048, (bf16*)(ws + WS_WGU) + (size_t)e * 2048 * 1024, true, scr, r % I_GU1, lane); continue; } r -= NE * I_GU1;
            { const int e = r / I_D1; transpose_item(INP(I_WD) + (size_t)e * 1024 * 1024, 1024, 1024, (bf16*)(ws + WS_WD) + (size_t)e * 1024 * 1024, false, scr, r % I_D1, lane); }
        }
    }
    xcd_barrier(bar);

    { unsigned char* ws = WSB(); const float* x = INP(I_X); const float* gmix = INP(I_GMIX); const float* MOD = (const float*)(ws + WS_MOD); bf16* Hb = (bf16*)(ws + WS_H);
    for (int m = gw; m < NTOK; m += NGW) {
        const int b = m >> 13;
        const f32x4* xr = (const f32x4*)(x + (size_t)m * DM) + lane;
        f32x4 v[4]; float s = 0.f;
#pragma unroll
        for (int j = 0; j < 4; ++j) { v[j] = xr[64 * j]; s += (v[j].x * v[j].x + v[j].y * v[j].y) + (v[j].z * v[j].z + v[j].w * v[j].w); }
        const float r = rsqrtf(wave_sum(s) * (1.f / DM) + RMS_EPS);
        v2u* o8 = (v2u*)(Hb + (size_t)m * DM) + lane;
#pragma unroll
        for (int j = 0; j < 4; ++j) {
            const int col = 4 * lane + 256 * j;
            const f32x4 g = *(const f32x4*)(gmix + col);
            const f32x4 sh = *(const f32x4*)(MOD + b * 6144 + col), sc = *(const f32x4*)(MOD + b * 6144 + 1024 + col);
            v2u w; w.x = pk2(v[j].x * r * g.x * (1.f + sc.x) + sh.x, v[j].y * r * g.y * (1.f + sc.y) + sh.y);
            w.y = pk2(v[j].z * r * g.z * (1.f + sc.z) + sh.z, v[j].w * r * g.w * (1.f + sc.w) + sh.w);
            o8[64 * j] = w;
        }
    } }
    xcd_barrier(bar);

    { unsigned char* ws = WSB(); bf16* Hb = (bf16*)(ws + WS_H); bf16* WIN = (bf16*)(ws + WS_WIN);
      bf16* Ub = (bf16*)(ws + WS_U); bf16* Qb = (bf16*)(ws + WS_Q); bf16* Kb = (bf16*)(ws + WS_K); bf16* Vb = (bf16*)(ws + WS_V); bf16* GAb = (bf16*)(ws + WS_GA); bf16* GBb = (bf16*)(ws + WS_GB);
    for (int u = bid; u < (NTOK / 64) * 16; u += G) {
        const int pm = u >> 4, pn = u & 15;
        bf16* dst; int ld, cb;
        if (pn < 2) { dst = Ub; ld = 512; cb = 256 * pn; } else if (pn < 4) { dst = Qb; ld = 512; cb = 256 * (pn - 2); } else if (pn < 6) { dst = Kb; ld = 512; cb = 256 * (pn - 4); }
        else if (pn < 8) { dst = Vb; ld = 512; cb = 256 * (pn - 6); } else if (pn < 12) { dst = GAb; ld = 1024; cb = 256 * (pn - 8); } else { dst = GBb; ld = 1024; cb = 256 * (pn - 12); }
        ngemm_unit(lds, 1024,
            [&](int r) { return Hb + (size_t)(pm * 64 + r) * 1024; },
            [&](int n) { return WIN + (size_t)(pn * 256 + n) * 1024; },
            [&](int r, int c8, const float (&v0)[8], const float (&v1)[8]) {
                bf16* o = dst + (size_t)(pm * 64 + r) * ld + cb + c8;
                *(v4u*)o = pack8(v0); *(v4u*)(o + 128) = pack8(v1);
            });
    } }
    xcd_barrier(bar);

    { unsigned char* ws = WSB(); bf16* Qb = (bf16*)(ws + WS_Q); bf16* Kb = (bf16*)(ws + WS_K); const float* ROT = (const float*)(ws + WS_ROT); float* KMEAN = (float*)(ws + WS_KMEAN);
    for (int it = gw; it < 2 * BATCH * NH * 32; it += NGW) {
        const int isk = it >> 10, r = it & 1023, b = r >> 8, h = (r >> 5) & 7, j = r & 31;
        bf16* T = isk ? Kb : Qb;
        float sum = 0.f;
        for (int t = 0; t < 256; ++t) {
            const int s = j * 256 + t; const size_t row = (size_t)b * SEQ + s;
            bf16* p = T + row * 512 + h * 64 + lane;
            float v = bf2f(*p);
            const float other = __shfl_xor(v, 8);
            if (lane < 16) {
                const float cs = ROT[(s * 8 + (lane & 7)) * 2], sn = ROT[(s * 8 + (lane & 7)) * 2 + 1];
                v = (lane < 8) ? (v * cs - other * sn) : (v * cs + other * sn);
                const unsigned rb = f2bf(v); *p = (bf16)rb; v = bf2f((bf16)rb);
            }
            sum += v;
        }
        if (isk) KMEAN[((b * NH + h) * 32 + j) * 64 + lane] = sum * (1.f / 256.f);
    } }
    xcd_barrier(bar);

    if (gw < BATCH * NG) {
        unsigned char* ws = WSB(); const bf16* Ub = (const bf16*)(ws + WS_U); bf16* Yb = (bf16*)(ws + WS_Y);
        const int b = gw >> 5, g = gw & 31, p = lane;
        const float lr = INP(I_ARE)[g * 64 + p], li = INP(I_AIM)[g * 64 + p], dt = expf(INP(I_LOGDT)[g]);
        const float mag = expf(lr * dt); float sn, cs; sincosf(li * dt, &sn, &cs);
        const float ar = mag * cs, ai = mag * sn, den = lr * lr + li * li;
        const float cfr = ((ar - 1.f) * lr + ai * li) / den, cfi = (ai * lr - (ar - 1.f) * li) / den;
        float bbr[16], bbi[16], ccr[16], cci[16];
        { const float* pbre = INP(I_BRE); const float* pbim = INP(I_BIM); const float* pcre = INP(I_CRE); const float* pcim = INP(I_CIM);
#pragma unroll
        for (int c = 0; c < 16; ++c) {
            const float br = pbre[(g * 64 + p) * 16 + c], bi = pbim[(g * 64 + p) * 16 + c];
            bbr[c] = cfr * br - cfi * bi; bbi[c] = cfr * bi + cfi * br;
            ccr[c] = pcre[(g * 16 + c) * 64 + p]; cci[c] = pcim[(g * 16 + c) * 64 + p];
        } }
        const int ch = lane >> 2;
        const float dsk = INP(I_SD)[g * 16 + ch];
        float xr = 0.f, xi = 0.f;
        for (int t = 0; t < SEQ; ++t) {
            const size_t row = (size_t)b * SEQ + t;
            const bf16* up = Ub + row * 512 + g * 16;
            const v4u w0 = *(const v4u*)up, w1 = *(const v4u*)(up + 8);
            float u[16];
            { float f[8]; unpack8(w0, f);
#pragma unroll
              for (int i = 0; i < 8; ++i) u[i] = f[i];
              unpack8(w1, f);
#pragma unroll
              for (int i = 0; i < 8; ++i) u[8 + i] = f[i]; }
            const float uc = bf2f(up[ch]);
            float bur = 0.f, bui = 0.f;
#pragma unroll
            for (int c = 0; c < 16; ++c) { bur += bbr[c] * u[c]; bui += bbi[c] * u[c]; }
            const float nxr = ar * xr - ai * xi + bur, nxi = ar * xi + ai * xr + bui; xr = nxr; xi = nxi;
            float v[16];
#pragma unroll
            for (int c = 0; c < 16; ++c) v[c] = ccr[c] * xr - cci[c] * xi;
            float w8[8], w4[4], w2[2], w1_;
            { const bool hi = (lane & 32) != 0;
#pragma unroll
              for (int i = 0; i < 8; ++i) { const float keep = hi ? v[i + 8] : v[i], send = hi ? v[i] : v[i + 8]; w8[i] = keep + __shfl_xor(send, 32); } }
            { const bool hi = (lane & 16) != 0;
#pragma unroll
              for (int i = 0; i < 4; ++i) { const float keep = hi ? w8[i + 4] : w8[i], send = hi ? w8[i] : w8[i + 4]; w4[i] = keep + __shfl_xor(send, 16); } }
            { const bool hi = (lane & 8) != 0;
#pragma unroll
              for (int i = 0; i < 2; ++i) { const float keep = hi ? w4[i + 2] : w4[i], send = hi ? w4[i] : w4[i + 2]; w2[i] = keep + __shfl_xor(send, 8); } }
            { const bool hi = (lane & 4) != 0; const float keep = hi ? w2[1] : w2[0], send = hi ? w2[0] : w2[1]; w1_ = keep + __shfl_xor(send, 4); }
            w1_ += __shfl_xor(w1_, 2); w1_ += __shfl_xor(w1_, 1);
            const float y = w1_ + dsk * uc;
            const float ge = y * sigm(1.5957691216f * (y + 0.044715f * y * y * y));
            if ((lane & 3) == 0) Yb[row * 512 + g * 16 + ch] = (bf16)f2bf(ge);
        }
    }
    { unsigned char* ws = WSB();
    for (int it = gw; it < BATCH * NH * 128; it += NGW) {
        const int b = it >> 10, h = (it >> 7) & 7, chk = it & 127, s = chk * 64 + lane, nb = chk >> 2;
        const size_t qrow = (size_t)b * SEQ + s;
        const bf16* Qb_ = (const bf16*)(ws + WS_Q); const bf16* Kb_ = (const bf16*)(ws + WS_K); const bf16* Vb_ = (const bf16*)(ws + WS_V);
        v4u qp[8];
#pragma unroll
        for (int i = 0; i < 8; ++i) qp[i] = ((const v4u*)(Qb_ + qrow * 512 + h * 64))[i];
        float g0 = -INFINITY, g1 = -INFINITY, g2 = -INFINITY; int s0 = 0, s1 = 0, s2 = 0;
        for (int j = 0; j < nb; ++j) {
            const float* km = (const float*)(ws + WS_KMEAN) + ((b * NH + h) * 32 + j) * 64;
            float g = 0.f;
#pragma unroll
            for (int i = 0; i < 8; ++i) { float f[8]; unpack8(qp[i], f);
#pragma unroll
                for (int jj = 0; jj < 8; ++jj) g += f[jj] * km[8 * i + jj]; }
            if (g > g0) { g2 = g1; s2 = s1; g1 = g0; s1 = s0; g0 = g; s0 = j; }
            else if (g > g1) { g2 = g1; s2 = s1; g1 = g; s1 = j; }
            else if (g > g2) { g2 = g; s2 = j; }
        }
        const int nsel = nb < 3 ? nb : 3;
        float m = -1e30f, l = 0.f, o[64];
#pragma unroll
        for (int d = 0; d < 64; ++d) o[d] = 0.f;
        for (int t = 0; t < 4; ++t) {
            if (t < 3 && t >= nsel) continue;
            const int j = (t == 0) ? s0 : (t == 1) ? s1 : (t == 2) ? s2 : nb;
            const int kend = (t == 3) ? ((s & 255) + 1) : 256;
            const int kmax = (t == 3) ? ((chk & 3) * 64 + 64) : 256;
            const size_t base = (size_t)b * SEQ + (size_t)j * 256;
#pragma unroll 1
            for (int key = 0; key < kmax; ++key) {
                const v4u* kp = (const v4u*)(Kb_ + (base + key) * 512 + h * 64);
                float d0 = 0.f;
#pragma unroll
                for (int i = 0; i < 8; ++i) { float f[8], qf[8]; unpack8(kp[i], f); unpack8(qp[i], qf);
#pragma unroll
                    for (int jj = 0; jj < 8; ++jj) d0 += qf[jj] * f[jj]; }
                const bool valid = key < kend;
                const float sc = valid ? d0 * 0.125f : -1e30f;
                if (sc > m) {
                    const float alpha = __expf(m - sc);
                    l *= alpha;
#pragma unroll
                    for (int d = 0; d < 64; ++d) o[d] *= alpha;
                    m = sc;
                }
                const float pexp = valid ? __expf(sc - m) : 0.f;
                l += pexp;
                const v4u* vp = (const v4u*)(Vb_ + (base + key) * 512 + h * 64);
#pragma unroll
                for (int i = 0; i < 8; ++i) { float f[8]; unpack8(vp[i], f);
#pragma unroll
                    for (int jj = 0; jj < 8; ++jj) o[8 * i + jj] += pexp * f[jj]; }
            }
        }
        const float il = 1.f / l;
        v4u* op = (v4u*)((bf16*)(ws + WS_O) + qrow * 512 + h * 64);
#pragma unroll
        for (int i = 0; i < 8; ++i) { float f[8];
#pragma unroll
            for (int j = 0; j < 8; ++j) f[j] = o[8 * i + j] * il;
            op[i] = pack8(f); }
    } }
    xcd_barrier(bar);

    { unsigned char* ws = WSB(); const bf16* Yb = (const bf16*)(ws + WS_Y); const bf16* WGLU = (const bf16*)(ws + WS_WGLU); const bf16* GAb = (const bf16*)(ws + WS_GA); bf16* MRG = (bf16*)(ws + WS_MRG);
    for (int u = bid; u < (NTOK / 64) * 8; u += G) {
        const int pm = u >> 3, pn = u & 7;
        ngemm_unit(lds, 512,
            [&](int r) { return Yb + (size_t)(pm * 64 + r) * 512; },
            [&](int n) { return WGLU + (size_t)(pn * 256 + n) * 512; },
            [&](int r, int c8, const float (&v0)[8], const float (&v1)[8]) {
                const size_t off = (size_t)(pm * 64 + r) * 1024 + pn * 128 + c8;
                float ga[8]; unpack8(*(const v4u*)(GAb + off), ga);
                float f[8];
#pragma unroll
                for (int j = 0; j < 8; ++j) f[j] = sigm(ga[j]) * v0[j] * sigm(v1[j]);
                *(v4u*)(MRG + off) = pack8(f);
            });
    } }
    xcd_barrier(bar);

    { unsigned char* ws = WSB(); const bf16* Ob = (const bf16*)(ws + WS_O); const bf16* WAO = (const bf16*)(ws + WS_WAO); const bf16* GBb = (const bf16*)(ws + WS_GB); bf16* MRG = (bf16*)(ws + WS_MRG);
    for (int u = bid; u < (NTOK / 64) * 4; u += G) {
        const int pm = u >> 2, pn = u & 3;
        ngemm_unit(lds, 512,
            [&](int r) { return Ob + (size_t)(pm * 64 + r) * 512; },
            [&](int n) { return WAO + (size_t)(pn * 256 + n) * 512; },
            [&](int r, int c8, const float (&v0)[8], const float (&v1)[8]) {
                const size_t off = (size_t)(pm * 64 + r) * 1024 + pn * 256 + c8;
                float gb[8], ma[8], f[8];
                unpack8(*(const v4u*)(GBb + off), gb); unpack8(*(const v4u*)(MRG + off), ma);
#pragma unroll
                for (int j = 0; j < 8; ++j) f[j] = ma[j] + sigm(gb[j]) * v0[j];
                *(v4u*)(MRG + off) = pack8(f);
                unpack8(*(const v4u*)(GBb + off + 128), gb); unpack8(*(const v4u*)(MRG + off + 128), ma);
#pragma unroll
                for (int j = 0; j < 8; ++j) f[j] = ma[j] + sigm(gb[j]) * v1[j];
                *(v4u*)(MRG + off + 128) = pack8(f);
            });
    } }
    xcd_barrier(bar);

    { unsigned char* ws = WSB(); const float* x = INP(I_X); const float* MOD = (const float*)(ws + WS_MOD); const bf16* MRG = (const bf16*)(ws + WS_MRG); const bf16* WOUT = (const bf16*)(ws + WS_WOUT); float* X1 = (float*)(ws + WS_X1);
    for (int u = bid; u < (NTOK / 64) * 4; u += G) {
        const int pm = u >> 2, pn = u & 3;
        ngemm_unit(lds, 1024,
            [&](int r) { return MRG + (size_t)(pm * 64 + r) * 1024; },
            [&](int n) { return WOUT + (size_t)(pn * 256 + n) * 1024; },
            [&](int r, int c8, const float (&v0)[8], const float (&v1)[8]) {
                const int row = pm * 64 + r, b = row >> 13, col = pn * 256 + c8;
                const float* gt = MOD + b * 6144 + 2048 + col;
                const float* xp = x + (size_t)row * 1024 + col; float* op = X1 + (size_t)row * 1024 + col;
#pragma unroll
                for (int j = 0; j < 8; ++j) { op[j] = xp[j] + gt[j] * v0[j]; op[128 + j] = xp[128 + j] + gt[128 + j] * v1[j]; }
            });
    } }
    xcd_barrier(bar);

    {
        unsigned char* ws = WSB(); const float* X1 = (const float*)(ws + WS_X1); const float* MOD = (const float*)(ws + WS_MOD); bf16* Hb = (bf16*)(ws + WS_H);
        const float* gffn = INP(I_GFFN); const float* wrt = INP(I_WR); const float* brt = INP(I_BR);
        int* TOPI = (int*)(ws + WS_TOPI); float* TOPW = (float*)(ws + WS_TOPW); int* BLKCNT = (int*)(ws + WS_BLKCNT);
        LAS int* cnt = (LAS int*)lds;
        if (tid < 32) cnt[tid] = 0;
        __syncthreads();
        const int tpb = NTOK / G;
        for (int tl = wave; tl < tpb; tl += NWAVES) {
            const int m = bid * tpb + tl, b = m >> 13;
            const f32x4* xr = (const f32x4*)(X1 + (size_t)m * DM) + lane;
            f32x4 v[4]; float s = 0.f;
#pragma unroll
            for (int j = 0; j < 4; ++j) { v[j] = xr[64 * j]; s += (v[j].x * v[j].x + v[j].y * v[j].y) + (v[j].z * v[j].z + v[j].w * v[j].w); }
            const float r = rsqrtf(wave_sum(s) * (1.f / DM) + RMS_EPS);
            float lg[32];
#pragma unroll
            for (int e = 0; e < 32; ++e) lg[e] = 0.f;
            v2u* o8 = (v2u*)(Hb + (size_t)m * DM) + lane;
#pragma unroll
            for (int j = 0; j < 4; ++j) {
                const int col = 4 * lane + 256 * j;
                const f32x4 g = *(const f32x4*)(gffn + col);
                const f32x4 sh = *(const f32x4*)(MOD + b * 6144 + 3072 + col), sc = *(const f32x4*)(MOD + b * 6144 + 4096 + col);
                float hv[4];
                hv[0] = v[j].x * r * g.x * (1.f + sc.x) + sh.x; hv[1] = v[j].y * r * g.y * (1.f + sc.y) + sh.y;
                hv[2] = v[j].z * r * g.z * (1.f + sc.z) + sh.z; hv[3] = v[j].w * r * g.w * (1.f + sc.w) + sh.w;
                v2u w; w.x = pk2(hv[0], hv[1]); w.y = pk2(hv[2], hv[3]); o8[64 * j] = w;
#pragma unroll
                for (int i = 0; i < 4; ++i) {
                    const f32x4* wr = (const f32x4*)(wrt + (size_t)(col + i) * 32);
#pragma unroll
                    for (int e4 = 0; e4 < 8; ++e4) { const f32x4 w4 = wr[e4]; lg[4 * e4] += hv[i] * w4.x; lg[4 * e4 + 1] += hv[i] * w4.y; lg[4 * e4 + 2] += hv[i] * w4.z; lg[4 * e4 + 3] += hv[i] * w4.w; }
                }
            }
            float a16[16], a8[8], a4[4], a2[2], a1;
            { const bool hi = (lane & 32) != 0;
#pragma unroll
              for (int i = 0; i < 16; ++i) { const float keep = hi ? lg[i + 16] : lg[i], send = hi ? lg[i] : lg[i + 16]; a16[i] = keep + __shfl_xor(send, 32); } }
            { const bool hi = (lane & 16) != 0;
#pragma unroll
              for (int i = 0; i < 8; ++i) { const float keep = hi ? a16[i + 8] : a16[i], send = hi ? a16[i] : a16[i + 8]; a8[i] = keep + __shfl_xor(send, 16); } }
            { const bool hi = (lane & 8) != 0;
#pragma unroll
              for (int i = 0; i < 4; ++i) { const float keep = hi ? a8[i + 4] : a8[i], send = hi ? a8[i] : a8[i + 4]; a4[i] = keep + __shfl_xor(send, 8); } }
            { const bool hi = (lane & 4) != 0;
#pragma unroll
              for (int i = 0; i < 2; ++i) { const float keep = hi ? a4[i + 2] : a4[i], send = hi ? a4[i] : a4[i + 2]; a2[i] = keep + __shfl_xor(send, 4); } }
            { const bool hi = (lane & 2) != 0; const float keep = hi ? a2[1] : a2[0], send = hi ? a2[0] : a2[1]; a1 = keep + __shfl_xor(send, 2); }
            a1 += __shfl_xor(a1, 1);
            const int e_me = lane >> 1;
            float val = a1 + brt[e_me];
            float tv[4]; int ti[4];
#pragma unroll
            for (int k = 0; k < 4; ++k) {
                float bv = val; int bi = e_me;
#pragma unroll
                for (int o = 1; o < 64; o <<= 1) { const float ov = __shfl_xor(bv, o); const int oi = __shfl_xor(bi, o); if (ov > bv || (ov == bv && oi < bi)) { bv = ov; bi = oi; } }
                tv[k] = bv; ti[k] = bi;
                if (e_me == bi) val = -INFINITY;
            }
            const float e0 = 1.f, e1 = __expf(tv[1] - tv[0]), e2 = __expf(tv[2] - tv[0]), e3 = __expf(tv[3] - tv[0]);
            const float inv = 1.f / (e0 + e1 + e2 + e3);
            if (lane == 0) {
                TOPI[m * 4 + 0] = ti[0]; TOPI[m * 4 + 1] = ti[1]; TOPI[m * 4 + 2] = ti[2]; TOPI[m * 4 + 3] = ti[3];
                TOPW[m * 4 + 0] = e0 * inv; TOPW[m * 4 + 1] = e1 * inv; TOPW[m * 4 + 2] = e2 * inv; TOPW[m * 4 + 3] = e3 * inv;
                atomicAdd((int*)&cnt[ti[0]], 1); atomicAdd((int*)&cnt[ti[1]], 1); atomicAdd((int*)&cnt[ti[2]], 1); atomicAdd((int*)&cnt[ti[3]], 1);
            }
        }
        __syncthreads();
        if (tid < 32) BLKCNT[bid * 32 + tid] = cnt[tid];
    }
    xcd_barrier(bar);

    {
        unsigned char* ws = WSB(); const int* TOPI = (const int*)(ws + WS_TOPI); const float* TOPW = (const float*)(ws + WS_TOPW); const int* BLKCNT = (const int*)(ws + WS_BLKCNT);
        int* ROWTOK = (int*)(ws + WS_ROWTOK); float* ROWW = (float*)(ws + WS_ROWW); int* TILEE = (int*)(ws + WS_TILEE);
        LAS int* tot = (LAS int*)lds;
        LAS int* mine = tot + 32;
        LAS int* pst = mine + 32;
        LAS int* ent = pst + 64;
        const int tpb = NTOK / G;
        if (tid < 32) {
            int t = 0, mn = 0;
            for (int k = 0; k < G; ++k) { const int c = BLKCNT[k * 32 + tid]; t += c; if (k < bid) mn += c; }
            tot[tid] = t; mine[tid] = mn;
        }
        for (int i = tid; i < tpb * 4; i += NTHR) ent[i] = TOPI[bid * tpb * 4 + i];
        __syncthreads();
        if (tid == 0) { int a = 0; for (int e = 0; e < 32; ++e) { pst[e] = a; a += (tot[e] + 255) & ~255; } pst[32] = a; }
        __syncthreads();
        for (int i = tid; i < tpb * 4; i += NTHR) {
            const int e = ent[i]; int rank = 0;
            for (int k = 0; k < i; ++k) rank += (ent[k] == e) ? 1 : 0;
            const int pos = pst[e] + mine[e] + rank;
            ROWTOK[pos] = (bid * tpb + (i >> 2)) * 4 + (i & 3);
            ROWW[pos] = TOPW[bid * tpb * 4 + i];
        }
        if (bid < 32) { const int e = bid; for (int pos = pst[e] + tot[e] + tid; pos < pst[e + 1]; pos += NTHR) { ROWTOK[pos] = -1; ROWW[pos] = 0.f; } }
        if (bid == 32 % G) {
            const int nt = pst[32] >> 8;
            for (int t = tid; t < nt; t += NTHR) { int e = 0; for (int k = 0; k < 32; ++k) if ((t << 8) >= pst[k]) e = k; TILEE[t] = e; }
            if (tid == 0) TILEE[1023] = nt;
        }
    }
    xcd_barrier(bar);

    {
        unsigned char* ws = WSB(); const int* TILEE = (const int*)(ws + WS_TILEE); const int* ROWTOK = (const int*)(ws + WS_ROWTOK); const bf16* Hb = (const bf16*)(ws + WS_H); const bf16* WGU = (const bf16*)(ws + WS_WGU); bf16* ACT = (bf16*)(ws + WS_ACT);
        const float* bgu = INP(I_BGU);
        const int nt = TILEE[1023];
        for (int u = bid; u < nt * 4 * 8; u += G) {
            const int pm = u >> 3, pn = u & 7, e = TILEE[pm >> 2];
            const bf16* wb = WGU + (size_t)e * 2048 * 1024;
            const float* bg = bgu + (size_t)e * 2048;
            ngemm_unit(lds, 1024,
                [&](int r) { const int rt = ROWTOK[pm * 64 + r]; return Hb + (size_t)(rt < 0 ? 0 : (rt >> 2)) * 1024; },
                [&](int n) { return wb + (size_t)(pn * 256 + n) * 1024; },
                [&](int r, int c8, const float (&v0)[8], const float (&v1)[8]) {
                    const int col = pn * 128 + c8; float f[8];
#pragma unroll
                    for (int j = 0; j < 8; ++j) {
                        const float gt = fminf(v0[j] + bg[col + j], 7.f);
                        const float up = fminf(fmaxf(v1[j] + bg[1024 + col + j], -7.f), 7.f);
                        f[j] = (up + 1.f) * gt * sigm(1.702f * gt);
                    }
                    *(v4u*)(ACT + (size_t)(pm * 64 + r) * 1024 + col) = pack8(f);
                });
        }
    }
    xcd_barrier(bar);

    {
        unsigned char* ws = WSB(); const int* TILEE = (const int*)(ws + WS_TILEE); const int* ROWTOK = (const int*)(ws + WS_ROWTOK); const float* ROWW = (const float*)(ws + WS_ROWW); const bf16* ACT = (const bf16*)(ws + WS_ACT); const bf16* WD = (const bf16*)(ws + WS_WD); bf16* YS = (bf16*)(ws + WS_YS);
        const float* bdn = INP(I_BD);
        const int nt = TILEE[1023];
        for (int u = bid; u < nt * 4 * 4; u += G) {
            const int pm = u >> 2, pn = u & 3, e = TILEE[pm >> 2];
            const bf16* wb = WD + (size_t)e * 1024 * 1024;
            const float* bd = bdn + (size_t)e * 1024;
            ngemm_unit(lds, 1024,
                [&](int r) { return ACT + (size_t)(pm * 64 + r) * 1024; },
                [&](int n) { return wb + (size_t)(pn * 256 + n) * 1024; },
                [&](int r, int c8, const float (&v0)[8], const float (&v1)[8]) {
                    const int rt = ROWTOK[pm * 64 + r];
                    if (rt >= 0) {
                        const float w = ROWW[pm * 64 + r]; const int col = pn * 256 + c8; float f[8];
#pragma unroll
                        for (int j = 0; j < 8; ++j) f[j] = (v0[j] + bd[col + j]) * w;
                        *(v4u*)(YS + (size_t)rt * 1024 + col) = pack8(f);
#pragma unroll
                        for (int j = 0; j < 8; ++j) f[j] = (v1[j] + bd[col + 128 + j]) * w;
                        *(v4u*)(YS + (size_t)rt * 1024 + col + 128) = pack8(f);
                    }
                });
        }
    }
    xcd_barrier(bar);

    { unsigned char* ws = WSB(); const float* X1 = (const float*)(ws + WS_X1); const float* MOD = (const float*)(ws + WS_MOD); const bf16* YS = (const bf16*)(ws + WS_YS); const float* gfin = INP(I_GFIN); float* outp = (float*)ldptr(lds, 25);
    for (int m = gw; m < NTOK; m += NGW) {
        const int b = m >> 13;
        const f32x4* xr = (const f32x4*)(X1 + (size_t)m * DM) + lane;
        f32x4 v[4]; float s = 0.f;
#pragma unroll
        for (int j = 0; j < 4; ++j) {
            const int col = 4 * lane + 256 * j;
            f32x4 a = (f32x4){0.f, 0.f, 0.f, 0.f};
#pragma unroll
            for (int sl = 0; sl < 4; ++sl) { const v2u w = *(const v2u*)(YS + ((size_t)m * 4 + sl) * 1024 + col); a.x += lo16(w.x); a.y += hi16(w.x); a.z += lo16(w.y); a.w += hi16(w.y); }
            const f32x4 gt = *(const f32x4*)(MOD + b * 6144 + 5120 + col);
            v[j] = xr[64 * j] + gt * a;
            s += (v[j].x * v[j].x + v[j].y * v[j].y) + (v[j].z * v[j].z + v[j].w * v[j].w);
        }
        const float r = rsqrtf(wave_sum(s) * (1.f / DM) + RMS_EPS);
        f32x4* op = (f32x4*)(outp + (size_t)m * DM) + lane;
#pragma unroll
        for (int j = 0; j < 4; ++j) { const f32x4 g = *(const f32x4*)(gfin + 4 * lane + 256 * j); op[64 * j] = v[j] * r * g; }
    } }
}

extern "C" void kernel_launch(void* const* d_in, const int* in_sizes, int n_in, void* d_out, int out_size, void* d_ws, size_t ws_size, hipStream_t stream) {
    static int grid = 0;
    if (grid == 0) {
        if (n_in != 25 || in_sizes[0] != NTOK * DM || out_size != NTOK * DM || ws_size < WS_END) {
            fprintf(stderr, "kernel_launch: unexpected shapes (n_in %d, in0 %d, out %d, ws %zu); nothing launched\n", n_in, n_in > 0 ? in_sizes[0] : -1, out_size, ws_size); grid = -1; return; }
        int dev = 0, cus = 0, per_cu = 0;
        if (hipGetDevice(&dev) != hipSuccess || hipDeviceGetAttribute(&cus, hipDeviceAttributeMultiprocessorCount, dev) != hipSuccess) { grid = -1; return; }
        if (hipFuncSetAttribute((const void*)mega_fwd, hipFuncAttributeMaxDynamicSharedMemorySize, LDS_BYTES) != hipSuccess) { fprintf(stderr, "kernel_launch: hipFuncSetAttribute failed\n"); grid = -1; return; }
        if (hipOccupancyMaxActiveBlocksPerMultiprocessor(&per_cu, (const void*)mega_fwd, NTHR, LDS_BYTES) != hipSuccess || per_cu < 1) {
            fprintf(stderr, "kernel_launch: occupancy query reports %d blocks per CU\n", per_cu); (void)hipGetLastError(); grid = -1; return; }
        grid = cus;
        if (NTOK % grid != 0) { fprintf(stderr, "kernel_launch: grid %d does not divide the token count\n", grid); grid = -1; return; }
    }
    if (grid < 0) return;
    (void)hipMemsetAsync((char*)d_ws + WS_CTL, 0, CTL_ZERO_BYTES, stream);
    Params p{};
    for (int i = 0; i < 25; ++i) p.in[i] = (const float*)d_in[i];
    p.out = (float*)d_out; p.ws = (unsigned char*)d_ws;
    hipLaunchKernelGGL(mega_fwd, dim3(grid), dim3(NTHR), LDS_BYTES, stream, p);
}
```

```cpp
#include <hip/hip_runtime.h>
#include <cstdio>
#include <cstdint>

#define GAS __attribute__((address_space(1)))
#define LAS __attribute__((address_space(3)))
typedef unsigned short bf16;
typedef unsigned v4u __attribute__((ext_vector_type(4)));
typedef unsigned v2u __attribute__((ext_vector_type(2)));
typedef float f32x4 __attribute__((ext_vector_type(4)));

constexpr int BATCH = 4, SEQ = 8192, DM = 1024, NTOK = BATCH * SEQ, INW = 4096;
constexpr int NH = 8, HD = 64, AW = 512, SW = 512, NG = 32, NP = 64, NC = 16;
constexpr int NE = 32, TOPK = 4, DFF = 1024, MAXTILES = 544, MAXROWS = MAXTILES * 256;
constexpr int NWAVES = 8, NTHR = 512;
constexpr float RMS_EPS = 1e-5f;

constexpr size_t MiB = 1u << 20;
constexpr size_t WS_CTL = 0, CTL_ZERO_BYTES = 64 * 1024;
constexpr size_t WS_MOD = 1 * MiB;
constexpr size_t WS_ROT = 2 * MiB;
constexpr size_t WS_KMEAN = 3 * MiB;
constexpr size_t WS_TOPI = 4 * MiB;
constexpr size_t WS_TOPW = 5 * MiB;
constexpr size_t WS_BLKCNT = 6 * MiB;
constexpr size_t WS_ROWTOK = 7 * MiB;
constexpr size_t WS_ROWW = 8 * MiB;
constexpr size_t WS_TILEE = 9 * MiB;
constexpr size_t WS_WIN = 16 * MiB, WS_WGLU = 24 * MiB, WS_WAO = 26 * MiB, WS_WOUT = 27 * MiB, WS_WGU = 32 * MiB, WS_WD = 160 * MiB;
constexpr size_t WS_X1 = 224 * MiB;
constexpr size_t WS_U = 352 * MiB, WS_Q = 384 * MiB, WS_K = 416 * MiB, WS_V = 448 * MiB, WS_GA = 480 * MiB, WS_GB = 544 * MiB, WS_O = 608 * MiB, WS_Y = 640 * MiB;
constexpr size_t WS_ACT = 352 * MiB;
constexpr size_t WS_H = 672 * MiB;
constexpr size_t WS_MRG = 736 * MiB;
constexpr size_t WS_YS = 672 * MiB;
constexpr size_t WS_END = 928 * MiB;

constexpr int LDS_BYTES = 147456;
constexpr int LDS_MISC = 147456 - 512;
constexpr int LDS_PAR = 147456 - 1024;

__device__ __forceinline__ float bf2f(bf16 v) { return __builtin_bit_cast(float, (unsigned)v << 16); }
__device__ __forceinline__ unsigned f2bf(float f) { unsigned u = __builtin_bit_cast(unsigned, f); return (u + 0x7fffu + ((u >> 16) & 1u)) >> 16; }
__device__ __forceinline__ unsigned pk2(float lo, float hi) { return f2bf(lo) | (f2bf(hi) << 16); }
__device__ __forceinline__ float lo16(unsigned w) { return __builtin_bit_cast(float, w << 16); }
__device__ __forceinline__ float hi16(unsigned w) { return __builtin_bit_cast(float, w & 0xffff0000u); }
__device__ __forceinline__ float sigm(float x) { return 1.f / (1.f + __expf(-x)); }
__device__ __forceinline__ float wave_sum(float v) {
#pragma unroll
    for (int o = 1; o < 64; o <<= 1) v += __shfl_xor(v, o);
    return v;
}
__device__ __forceinline__ void unpack8(v4u w, float (&f)[8]) {
    f[0] = lo16(w.x); f[1] = hi16(w.x); f[2] = lo16(w.y); f[3] = hi16(w.y); f[4] = lo16(w.z); f[5] = hi16(w.z); f[6] = lo16(w.w); f[7] = hi16(w.w);
}
__device__ __forceinline__ v4u pack8(const float (&f)[8]) { v4u w; w.x = pk2(f[0], f[1]); w.y = pk2(f[2], f[3]); w.z = pk2(f[4], f[5]); w.w = pk2(f[6], f[7]); return w; }

#define XB_TMO      128
#define XB_XCNT(j)  (256  + 64 * (j))
#define XB_XSUB(j)  (1280 + 64 * (j))
#define XB_XGEN(j)  (2304 + 64 * (j))
#define XB_TOP      3328
#define XB_TOPGEN   3392
#define XCD_BAR_WORDS 3456
#define XB_SPIN_CAP (1u << 25)
__device__ __forceinline__ unsigned xb_ld(unsigned* p)              { return __hip_atomic_load(p, __ATOMIC_RELAXED, __HIP_MEMORY_SCOPE_AGENT); }
__device__ __forceinline__ unsigned xb_add(unsigned* p, unsigned v) { return __hip_atomic_fetch_add(p, v, __ATOMIC_RELAXED, __HIP_MEMORY_SCOPE_AGENT); }
__device__ __forceinline__ unsigned xb_xcc_id() { return (unsigned)__builtin_amdgcn_s_getreg((3 << 11) | 20) & 0xFu; }
#define XB_SPIN(cond, bar) do { unsigned _sp = 0; while (cond) { __builtin_amdgcn_s_sleep(1); \
    if ((++_sp & 255u) == 0u) { if (xb_ld(&(bar)[XB_TMO])) break; if (_sp > XB_SPIN_CAP) { atomicAdd(&(bar)[XB_TMO], 1u); break; } } } } while (0)
struct XcdBarrier { unsigned* bar; unsigned x; volatile LAS unsigned* st; };
__device__ __forceinline__ XcdBarrier xcd_barrier_post(unsigned* bar, volatile LAS unsigned* st) {
    XcdBarrier b; b.bar = bar; b.x = xb_xcc_id(); b.st = st;
    if (threadIdx.x == 0) (void)xb_add(&bar[XB_XCNT(b.x)], 1u);
    return b;
}
__device__ __forceinline__ void xcd_barrier_complete(unsigned* bar, unsigned x, unsigned& nloc, unsigned& nx) {
    const unsigned G = gridDim.x * gridDim.y * gridDim.z;
    unsigned sum, cnt, mine, sp = 0u;
    for (;;) {
        sum = 0u; cnt = 0u; mine = 0u;
#pragma unroll
        for (unsigned j = 0; j < 16; ++j) { const unsigned c = xb_ld(&bar[XB_XCNT(j)]); sum += c; cnt += (c > 0u) ? 1u : 0u; mine = (j == x) ? c : mine; }
        if (sum == G) break;
        __builtin_amdgcn_s_sleep(1);
        if ((++sp & 255u) == 0u) { if (xb_ld(&bar[XB_TMO])) break; if (sp > XB_SPIN_CAP) { atomicAdd(&bar[XB_TMO], 1u); break; } }
    }
    nloc = mine > 0u ? mine : 1u; nx = cnt > 0u ? cnt : 1u;
}
__device__ __forceinline__ void xcd_barrier(const XcdBarrier& b) {
    asm volatile("s_waitcnt vmcnt(0)" ::: "memory");
    __syncthreads();
    if (threadIdx.x == 0) {
        unsigned* bar = b.bar;
        __builtin_amdgcn_s_waitcnt(0);
        unsigned nloc = b.st[0], nx = b.st[1];
        if (nloc == 0u) { xcd_barrier_complete(bar, b.x, nloc, nx); b.st[0] = nloc; b.st[1] = nx; }
        const unsigned old = xb_add(&bar[XB_XSUB(b.x)], 1u);
        const unsigned gen = old / nloc;
        if (old + 1u == (gen + 1u) * nloc) {
            __builtin_amdgcn_fence(__ATOMIC_RELEASE, "agent");
            asm volatile("s_waitcnt vmcnt(0)" ::: "memory");
            const unsigned og = xb_add(&bar[XB_TOP], 1u);
            const unsigned tg = og / nx;
            if (og + 1u == (tg + 1u) * nx) xb_add(&bar[XB_TOPGEN], 1u);
            else XB_SPIN(xb_ld(&bar[XB_TOPGEN]) == tg, bar);
            __builtin_amdgcn_fence(__ATOMIC_ACQUIRE, "agent");
            xb_add(&bar[XB_XGEN(b.x)], 1u);
            asm volatile("s_waitcnt vmcnt(0)" ::: "memory");
        } else {
            XB_SPIN(xb_ld(&bar[XB_XGEN(b.x)]) == gen, bar);
            __builtin_amdgcn_fence(__ATOMIC_ACQUIRE, "agent");
            asm volatile("s_waitcnt vmcnt(0)" ::: "memory");
        }
    }
    __syncthreads();
}

struct Params { const float* in[25]; float* out; unsigned char* ws; };
enum { I_X = 0, I_C, I_WADA, I_BADA, I_GMIX, I_WIN, I_ARE, I_AIM, I_LOGDT, I_BRE, I_BIM, I_CRE, I_CIM, I_SD, I_WGLU, I_WAO, I_WOUT, I_GFFN, I_WR, I_BR, I_WGU, I_BGU, I_WD, I_BD, I_GFIN };

__device__ __forceinline__ int ilv(int n) { return n < 1024 ? ((n >> 7) * 256 + (n & 127)) : (((n - 1024) >> 7) * 256 + 128 + ((n - 1024) & 127)); }

__device__ __forceinline__ void transpose_item(const float* W, int K, int N, bf16* WT, bool interleave, LAS float* scr, int item, int lane) {
    const int nblk = N / 32, kb = item / nblk, nb = item % nblk, k0 = 64 * kb, n0 = 32 * nb;
#pragma unroll 8
    for (int i = 0; i < 32; ++i) { const int kk = 2 * i + (lane >> 5); scr[kk * 33 + (lane & 31)] = W[(size_t)(k0 + kk) * N + n0 + (lane & 31)]; }
    asm volatile("s_waitcnt lgkmcnt(0)" ::: "memory");
    const int c = lane & 7;
    const int r0 = interleave ? ilv(n0) : n0;
#pragma unroll
    for (int j = 0; j < 4; ++j) { const int n = (lane >> 3) + 8 * j; const LAS float* s = scr + (8 * c) * 33 + n;
        v4u o; o.x = pk2(s[0 * 33], s[1 * 33]); o.y = pk2(s[2 * 33], s[3 * 33]); o.z = pk2(s[4 * 33], s[5 * 33]); o.w = pk2(s[6 * 33], s[7 * 33]);
        *(v4u*)(WT + (size_t)(r0 + n) * K + k0 + 8 * c) = o; }
    asm volatile("s_waitcnt lgkmcnt(0)" ::: "memory");
}

template <class AP, class BP, class Epi>
__device__ __forceinline__ void ngemm_unit(LAS unsigned char* lds, int K, AP ap, BP bp, Epi epi) {
    LAS float* As = (LAS float*)lds;
    LAS float* Bs = As + 32 * 65;
    LAS float* Cs = Bs + 32 * 257;
    const int tid = threadIdx.x, rp = tid >> 4, cg = tid & 15;
    float acc[2][16];
#pragma unroll
    for (int i = 0; i < 2; ++i)
#pragma unroll
        for (int j = 0; j < 16; ++j) acc[i][j] = 0.f;
    const int arow = tid >> 3, akq = (tid & 7) * 4;
    const int bn = tid >> 1, bkh = (tid & 1) * 16;
    const bf16* aptr = ap(arow) + akq;
    const bf16* bptr = bp(bn) + bkh;
    for (int k0 = 0; k0 < K; k0 += 32) {
        const v2u av = *(const v2u*)(aptr + k0);
        const v4u bv0 = *(const v4u*)(bptr + k0), bv1 = *(const v4u*)(bptr + k0 + 8);
        __syncthreads();
        As[(akq + 0) * 65 + arow] = lo16(av.x); As[(akq + 1) * 65 + arow] = hi16(av.x); As[(akq + 2) * 65 + arow] = lo16(av.y); As[(akq + 3) * 65 + arow] = hi16(av.y);
        { float f[8]; unpack8(bv0, f);
#pragma unroll
          for (int i = 0; i < 8; ++i) Bs[(bkh + i) * 257 + bn] = f[i];
          unpack8(bv1, f);
#pragma unroll
          for (int i = 0; i < 8; ++i) Bs[(bkh + 8 + i) * 257 + bn] = f[i]; }
        __syncthreads();
#pragma unroll 4
        for (int kk = 0; kk < 32; ++kk) {
            const float a0 = As[kk * 65 + 2 * rp], a1 = As[kk * 65 + 2 * rp + 1];
#pragma unroll
            for (int j = 0; j < 16; ++j) { const float b = Bs[kk * 257 + cg + 16 * j]; acc[0][j] += a0 * b; acc[1][j] += a1 * b; }
        }
    }
#pragma unroll
    for (int i = 0; i < 2; ++i)
#pragma unroll
        for (int j = 0; j < 16; ++j) Cs[(2 * rp + i) * 257 + cg + 16 * j] = acc[i][j];
    __syncthreads();
#pragma unroll
    for (int i = 0; i < 2; ++i) {
        float v0[8], v1[8];
#pragma unroll
        for (int j = 0; j < 8; ++j) { v0[j] = Cs[(2 * rp + i) * 257 + 8 * cg + j]; v1[j] = Cs[(2 * rp + i) * 257 + 128 + 8 * cg + j]; }
        epi(2 * rp + i, 8 * cg, v0, v1);
    }
    __syncthreads();
}


namespace pg8 {
typedef short bf16x8 __attribute__((ext_vector_type(8)));
constexpr int BM = 256, BK = 64, HALF = 128, HTB = HALF * BK * 2, STAGE_BYTES = 8 * HTB, NXCD = 8, WGM = 8;
__host__ __device__ __forceinline__ int lds_byte(int r, int c) { const int st = (r >> 4) * 2 + (c >> 5), rr = r & 15, cc = c & 31, ob = rr * 64 + cc * 2; return st * 1024 + (ob ^ (((ob >> 9) & 1) << 5)); }
__host__ __device__ __forceinline__ void stage_rc(int b, int& R, int& C) { const int st = b / 1024, sb = b % 1024, swz = sb ^ (((sb >> 9) & 1) << 5); R = (st >> 1) * 16 + swz / 64; C = (st & 1) * 32 + (swz % 64) / 2; }
__host__ __device__ __forceinline__ int perm32(int rho) { const int n = rho >> 4, i = rho & 15; return 8 * (i >> 2) + 4 * n + (i & 3); }
struct Unit { int pm, pn, e, pad; const char* A; const char* B; };

struct DenseOrder {
    const char* A; const char* Bt; int nM, nN, nwg, G, c; size_t tstep;
    __device__ __forceinline__ void init(const void* A_, const void* Bt_, int M, int N, int K, int G_, int c_) { A = (const char*)A_; Bt = (const char*)Bt_; nM = M / BM; nN = N / BM; nwg = nM * nN; G = G_; c = c_; tstep = (size_t)BM * K * 2; }
    __device__ __forceinline__ bool next(int i, Unit& u) const {
        const long L = (long)i * G + c; if (L >= nwg) return false;
        int wgid = (int)L; { const int q = nwg / NXCD, r = nwg % NXCD, xcd = wgid % NXCD, off = wgid / NXCD; wgid = (xcd < r ? xcd * (q + 1) : r * (q + 1) + (xcd - r) * q) + off; }
        const int nig = WGM * nN, gid = wgid / nig, fm = gid * WGM, gsz = (nM - fm) < WGM ? (nM - fm) : WGM;
        u.pm = fm + ((wgid % nig) % gsz); u.pn = (wgid % nig) / gsz; u.e = 0; u.A = A + (size_t)u.pm * tstep; u.B = Bt + (size_t)u.pn * tstep; return true;
    }
    __device__ __forceinline__ unsigned rowoff(const Unit&, int) const { return 0u; }
};

template <class Epi, class Sched, bool GATHER>
__device__ __forceinline__ void gemm_phase(LAS unsigned char* lds, const int K, const Sched& S, const Epi& E) {
    int tid = threadIdx.x; asm volatile("" : "+v"(tid));
    const int wid = __builtin_amdgcn_readfirstlane(tid >> 6), lane = tid & 63, wr = wid >> 2, wc = wid & 3, fr = lane & 15, fq = lane >> 4;
    const int nt = K / BK;
    int sR[2], sC[2];
    unsigned voffA[2][2], nvoffA[2][2], voffB[2];
#pragma unroll
    for (int i = 0; i < 2; ++i) { int R, C; stage_rc(tid * 16 + i * 8192, R, C); sR[i] = R; sC[i] = C; const int Rb = (R & ~31) + perm32(R & 31);
        voffA[0][i] = (unsigned)(R * K + C) * 2u; voffA[1][i] = (unsigned)((R + HALF) * K + C) * 2u; voffB[i] = (unsigned)(Rb * K + C) * 2u;
        nvoffA[0][i] = voffA[0][i]; nvoffA[1][i] = voffA[1][i]; }
    const size_t kstep = (size_t)(BK * 2);
    const size_t hstep = (size_t)HALF * K * 2;
    const unsigned ldsw = (unsigned)wid * 1024u;
    const int aoff = lds_byte(wr * 64 + fr, fq * 8), boff = lds_byte(wc * 32 + fr, fq * 8);
#define PG8_SA(b, h) (((b) * 2 + (h)) * HTB)
#define PG8_SB(b, h) ((4 + (b) * 2 + (h)) * HTB)
#define PG8_STAGE(bufoff, gbase, v0, v1) do { \
        __builtin_amdgcn_global_load_lds((const unsigned*)((const char*)(gbase) + (v0)), (LAS unsigned*)(lds + (bufoff) + ldsw), 16, 0, 0); \
        __builtin_amdgcn_global_load_lds((const unsigned*)((const char*)(gbase) + (v1)), (LAS unsigned*)(lds + (bufoff) + ldsw + 8192), 16, 0, 0); } while (0)
#define PG8_LDA(dst, b, h) do { _Pragma("unroll") for (int m = 0; m < 4; ++m) _Pragma("unroll") for (int k = 0; k < 2; ++k) dst[m][k] = *(const LAS bf16x8*)(lds + PG8_SA(b, h) + aoff + m * 2048 + k * 1024); } while (0)
#define PG8_LDB(dst, b, h) do { _Pragma("unroll") for (int n = 0; n < 2; ++n) _Pragma("unroll") for (int k = 0; k < 2; ++k) dst[n][k] = *(const LAS bf16x8*)(lds + PG8_SB(b, h) + boff + n * 2048 + k * 1024); } while (0)
#define PG8_MMA(ai, bj, At, Bt) do { __builtin_amdgcn_s_setprio(1); _Pragma("unroll") for (int m = 0; m < 4; ++m) _Pragma("unroll") for (int n = 0; n < 2; ++n) _Pragma("unroll") for (int k = 0; k < 2; ++k) \
        acc[ai][bj][m][n] = __builtin_amdgcn_mfma_f32_16x16x32_bf16(Bt[n][k], At[m][k], acc[ai][bj][m][n], 0, 0, 0); __builtin_amdgcn_s_setprio(0); } while (0)
#define PG8_WAIT_V(n) asm volatile("s_waitcnt vmcnt(" #n ")" ::: "memory")
#define PG8_WAIT_L(n) asm volatile("s_waitcnt lgkmcnt(" #n ")" ::: "memory")
#define PG8_BAR __builtin_amdgcn_s_barrier()
#define PG8_SCHED __builtin_amdgcn_sched_barrier(0)
    Unit cur, nxt; int ui = 0;
    if (!S.next(0, cur)) return;
    if constexpr (GATHER) {
#pragma unroll
        for (int h = 0; h < 2; ++h)
#pragma unroll
            for (int i = 0; i < 2; ++i) voffA[h][i] = S.rowoff(cur, h * HALF + sR[i]) + (unsigned)sC[i] * 2u;
    }
    f32x4 acc[2][2][4][2];
#pragma unroll
    for (int a = 0; a < 2; ++a)
#pragma unroll
        for (int b = 0; b < 2; ++b)
#pragma unroll
            for (int m = 0; m < 4; ++m)
#pragma unroll
                for (int n = 0; n < 2; ++n) acc[a][b][m][n] = (f32x4){0.f, 0.f, 0.f, 0.f};
    bf16x8 At[4][2], B0[2][2], B1[2][2];
    const char* cA = cur.A; const char* cB = cur.B;
    PG8_STAGE(PG8_SB(0, 0), cB, voffB[0], voffB[1]); PG8_STAGE(PG8_SB(0, 1), cB + hstep, voffB[0], voffB[1]); PG8_STAGE(PG8_SA(0, 0), cA, voffA[0][0], voffA[0][1]); PG8_STAGE(PG8_SA(0, 1), cA, voffA[1][0], voffA[1][1]);
    if (wr == 1) PG8_BAR;
    PG8_WAIT_V(2); PG8_BAR;
    PG8_STAGE(PG8_SB(1, 0), cB + kstep, voffB[0], voffB[1]); PG8_STAGE(PG8_SA(1, 0), cA + kstep, voffA[0][0], voffA[0][1]); PG8_STAGE(PG8_SB(1, 1), cB + hstep + kstep, voffB[0], voffB[1]);
    PG8_WAIT_V(6); PG8_BAR;
    for (;;) {
        const bool has_next = S.next(ui + 1, nxt);
        const char* nA = has_next ? nxt.A : cA; const char* nB = has_next ? nxt.B : cB;
        if constexpr (GATHER) {
            if (has_next) {
#pragma unroll
                for (int h = 0; h < 2; ++h)
#pragma unroll
                    for (int i = 0; i < 2; ++i) nvoffA[h][i] = S.rowoff(nxt, h * HALF + sR[i]) + (unsigned)sC[i] * 2u;
            } else {
#pragma unroll
                for (int h = 0; h < 2; ++h)
#pragma unroll
                    for (int i = 0; i < 2; ++i) nvoffA[h][i] = voffA[h][i];
            }
        }
        for (int t = 0; t < nt; t += 2) {
            const bool last = (t == nt - 2);
            const char* a1 = cA + (size_t)(t + 1) * kstep;
            const char* a2 = last ? nA : cA + (size_t)(t + 2) * kstep; const char* b2 = last ? nB : cB + (size_t)(t + 2) * kstep;
            const char* a3 = a2 + kstep; const char* b3 = b2 + kstep;
            unsigned w00, w01, w10, w11;
            if constexpr (GATHER) { w00 = last ? nvoffA[0][0] : voffA[0][0]; w01 = last ? nvoffA[0][1] : voffA[0][1]; w10 = last ? nvoffA[1][0] : voffA[1][0]; w11 = last ? nvoffA[1][1] : voffA[1][1]; }
            else { w00 = voffA[0][0]; w01 = voffA[0][1]; w10 = voffA[1][0]; w11 = voffA[1][1]; }
            PG8_LDB(B0, 0, 0); PG8_LDB(B1, 0, 1); PG8_SCHED; PG8_LDA(At, 0, 0); PG8_STAGE(PG8_SA(1, 1), a1, voffA[1][0], voffA[1][1]);
            PG8_WAIT_V(8); PG8_WAIT_L(0); PG8_BAR; PG8_MMA(0, 0, At, B0); PG8_MMA(0, 1, At, B1); PG8_BAR; PG8_SCHED;
            PG8_LDA(At, 0, 1); PG8_STAGE(PG8_SB(0, 0), b2, voffB[0], voffB[1]); PG8_STAGE(PG8_SB(0, 1), b2 + hstep, voffB[0], voffB[1]); PG8_STAGE(PG8_SA(0, 0), a2, w00, w01);
            PG8_WAIT_V(8); PG8_WAIT_L(0); PG8_BAR; PG8_MMA(1, 0, At, B0); PG8_MMA(1, 1, At, B1); PG8_BAR; PG8_SCHED;
            PG8_LDB(B0, 1, 0); PG8_LDB(B1, 1, 1); PG8_SCHED; PG8_LDA(At, 1, 0); PG8_STAGE(PG8_SA(0, 1), a2, w10, w11);
            PG8_WAIT_V(8); PG8_WAIT_L(0); PG8_BAR; PG8_MMA(0, 0, At, B0); PG8_MMA(0, 1, At, B1); PG8_BAR; PG8_SCHED;
            PG8_LDA(At, 1, 1); PG8_STAGE(PG8_SB(1, 0), b3, voffB[0], voffB[1]); PG8_STAGE(PG8_SB(1, 1), b3 + hstep, voffB[0], voffB[1]); PG8_STAGE(PG8_SA(1, 0), a3, w00, w01);
            PG8_WAIT_V(8); PG8_WAIT_L(0); PG8_BAR; PG8_MMA(1, 0, At, B0); PG8_MMA(1, 1, At, B1); PG8_BAR; PG8_SCHED;
        }
        if (wr == 0) PG8_BAR;
        E(acc, cur, wr, wc, fr, fq);
        if (!has_next) break;
#pragma unroll
        for (int a = 0; a < 2; ++a)
#pragma unroll
            for (int b = 0; b < 2; ++b)
#pragma unroll
                for (int m = 0; m < 4; ++m)
#pragma unroll
                    for (int n = 0; n < 2; ++n) acc[a][b][m][n] = (f32x4){0.f, 0.f, 0.f, 0.f};
        cur = nxt; cA = nA; cB = nB; ++ui;
        if constexpr (GATHER) {
#pragma unroll
            for (int h = 0; h < 2; ++h)
#pragma unroll
                for (int i = 0; i < 2; ++i) voffA[h][i] = nvoffA[h][i];
        }
        if (wr == 1) PG8_BAR;
    }
    PG8_WAIT_V(0);
    PG8_BAR;
#undef PG8_SA
#undef PG8_SB
#undef PG8_STAGE
#undef PG8_LDA
#undef PG8_LDB
#undef PG8_MMA
#undef PG8_WAIT_V
#undef PG8_WAIT_L
#undef PG8_BAR
#undef PG8_SCHED
}

template <class F> struct EpiRows {
    F f;
    __device__ __forceinline__ void operator()(const f32x4 (&acc)[2][2][4][2], const Unit& u, int wr, int wc, int fr, int fq) const {
#pragma unroll
        for (int ai = 0; ai < 2; ++ai)
#pragma unroll
            for (int m = 0; m < 4; ++m) {
                float v0[8], v1[8];
#pragma unroll
                for (int j = 0; j < 4; ++j) { v0[j] = acc[ai][0][m][0][j]; v0[4 + j] = acc[ai][0][m][1][j]; v1[j] = acc[ai][1][m][0][j]; v1[4 + j] = acc[ai][1][m][1][j]; }
                f(u, ai * HALF + wr * 64 + m * 16 + fr, wc * 32 + 8 * fq, v0, v1);
            }
    }
};
template <class F> __device__ __forceinline__ EpiRows<F> make_epi(F f) { return EpiRows<F>{f}; }
}

struct MoeOrder {
    const char* A; const char* Bt; const int* tile_e; const int* rowtok; int nt, npn, G, c, tpg, K; bool gather; size_t estride, tstep;
    __device__ __forceinline__ void init(const void* A_, const void* Bt_, const int* tile_e_, const int* rowtok_, int npn_, size_t estride_, int K_, int G_, int c_, bool gather_) {
        A = (const char*)A_; Bt = (const char*)Bt_; tile_e = tile_e_; rowtok = rowtok_; npn = npn_; estride = estride_; K = K_; G = G_; c = c_; gather = gather_;
        nt = tile_e_[1023]; tpg = (G / 8) / npn; tstep = (size_t)256 * K_ * 2;
    }
    __device__ __forceinline__ bool next(int i, pg8::Unit& u) const {
        const int xc = c & 7, ci = c >> 3, group = i * 8 + xc, tile = group * tpg + ci / npn;
        if (tile >= nt) return false;
        u.pm = tile; u.pn = ci % npn; u.e = tile_e[tile];
        u.A = gather ? A : A + (size_t)tile * tstep; u.B = Bt + (size_t)u.e * estride + (size_t)u.pn * tstep; return true;
    }
    __device__ __forceinline__ unsigned rowoff(const pg8::Unit& u, int r) const { const int rt = rowtok[u.pm * 256 + r]; return (unsigned)(rt < 0 ? 0 : (rt >> 2)) * (unsigned)(K * 2); }
};

__device__ __forceinline__ const void* ldptr(LAS unsigned char* lds, int i) {
    const unsigned long long v = ((volatile LAS unsigned long long*)(lds + LDS_PAR))[i];
    const unsigned lo = __builtin_amdgcn_readfirstlane((unsigned)v), hi = __builtin_amdgcn_readfirstlane((unsigned)(v >> 32));
    return (const void*)(const GAS void*)(((unsigned long long)hi << 32) | lo);
}
#define INP(i) ((const float*)ldptr(lds, (i)))
#define WSB() ((unsigned char*)ldptr(lds, 26))
__global__ void __launch_bounds__(NTHR, 2) mega_fwd(Params P) {
    extern __shared__ __attribute__((aligned(16))) unsigned char lds_raw[];
    LAS unsigned char* lds = (LAS unsigned char*)lds_raw;
    volatile LAS unsigned* MISC = (volatile LAS unsigned*)(lds + LDS_MISC);
    const int tid = threadIdx.x, lane = tid & 63, wave = __builtin_amdgcn_readfirstlane(tid >> 6);
    const int G = gridDim.x, bid = blockIdx.x;
    const int gw = bid * NWAVES + wave, NGW = G * NWAVES;
    if (tid < 128) MISC[tid] = 0u;
    if (tid < 25) ((LAS unsigned long long*)(lds + LDS_PAR))[tid] = (unsigned long long)P.in[tid];
    if (tid == 25) ((LAS unsigned long long*)(lds + LDS_PAR))[25] = (unsigned long long)P.out;
    if (tid == 26) ((LAS unsigned long long*)(lds + LDS_PAR))[26] = (unsigned long long)P.ws;
    __syncthreads();
    XcdBarrier bar = xcd_barrier_post((unsigned*)(P.ws + WS_CTL) + 1024, MISC + 8);

    {
        unsigned char* ws = WSB(); float* MOD = (float*)(ws + WS_MOD); float* ROT = (float*)(ws + WS_ROT);
        for (int it = gw; it < 6144 / 64; it += NGW) {
            const int j = it * 64 + lane;
            float a0 = 0.f, a1 = 0.f, a2 = 0.f, a3 = 0.f;
            const float* c = INP(I_C); const float* w = INP(I_WADA);
#pragma unroll 8
            for (int k = 0; k < 1024; ++k) {
                const float wv = w[(size_t)k * 6144 + j];
                const float c0 = c[k], c1 = c[1024 + k], c2 = c[2048 + k], c3 = c[3072 + k];
                a0 += c0 * sigm(c0) * wv; a1 += c1 * sigm(c1) * wv; a2 += c2 * sigm(c2) * wv; a3 += c3 * sigm(c3) * wv;
            }
            const float bb = INP(I_BADA)[j];
            MOD[j] = a0 + bb; MOD[6144 + j] = a1 + bb; MOD[2 * 6144 + j] = a2 + bb; MOD[3 * 6144 + j] = a3 + bb;
        }
        for (int i = bid * NTHR + tid; i < SEQ * 8; i += G * NTHR) {
            const int s = i >> 3, d = i & 7;
            const float inv = 1.0f / powf(500000.0f, (float)(2 * d) / 16.0f);
            const float ang = (float)s * inv;
            float sn, cs; sincosf(ang, &sn, &cs);
            ROT[2 * i] = cs; ROT[2 * i + 1] = sn;
        }
        LAS float* scr = (LAS float*)(lds + wave * 16384);
        constexpr int I_IN = 16 * 128, I_GL = 8 * 64, I_AO = 8 * 32, I_OU = 16 * 32, I_GU1 = 16 * 64, I_D1 = 16 * 32;
        constexpr int NIT = I_IN + I_GL + I_AO + I_OU + NE * I_GU1 + NE * I_D1;
        for (int it = gw; it < NIT; it += NGW) {
            int r = it;
            if (r < I_IN) { transpose_item(INP(I_WIN), 1024, 4096, (bf16*)(ws + WS_WIN), false, scr, r, lane); continue; } r -= I_IN;
            if (r < I_GL) { transpose_item(INP(I_WGLU), 512, 2048, (bf16*)(ws + WS_WGLU), true, scr, r, lane); continue; } r -= I_GL;
            if (r < I_AO) { transpose_item(INP(I_WAO), 512, 1024, (bf16*)(ws + WS_WAO), false, scr, r, lane); continue; } r -= I_AO;
            if (r < I_OU) { transpose_item(INP(I_WOUT), 1024, 1024, (bf16*)(ws + WS_WOUT), false, scr, r, lane); continue; } r -= I_OU;
            if (r < NE * I_GU1) { const int e = r / I_GU1; transpose_item(INP(I_WGU) + (size_t)e * 1024 * 2048, 1024, 2048, (bf16*)(ws + WS_WGU) + (size_t)e * 2048 * 1024, true, scr, r % I_GU1, lane); continue; } r -= NE * I_GU1;
            { const int e = r / I_D1; transpose_item(INP(I_WD) + (size_t)e * 1024 * 1024, 1024, 1024, (bf16*)(ws + WS_WD) + (size_t)e * 1024 * 1024, false, scr, r % I_D1, lane); }
        }
    }
    xcd_barrier(bar);

    { unsigned char* ws = WSB(); const float* x = INP(I_X); const float* gmix = INP(I_GMIX); const float* MOD = (const float*)(ws + WS_MOD); bf16* Hb = (bf16*)(ws + WS_H);
    for (int m = gw; m < NTOK; m += NGW) {
        const int b = m >> 13;
        const f32x4* xr = (const f32x4*)(x + (size_t)m * DM) + lane;
        f32x4 v[4]; float s = 0.f;
#pragma unroll
        for (int j = 0; j < 4; ++j) { v[j] = xr[64 * j]; s += (v[j].x * v[j].x + v[j].y * v[j].y) + (v[j].z * v[j].z + v[j].w * v[j].w); }
        const float r = rsqrtf(wave_sum(s) * (1.f / DM) + RMS_EPS);
        v2u* o8 = (v2u*)(Hb + (size_t)m * DM) + lane;
#pragma unroll
        for (int j = 0; j < 4; ++j) {
            const int col = 4 * lane + 256 * j;
            const f32x4 g = *(const f32x4*)(gmix + col);
            const f32x4 sh = *(const f32x4*)(MOD + b * 6144 + col), sc = *(const f32x4*)(MOD + b * 6144 + 1024 + col);
            v2u w; w.x = pk2(v[j].x * r * g.x * (1.f + sc.x) + sh.x, v[j].y * r * g.y * (1.f + sc.y) + sh.y);
            w.y = pk2(v[j].z * r * g.z * (1.f + sc.z) + sh.z, v[j].w * r * g.w * (1.f + sc.w) + sh.w);
            o8[64 * j] = w;
        }
    } }
    xcd_barrier(bar);

    { unsigned char* ws = WSB();
      pg8::DenseOrder S; S.init(ws + WS_H, ws + WS_WIN, NTOK, INW, 1024, G, bid);
      auto E = pg8::make_epi([=](const pg8::Unit& u, int r, int c8, const float (&v0)[8], const float (&v1)[8]) {
          const int pn = u.pn;
          size_t boff; int ld, cb;
          if (pn < 8) { boff = WS_U + (size_t)(pn >> 1) * (32 * MiB); ld = 512; cb = 256 * (pn & 1); }
          else { boff = WS_GA + (size_t)((pn - 8) >> 2) * (64 * MiB); ld = 1024; cb = 256 * ((pn - 8) & 3); }
          bf16* o = (bf16*)(ws + boff) + (size_t)(u.pm * 256 + r) * ld + cb + c8;
          *(v4u*)o = pack8(v0); *(v4u*)(o + 128) = pack8(v1);
      });
      pg8::gemm_phase<decltype(E), pg8::DenseOrder, false>(lds, 1024, S, E);
    }
    xcd_barrier(bar);

    { unsigned char* ws = WSB(); bf16* Qb = (bf16*)(ws + WS_Q); bf16* Kb = (bf16*)(ws + WS_K); const float* ROT = (const float*)(ws + WS_ROT); float* KMEAN = (float*)(ws + WS_KMEAN);
    for (int it = gw; it < 2 * BATCH * NH * 32; it += NGW) {
        const int isk = it >> 10, r = it & 1023, b = r >> 8, h = (r >> 5) & 7, j = r & 31;
        bf16* T = isk ? Kb : Qb;
        float sum = 0.f;
        for (int t = 0; t < 256; ++t) {
            const int s = j * 256 + t; const size_t row = (size_t)b * SEQ + s;
            bf16* p = T + row * 512 + h * 64 + lane;
            float v = bf2f(*p);
            const float other = __shfl_xor(v, 8);
            if (lane < 16) {
                const float cs = ROT[(s * 8 + (lane & 7)) * 2], sn = ROT[(s * 8 + (lane & 7)) * 2 + 1];
                v = (lane < 8) ? (v * cs - other * sn) : (v * cs + other * sn);
                const unsigned rb = f2bf(v); *p = (bf16)rb; v = bf2f((bf16)rb);
            }
            sum += v;
        }
        if (isk) KMEAN[((b * NH + h) * 32 + j) * 64 + lane] = sum * (1.f / 256.f);
    } }
    xcd_barrier(bar);

    if (gw < BATCH * NG) {
        unsigned char* ws = WSB(); const bf16* Ub = (const bf16*)(ws + WS_U); bf16* Yb = (bf16*)(ws + WS_Y);
        const int b = gw >> 5, g = gw & 31, p = lane;
        const float lr = INP(I_ARE)[g * 64 + p], li = INP(I_AIM)[g * 64 + p], dt = expf(INP(I_LOGDT)[g]);
        const float mag = expf(lr * dt); float sn, cs; sincosf(li * dt, &sn, &cs);
        const float ar = mag * cs, ai = mag * sn, den = lr * lr + li * li;
        const float cfr = ((ar - 1.f) * lr + ai * li) / den, cfi = (ai * lr - (ar - 1.f) * li) / den;
        float bbr[16], bbi[16], ccr[16], cci[16];
        { const float* pbre = INP(I_BRE); const float* pbim = INP(I_BIM); const float* pcre = INP(I_CRE); const float* pcim = INP(I_CIM);
#pragma unroll
        for (int c = 0; c < 16; ++c) {
            const float br = pbre[(g * 64 + p) * 16 + c], bi = pbim[(g * 64 + p) * 16 + c];
            bbr[c] = cfr * br - cfi * bi; bbi[c] = cfr * bi + cfi * br;
            ccr[c] = pcre[(g * 16 + c) * 64 + p]; cci[c] = pcim[(g * 16 + c) * 64 + p];
        } }
        const int ch = lane >> 2;
        const float dsk = INP(I_SD)[g * 16 + ch];
        float xr = 0.f, xi = 0.f;
        for (int t = 0; t < SEQ; ++t) {
            const size_t row = (size_t)b * SEQ + t;
            const bf16* up = Ub + row * 512 + g * 16;
            const v4u w0 = *(const v4u*)up, w1 = *(const v4u*)(up + 8);
            float u[16];
            { float f[8]; unpack8(w0, f);
#pragma unroll
              for (int i = 0; i < 8; ++i) u[i] = f[i];
              unpack8(w1, f);
#pragma unroll
              for (int i = 0; i < 8; ++i) u[8 + i] = f[i]; }
            const float uc = bf2f(up[ch]);
            float bur = 0.f, bui = 0.f;
#pragma unroll
            for (int c = 0; c < 16; ++c) { bur += bbr[c] * u[c]; bui += bbi[c] * u[c]; }
            const float nxr = ar * xr - ai * xi + bur, nxi = ar * xi + ai * xr + bui; xr = nxr; xi = nxi;
            float v[16];
#pragma unroll
            for (int c = 0; c < 16; ++c) v[c] = ccr[c] * xr - cci[c] * xi;
            float w8[8], w4[4], w2[2], w1_;
            { const bool hi = (lane & 32) != 0;
#pragma unroll
              for (int i = 0; i < 8; ++i) { const float keep = hi ? v[i + 8] : v[i], send = hi ? v[i] : v[i + 8]; w8[i] = keep + __shfl_xor(send, 32); } }
            { const bool hi = (lane & 16) != 0;
#pragma unroll
              for (int i = 0; i < 4; ++i) { const float keep = hi ? w8[i + 4] : w8[i], send = hi ? w8[i] : w8[i + 4]; w4[i] = keep + __shfl_xor(send, 16); } }
            { const bool hi = (lane & 8) != 0;
#pragma unroll
              for (int i = 0; i < 2; ++i) { const float keep = hi ? w4[i + 2] : w4[i], send = hi ? w4[i] : w4[i + 2]; w2[i] = keep + __shfl_xor(send, 8); } }
            { const bool hi = (lane & 4) != 0; const float keep = hi ? w2[1] : w2[0], send = hi ? w2[0] : w2[1]; w1_ = keep + __shfl_xor(send, 4); }
            w1_ += __shfl_xor(w1_, 2); w1_ += __shfl_xor(w1_, 1);
            const float y = w1_ + dsk * uc;
            const float ge = y * sigm(1.5957691216f * (y + 0.044715f * y * y * y));
            if ((lane & 3) == 0) Yb[row * 512 + g * 16 + ch] = (bf16)f2bf(ge);
        }
    }
    { unsigned char* ws = WSB();
    for (int it = gw; it < BATCH * NH * 128; it += NGW) {
        const int b = it >> 10, h = (it >> 7) & 7, chk = it & 127, s = chk * 64 + lane, nb = chk >> 2;
        const size_t qrow = (size_t)b * SEQ + s;
        const bf16* Qb_ = (const bf16*)(ws + WS_Q); const bf16* Kb_ = (const bf16*)(ws + WS_K); const bf16* Vb_ = (const bf16*)(ws + WS_V);
        v4u qp[8];
#pragma unroll
        for (int i = 0; i < 8; ++i) qp[i] = ((const v4u*)(Qb_ + qrow * 512 + h * 64))[i];
        float g0 = -INFINITY, g1 = -INFINITY, g2 = -INFINITY; int s0 = 0, s1 = 0, s2 = 0;
        for (int j = 0; j < nb; ++j) {
            const float* km = (const float*)(ws + WS_KMEAN) + ((b * NH + h) * 32 + j) * 64;
            float g = 0.f;
#pragma unroll
            for (int i = 0; i < 8; ++i) { float f[8]; unpack8(qp[i], f);
#pragma unroll
                for (int jj = 0; jj < 8; ++jj) g += f[jj] * km[8 * i + jj]; }
            if (g > g0) { g2 = g1; s2 = s1; g1 = g0; s1 = s0; g0 = g; s0 = j; }
            else if (g > g1) { g2 = g1; s2 = s1; g1 = g; s1 = j; }
            else if (g > g2) { g2 = g; s2 = j; }
        }
        const int nsel = nb < 3 ? nb : 3;
        float m = -1e30f, l = 0.f, o[64];
#pragma unroll
        for (int d = 0; d < 64; ++d) o[d] = 0.f;
        for (int t = 0; t < 4; ++t) {
            if (t < 3 && t >= nsel) continue;
            const int j = (t == 0) ? s0 : (t == 1) ? s1 : (t == 2) ? s2 : nb;
            const int kend = (t == 3) ? ((s & 255) + 1) : 256;
            const int kmax = (t == 3) ? ((chk & 3) * 64 + 64) : 256;
            const size_t base = (size_t)b * SEQ + (size_t)j * 256;
#pragma unroll 1
            for (int key = 0; key < kmax; ++key) {
                const v4u* kp = (const v4u*)(Kb_ + (base + key) * 512 + h * 64);
                float d0 = 0.f;
#pragma unroll
                for (int i = 0; i < 8; ++i) { float f[8], qf[8]; unpack8(kp[i], f); unpack8(qp[i], qf);
#pragma unroll
                    for (int jj = 0; jj < 8; ++jj) d0 += qf[jj] * f[jj]; }
                const bool valid = key < kend;
                const float sc = valid ? d0 * 0.125f : -1e30f;
                if (sc > m) {
                    const float alpha = __expf(m - sc);
                    l *= alpha;
#pragma unroll
                    for (int d = 0; d < 64; ++d) o[d] *= alpha;
                    m = sc;
                }
                const float pexp = valid ? __expf(sc - m) : 0.f;
                l += pexp;
                const v4u* vp = (const v4u*)(Vb_ + (base + key) * 512 + h * 64);
#pragma unroll
                for (int i = 0; i < 8; ++i) { float f[8]; unpack8(vp[i], f);
#pragma unroll
                    for (int jj = 0; jj < 8; ++jj) o[8 * i + jj] += pexp * f[jj]; }
            }
        }
        const float il = 1.f / l;
        v4u* op = (v4u*)((bf16*)(ws + WS_O) + qrow * 512 + h * 64);
#pragma unroll
        for (int i = 0; i < 8; ++i) { float f[8];
#pragma unroll
            for (int j = 0; j < 8; ++j) f[j] = o[8 * i + j] * il;
            op[i] = pack8(f); }
    } }
    xcd_barrier(bar);

    { unsigned char* ws = WSB();
      pg8::DenseOrder S; S.init(ws + WS_Y, ws + WS_WGLU, NTOK, 2048, 512, G, bid);
      auto E = pg8::make_epi([=](const pg8::Unit& u, int r, int c8, const float (&v0)[8], const float (&v1)[8]) {
          const size_t off = (size_t)(u.pm * 256 + r) * 1024 + u.pn * 128 + c8;
          float ga[8]; unpack8(*(const v4u*)((const bf16*)(ws + WS_GA) + off), ga);
          float f[8];
#pragma unroll
          for (int j = 0; j < 8; ++j) f[j] = sigm(ga[j]) * v0[j] * sigm(v1[j]);
          *(v4u*)((bf16*)(ws + WS_MRG) + off) = pack8(f);
      });
      pg8::gemm_phase<decltype(E), pg8::DenseOrder, false>(lds, 512, S, E);
    }
    xcd_barrier(bar);

    { unsigned char* ws = WSB();
      pg8::DenseOrder S; S.init(ws + WS_O, ws + WS_WAO, NTOK, 1024, 512, G, bid);
      auto E = pg8::make_epi([=](const pg8::Unit& u, int r, int c8, const float (&v0)[8], const float (&v1)[8]) {
          const size_t off = (size_t)(u.pm * 256 + r) * 1024 + u.pn * 256 + c8;
          const bf16* GBb = (const bf16*)(ws + WS_GB); bf16* MRG = (bf16*)(ws + WS_MRG);
          float gb[8], ma[8], f[8];
          unpack8(*(const v4u*)(GBb + off), gb); unpack8(*(const v4u*)(MRG + off), ma);
#pragma unroll
          for (int j = 0; j < 8; ++j) f[j] = ma[j] + sigm(gb[j]) * v0[j];
          *(v4u*)(MRG + off) = pack8(f);
          unpack8(*(const v4u*)(GBb + off + 128), gb); unpack8(*(const v4u*)(MRG + off + 128), ma);
#pragma unroll
          for (int j = 0; j < 8; ++j) f[j] = ma[j] + sigm(gb[j]) * v1[j];
          *(v4u*)(MRG + off + 128) = pack8(f);
      });
      pg8::gemm_phase<decltype(E), pg8::DenseOrder, false>(lds, 512, S, E);
    }
    xcd_barrier(bar);

    { unsigned char* ws = WSB(); const float* x = INP(I_X);
      pg8::DenseOrder S; S.init(ws + WS_MRG, ws + WS_WOUT, NTOK, 1024, 1024, G, bid);
      auto E = pg8::make_epi([=](const pg8::Unit& u, int r, int c8, const float (&v0)[8], const float (&v1)[8]) {
          const int row = u.pm * 256 + r, b = row >> 13, col = u.pn * 256 + c8;
          const float* gt = (const float*)(ws + WS_MOD) + b * 6144 + 2048 + col;
          const float* xp = x + (size_t)row * 1024 + col; float* op = (float*)(ws + WS_X1) + (size_t)row * 1024 + col;
#pragma unroll
          for (int h = 0; h < 2; ++h) {
              const f32x4 g0 = *(const f32x4*)(gt + 128 * h), g1 = *(const f32x4*)(gt + 128 * h + 4), x0 = *(const f32x4*)(xp + 128 * h), x1 = *(const f32x4*)(xp + 128 * h + 4);
              const float (&v)[8] = h ? v1 : v0;
              f32x4 o0, o1;
              o0.x = x0.x + g0.x * v[0]; o0.y = x0.y + g0.y * v[1]; o0.z = x0.z + g0.z * v[2]; o0.w = x0.w + g0.w * v[3];
              o1.x = x1.x + g1.x * v[4]; o1.y = x1.y + g1.y * v[5]; o1.z = x1.z + g1.z * v[6]; o1.w = x1.w + g1.w * v[7];
              *(f32x4*)(op + 128 * h) = o0; *(f32x4*)(op + 128 * h + 4) = o1;
          }
      });
      pg8::gemm_phase<decltype(E), pg8::DenseOrder, false>(lds, 1024, S, E);
    }
    xcd_barrier(bar);

    {
        unsigned char* ws = WSB(); const float* X1 = (const float*)(ws + WS_X1); const float* MOD = (const float*)(ws + WS_MOD); bf16* Hb = (bf16*)(ws + WS_H);
        const float* gffn = INP(I_GFFN); const float* wrt = INP(I_WR); const float* brt = INP(I_BR);
        int* TOPI = (int*)(ws + WS_TOPI); float* TOPW = (float*)(ws + WS_TOPW); int* BLKCNT = (int*)(ws + WS_BLKCNT);
        LAS int* cnt = (LAS int*)lds;
        if (tid < 32) cnt[tid] = 0;
        __syncthreads();
        const int tpb = NTOK / G;
        for (int tl = wave; tl < tpb; tl += NWAVES) {
            const int m = bid * tpb + tl, b = m >> 13;
            const f32x4* xr = (const f32x4*)(X1 + (size_t)m * DM) + lane;
            float s = 0.f;
#pragma unroll
            for (int j = 0; j < 4; ++j) { const f32x4 t = xr[64 * j]; s += (t.x * t.x + t.y * t.y) + (t.z * t.z + t.w * t.w); }
            const float r = rsqrtf(wave_sum(s) * (1.f / DM) + RMS_EPS);
            float lg[32];
#pragma unroll
            for (int e = 0; e < 32; ++e) lg[e] = 0.f;
            v2u* o8 = (v2u*)(Hb + (size_t)m * DM) + lane;
#pragma unroll 1
            for (int j = 0; j < 4; ++j) {
                const int col = 4 * lane + 256 * j;
                const f32x4 t = xr[64 * j];
                const f32x4 g = *(const f32x4*)(gffn + col);
                const f32x4 sh = *(const f32x4*)(MOD + b * 6144 + 3072 + col), sc = *(const f32x4*)(MOD + b * 6144 + 4096 + col);
                float hv[4];
                hv[0] = t.x * r * g.x * (1.f + sc.x) + sh.x; hv[1] = t.y * r * g.y * (1.f + sc.y) + sh.y;
                hv[2] = t.z * r * g.z * (1.f + sc.z) + sh.z; hv[3] = t.w * r * g.w * (1.f + sc.w) + sh.w;
                v2u w; w.x = pk2(hv[0], hv[1]); w.y = pk2(hv[2], hv[3]); o8[64 * j] = w;
                const f32x4* wr = (const f32x4*)(wrt + (size_t)col * 32);
#pragma unroll
                for (int i = 0; i < 4; ++i) {
#pragma unroll
                    for (int e4 = 0; e4 < 8; ++e4) { const f32x4 w4 = wr[i * 8 + e4]; lg[4 * e4] += hv[i] * w4.x; lg[4 * e4 + 1] += hv[i] * w4.y; lg[4 * e4 + 2] += hv[i] * w4.z; lg[4 * e4 + 3] += hv[i] * w4.w; }
                }
            }
            float a16[16], a8[8], a4[4], a2[2], a1;
            { const bool hi = (lane & 32) != 0;
#pragma unroll
              for (int i = 0; i < 16; ++i) { const float keep = hi ? lg[i + 16] : lg[i], send = hi ? lg[i] : lg[i + 16]; a16[i] = keep + __shfl_xor(send, 32); } }
            { const bool hi = (lane & 16) != 0;
#pragma unroll
              for (int i = 0; i < 8; ++i) { const float keep = hi ? a16[i + 8] : a16[i], send = hi ? a16[i] : a16[i + 8]; a8[i] = keep + __shfl_xor(send, 16); } }
            { const bool hi = (lane & 8) != 0;
#pragma unroll
              for (int i = 0; i < 4; ++i) { const float keep = hi ? a8[i + 4] : a8[i], send = hi ? a8[i] : a8[i + 4]; a4[i] = keep + __shfl_xor(send, 8); } }
            { const bool hi = (lane & 4) != 0;
#pragma unroll
              for (int i = 0; i < 2; ++i) { const float keep = hi ? a4[i + 2] : a4[i], send = hi ? a4[i] : a4[i + 2]; a2[i] = keep + __shfl_xor(send, 4); } }
            { const bool hi = (lane & 2) != 0; const float keep = hi ? a2[1] : a2[0], send = hi ? a2[0] : a2[1]; a1 = keep + __shfl_xor(send, 2); }
            a1 += __shfl_xor(a1, 1);
            const int e_me = lane >> 1;
            float val = a1 + brt[e_me];
            float tv[4]; int ti[4];
#pragma unroll
            for (int k = 0; k < 4; ++k) {
                float bv = val; int bi = e_me;
#pragma unroll
                for (int o = 1; o < 64; o <<= 1) { const float ov = __shfl_xor(bv, o); const int oi = __shfl_xor(bi, o); if (ov > bv || (ov == bv && oi < bi)) { bv = ov; bi = oi; } }
                tv[k] = bv; ti[k] = bi;
                if (e_me == bi) val = -INFINITY;
            }
            const float e0 = 1.f, e1 = __expf(tv[1] - tv[0]), e2 = __expf(tv[2] - tv[0]), e3 = __expf(tv[3] - tv[0]);
            const float inv = 1.f / (e0 + e1 + e2 + e3);
            if (lane == 0) {
                TOPI[m * 4 + 0] = ti[0]; TOPI[m * 4 + 1] = ti[1]; TOPI[m * 4 + 2] = ti[2]; TOPI[m * 4 + 3] = ti[3];
                TOPW[m * 4 + 0] = e0 * inv; TOPW[m * 4 + 1] = e1 * inv; TOPW[m * 4 + 2] = e2 * inv; TOPW[m * 4 + 3] = e3 * inv;
                atomicAdd((int*)&cnt[ti[0]], 1); atomicAdd((int*)&cnt[ti[1]], 1); atomicAdd((int*)&cnt[ti[2]], 1); atomicAdd((int*)&cnt[ti[3]], 1);
            }
        }
        __syncthreads();
        if (tid < 32) BLKCNT[bid * 32 + tid] = cnt[tid];
    }
    xcd_barrier(bar);

    {
        unsigned char* ws = WSB(); const int* TOPI = (const int*)(ws + WS_TOPI); const float* TOPW = (const float*)(ws + WS_TOPW); const int* BLKCNT = (const int*)(ws + WS_BLKCNT);
        int* ROWTOK = (int*)(ws + WS_ROWTOK); float* ROWW = (float*)(ws + WS_ROWW); int* TILEE = (int*)(ws + WS_TILEE);
        LAS int* tot = (LAS int*)lds;
        LAS int* mine = tot + 32;
        LAS int* pst = mine + 32;
        LAS int* ent = pst + 64;
        const int tpb = NTOK / G;
        if (tid < 32) {
            int t = 0, mn = 0;
            for (int k = 0; k < G; ++k) { const int c = BLKCNT[k * 32 + tid]; t += c; if (k < bid) mn += c; }
            tot[tid] = t; mine[tid] = mn;
        }
        for (int i = tid; i < tpb * 4; i += NTHR) ent[i] = TOPI[bid * tpb * 4 + i];
        __syncthreads();
        if (tid == 0) { int a = 0; for (int e = 0; e < 32; ++e) { pst[e] = a; a += (tot[e] + 255) & ~255; } pst[32] = a; }
        __syncthreads();
        for (int i = tid; i < tpb * 4; i += NTHR) {
            const int e = ent[i]; int rank = 0;
            for (int k = 0; k < i; ++k) rank += (ent[k] == e) ? 1 : 0;
            const int pos = pst[e] + mine[e] + rank;
            ROWTOK[pos] = (bid * tpb + (i >> 2)) * 4 + (i & 3);
            ROWW[pos] = TOPW[bid * tpb * 4 + i];
        }
        if (bid < 32) { const int e = bid; for (int pos = pst[e] + tot[e] + tid; pos < pst[e + 1]; pos += NTHR) { ROWTOK[pos] = -1; ROWW[pos] = 0.f; } }
        if (bid == 32 % G) {
            const int nt = pst[32] >> 8;
            for (int t = tid; t < nt; t += NTHR) { int e = 0; for (int k = 0; k < 32; ++k) if ((t << 8) >= pst[k]) e = k; TILEE[t] = e; }
            if (tid == 0) TILEE[1023] = nt;
        }
    }
    xcd_barrier(bar);

    { unsigned char* ws = WSB(); const float* bgu = INP(I_BGU);
      MoeOrder S; S.init(ws + WS_H, ws + WS_WGU, (const int*)(ws + WS_TILEE), (const int*)(ws + WS_ROWTOK), 8, (size_t)2048 * 1024 * 2, 1024, G, bid, true);
      auto E = pg8::make_epi([=](const pg8::Unit& u, int r, int c8, const float (&v0)[8], const float (&v1)[8]) {
          const int col = u.pn * 128 + c8; float f[8];
          const float* bg = bgu + (size_t)u.e * 2048 + col;
          const f32x4 bg0 = *(const f32x4*)bg, bg1 = *(const f32x4*)(bg + 4), bu0 = *(const f32x4*)(bg + 1024), bu1 = *(const f32x4*)(bg + 1028);
          const float bgv[8] = {bg0.x, bg0.y, bg0.z, bg0.w, bg1.x, bg1.y, bg1.z, bg1.w}, buv[8] = {bu0.x, bu0.y, bu0.z, bu0.w, bu1.x, bu1.y, bu1.z, bu1.w};
#pragma unroll
          for (int j = 0; j < 8; ++j) {
              const float gt = fminf(v0[j] + bgv[j], 7.f);
              const float up = fminf(fmaxf(v1[j] + buv[j], -7.f), 7.f);
              f[j] = (up + 1.f) * gt * sigm(1.702f * gt);
          }
          *(v4u*)((bf16*)(ws + WS_ACT) + (size_t)(u.pm * 256 + r) * 1024 + col) = pack8(f);
      });
      pg8::gemm_phase<decltype(E), MoeOrder, true>(lds, 1024, S, E);
    }
    xcd_barrier(bar);

    { unsigned char* ws = WSB(); const float* bdn = INP(I_BD);
      MoeOrder S; S.init(ws + WS_ACT, ws + WS_WD, (const int*)(ws + WS_TILEE), (const int*)(ws + WS_ROWTOK), 4, (size_t)1024 * 1024 * 2, 1024, G, bid, false);
      auto E = pg8::make_epi([=](const pg8::Unit& u, int r, int c8, const float (&v0)[8], const float (&v1)[8]) {
          const int srow = u.pm * 256 + r;
          const int rt = ((const int*)(ws + WS_ROWTOK))[srow];
          if (rt >= 0) {
              const float w = ((const float*)(ws + WS_ROWW))[srow]; const int col = u.pn * 256 + c8; float f[8];
              const float* bd = bdn + (size_t)u.e * 1024 + col;
              bf16* yp = (bf16*)(ws + WS_YS) + (size_t)rt * 1024 + col;
#pragma unroll
              for (int j = 0; j < 8; ++j) f[j] = (v0[j] + bd[j]) * w;
              *(v4u*)yp = pack8(f);
#pragma unroll
              for (int j = 0; j < 8; ++j) f[j] = (v1[j] + bd[128 + j]) * w;
              *(v4u*)(yp + 128) = pack8(f);
          }
      });
      pg8::gemm_phase<decltype(E), MoeOrder, false>(lds, 1024, S, E);
    }
    xcd_barrier(bar);

    { unsigned char* ws = WSB(); const float* X1 = (const float*)(ws + WS_X1); const float* MOD = (const float*)(ws + WS_MOD); const bf16* YS = (const bf16*)(ws + WS_YS); const float* gfin = INP(I_GFIN); float* outp = (float*)ldptr(lds, 25);
    for (int m = gw; m < NTOK; m += NGW) {
        const int b = m >> 13;
        const f32x4* xr = (const f32x4*)(X1 + (size_t)m * DM) + lane;
        f32x4 v[4]; float s = 0.f;
#pragma unroll
        for (int j = 0; j < 4; ++j) {
            const int col = 4 * lane + 256 * j;
            f32x4 a = (f32x4){0.f, 0.f, 0.f, 0.f};
#pragma unroll
            for (int sl = 0; sl < 4; ++sl) { const v2u w = *(const v2u*)(YS + ((size_t)m * 4 + sl) * 1024 + col); a.x += lo16(w.x); a.y += hi16(w.x); a.z += lo16(w.y); a.w += hi16(w.y); }
            const f32x4 gt = *(const f32x4*)(MOD + b * 6144 + 5120 + col);
            v[j] = xr[64 * j] + gt * a;
            s += (v[j].x * v[j].x + v[j].y * v[j].y) + (v[j].z * v[j].z + v[j].w * v[j].w);
        }
        const float r = rsqrtf(wave_sum(s) * (1.f / DM) + RMS_EPS);
        f32x4* op = (f32x4*)(outp + (size_t)m * DM) + lane;
#pragma unroll
        for (int j = 0; j < 4; ++j) { const f32x4 g = *(const f32x4*)(gfin + 4 * lane + 256 * j); op[64 * j] = v[j] * r * g; }
    } }
}

extern "C" void kernel_launch(void* const* d_in, const int* in_sizes, int n_in, void* d_out, int out_size, void* d_ws, size_t ws_size, hipStream_t stream) {
    static int grid = 0;
    if (grid == 0) {
        if (n_in != 25 || in_sizes[0] != NTOK * DM || out_size != NTOK * DM || ws_size < WS_END) {
            fprintf(stderr, "kernel_launch: unexpected shapes (n_in %d, in0 %d, out %d, ws %zu); nothing launched\n", n_in, n_in > 0 ? in_sizes[0] : -1, out_size, ws_size); grid = -1; return; }
        int dev = 0, cus = 0, per_cu = 0;
        if (hipGetDevice(&dev) != hipSuccess || hipDeviceGetAttribute(&cus, hipDeviceAttributeMultiprocessorCount, dev) != hipSuccess) { grid = -1; return; }
        if (hipFuncSetAttribute((const void*)mega_fwd, hipFuncAttributeMaxDynamicSharedMemorySize, LDS_BYTES) != hipSuccess) { fprintf(stderr, "kernel_launch: hipFuncSetAttribute failed\n"); grid = -1; return; }
        if (hipOccupancyMaxActiveBlocksPerMultiprocessor(&per_cu, (const void*)mega_fwd, NTHR, LDS_BYTES) != hipSuccess || per_cu < 1) {
            fprintf(stderr, "kernel_launch: occupancy query reports %d blocks per CU\n", per_cu); (void)hipGetLastError(); grid = -1; return; }
        grid = cus;
        if (NTOK % grid != 0) { fprintf(stderr, "kernel_launch: grid %d does not divide the token count\n", grid); grid = -1; return; }
    }
    if (grid < 0) return;
    (void)hipMemsetAsync((char*)d_ws + WS_CTL, 0, CTL_ZERO_BYTES, stream);
    Params p{};
    for (int i = 0; i < 25; ++i) p.in[i] = (const float*)d_in[i];
    p.out = (float*)d_out; p.ws = (unsigned char*)d_ws;
    hipLaunchKernelGGL(mega_fwd, dim3(grid), dim3(NTHR), LDS_BYTES, stream, p);
}
```

```cpp
#include <hip/hip_runtime.h>
#include <cstdio>
#include <cstdint>

#define GAS __attribute__((address_space(1)))
#define LAS __attribute__((address_space(3)))
typedef unsigned short bf16;
typedef unsigned v4u __attribute__((ext_vector_type(4)));
typedef unsigned v2u __attribute__((ext_vector_type(2)));
typedef float f32x4 __attribute__((ext_vector_type(4)));

constexpr int BATCH = 4, SEQ = 8192, DM = 1024, NTOK = BATCH * SEQ, INW = 4096;
constexpr int NH = 8, HD = 64, AW = 512, SW = 512, NG = 32, NP = 64, NC = 16;
constexpr int NE = 32, TOPK = 4, DFF = 1024, MAXTILES = 544, MAXROWS = MAXTILES * 256;
constexpr int NWAVES = 8, NTHR = 512;
constexpr float RMS_EPS = 1e-5f;

constexpr size_t MiB = 1u << 20;
constexpr size_t WS_CTL = 0, CTL_ZERO_BYTES = 64 * 1024;
constexpr size_t WS_MOD = 1 * MiB;
constexpr size_t WS_ROT = 2 * MiB;
constexpr size_t WS_KMEAN = 3 * MiB;
constexpr size_t WS_TOPI = 4 * MiB;
constexpr size_t WS_TOPW = 5 * MiB;
constexpr size_t WS_BLKCNT = 6 * MiB;
constexpr size_t WS_ROWTOK = 7 * MiB;
constexpr size_t WS_ROWW = 8 * MiB;
constexpr size_t WS_TILEE = 9 * MiB;
constexpr size_t WS_WIN = 16 * MiB, WS_WGLU = 24 * MiB, WS_WAO = 26 * MiB, WS_WOUT = 27 * MiB, WS_WGU = 32 * MiB, WS_WD = 160 * MiB;
constexpr size_t WS_X1 = 224 * MiB;
constexpr size_t WS_U = 352 * MiB, WS_Q = 384 * MiB, WS_K = 416 * MiB, WS_V = 448 * MiB, WS_GA = 480 * MiB, WS_GB = 544 * MiB, WS_O = 608 * MiB, WS_Y = 640 * MiB;
constexpr size_t WS_ACT = 352 * MiB;
constexpr size_t WS_H = 672 * MiB;
constexpr size_t WS_MRG = 736 * MiB;
constexpr size_t WS_YS = 672 * MiB;
constexpr size_t WS_S5T = 928 * MiB;
constexpr size_t WS_S5W = 952 * MiB;
constexpr size_t WS_XE = 960 * MiB;
constexpr size_t WS_UG = 976 * MiB;
constexpr size_t WS_END = 1016 * MiB;

constexpr int LDS_BYTES = 147456;
constexpr int LDS_MISC = 147456 - 512;
constexpr int LDS_PAR = 147456 - 1024;

__device__ __forceinline__ float bf2f(bf16 v) { return __builtin_bit_cast(float, (unsigned)v << 16); }
__device__ __forceinline__ unsigned f2bf(float f) { unsigned u = __builtin_bit_cast(unsigned, f); return (u + 0x7fffu + ((u >> 16) & 1u)) >> 16; }
__device__ __forceinline__ unsigned pk2(float lo, float hi) { return f2bf(lo) | (f2bf(hi) << 16); }
__device__ __forceinline__ float lo16(unsigned w) { return __builtin_bit_cast(float, w << 16); }
__device__ __forceinline__ float hi16(unsigned w) { return __builtin_bit_cast(float, w & 0xffff0000u); }
__device__ __forceinline__ float sigm(float x) { return 1.f / (1.f + __expf(-x)); }
__device__ __forceinline__ float wave_sum(float v) {
#pragma unroll
    for (int o = 1; o < 64; o <<= 1) v += __shfl_xor(v, o);
    return v;
}
__device__ __forceinline__ void unpack8(v4u w, float (&f)[8]) {
    f[0] = lo16(w.x); f[1] = hi16(w.x); f[2] = lo16(w.y); f[3] = hi16(w.y); f[4] = lo16(w.z); f[5] = hi16(w.z); f[6] = lo16(w.w); f[7] = hi16(w.w);
}
__device__ __forceinline__ v4u pack8(const float (&f)[8]) { v4u w; w.x = pk2(f[0], f[1]); w.y = pk2(f[2], f[3]); w.z = pk2(f[4], f[5]); w.w = pk2(f[6], f[7]); return w; }

#define XB_TMO      128
#define XB_XCNT(j)  (256  + 64 * (j))
#define XB_XSUB(j)  (1280 + 64 * (j))
#define XB_XGEN(j)  (2304 + 64 * (j))
#define XB_TOP      3328
#define XB_TOPGEN   3392
#define XCD_BAR_WORDS 3456
#define XB_SPIN_CAP (1u << 25)
__device__ __forceinline__ unsigned xb_ld(unsigned* p)              { return __hip_atomic_load(p, __ATOMIC_RELAXED, __HIP_MEMORY_SCOPE_AGENT); }
__device__ __forceinline__ unsigned xb_add(unsigned* p, unsigned v) { return __hip_atomic_fetch_add(p, v, __ATOMIC_RELAXED, __HIP_MEMORY_SCOPE_AGENT); }
__device__ __forceinline__ unsigned xb_xcc_id() { return (unsigned)__builtin_amdgcn_s_getreg((3 << 11) | 20) & 0xFu; }
#define XB_SPIN(cond, bar) do { unsigned _sp = 0; while (cond) { __builtin_amdgcn_s_sleep(1); \
    if ((++_sp & 255u) == 0u) { if (xb_ld(&(bar)[XB_TMO])) break; if (_sp > XB_SPIN_CAP) { atomicAdd(&(bar)[XB_TMO], 1u); break; } } } } while (0)
struct XcdBarrier { unsigned* bar; unsigned x; volatile LAS unsigned* st; };
__device__ __forceinline__ XcdBarrier xcd_barrier_post(unsigned* bar, volatile LAS unsigned* st) {
    XcdBarrier b; b.bar = bar; b.x = xb_xcc_id(); b.st = st;
    if (threadIdx.x == 0) (void)xb_add(&bar[XB_XCNT(b.x)], 1u);
    return b;
}
__device__ __forceinline__ void xcd_barrier_complete(unsigned* bar, unsigned x, unsigned& nloc, unsigned& nx) {
    const unsigned G = gridDim.x * gridDim.y * gridDim.z;
    unsigned sum, cnt, mine, sp = 0u;
    for (;;) {
        sum = 0u; cnt = 0u; mine = 0u;
#pragma unroll
        for (unsigned j = 0; j < 16; ++j) { const unsigned c = xb_ld(&bar[XB_XCNT(j)]); sum += c; cnt += (c > 0u) ? 1u : 0u; mine = (j == x) ? c : mine; }
        if (sum == G) break;
        __builtin_amdgcn_s_sleep(1);
        if ((++sp & 255u) == 0u) { if (xb_ld(&bar[XB_TMO])) break; if (sp > XB_SPIN_CAP) { atomicAdd(&bar[XB_TMO], 1u); break; } }
    }
    nloc = mine > 0u ? mine : 1u; nx = cnt > 0u ? cnt : 1u;
}
__device__ __forceinline__ void xcd_barrier(const XcdBarrier& b) {
    asm volatile("s_waitcnt vmcnt(0)" ::: "memory");
    __syncthreads();
    if (threadIdx.x == 0) {
        unsigned* bar = b.bar;
        __builtin_amdgcn_s_waitcnt(0);
        unsigned nloc = b.st[0], nx = b.st[1];
        if (nloc == 0u) { xcd_barrier_complete(bar, b.x, nloc, nx); b.st[0] = nloc; b.st[1] = nx; }
        const unsigned old = xb_add(&bar[XB_XSUB(b.x)], 1u);
        const unsigned gen = old / nloc;
        if (old + 1u == (gen + 1u) * nloc) {
            __builtin_amdgcn_fence(__ATOMIC_RELEASE, "agent");
            asm volatile("s_waitcnt vmcnt(0)" ::: "memory");
            const unsigned og = xb_add(&bar[XB_TOP], 1u);
            const unsigned tg = og / nx;
            if (og + 1u == (tg + 1u) * nx) xb_add(&bar[XB_TOPGEN], 1u);
            else XB_SPIN(xb_ld(&bar[XB_TOPGEN]) == tg, bar);
            __builtin_amdgcn_fence(__ATOMIC_ACQUIRE, "agent");
            xb_add(&bar[XB_XGEN(b.x)], 1u);
            asm volatile("s_waitcnt vmcnt(0)" ::: "memory");
        } else {
            XB_SPIN(xb_ld(&bar[XB_XGEN(b.x)]) == gen, bar);
            __builtin_amdgcn_fence(__ATOMIC_ACQUIRE, "agent");
            asm volatile("s_waitcnt vmcnt(0)" ::: "memory");
        }
    }
    __syncthreads();
}

struct Params { const float* in[25]; float* out; unsigned char* ws; };
enum { I_X = 0, I_C, I_WADA, I_BADA, I_GMIX, I_WIN, I_ARE, I_AIM, I_LOGDT, I_BRE, I_BIM, I_CRE, I_CIM, I_SD, I_WGLU, I_WAO, I_WOUT, I_GFFN, I_WR, I_BR, I_WGU, I_BGU, I_WD, I_BD, I_GFIN };

__device__ __forceinline__ int ilv(int n) { return n < 1024 ? ((n >> 7) * 256 + (n & 127)) : (((n - 1024) >> 7) * 256 + 128 + ((n - 1024) & 127)); }

__device__ __forceinline__ void transpose_item(const float* W, int K, int N, bf16* WT, bool interleave, LAS float* scr, int item, int lane) {
    const int nblk = N / 32, kb = item / nblk, nb = item % nblk, k0 = 64 * kb, n0 = 32 * nb;
#pragma unroll 8
    for (int i = 0; i < 32; ++i) { const int kk = 2 * i + (lane >> 5); scr[kk * 33 + (lane & 31)] = W[(size_t)(k0 + kk) * N + n0 + (lane & 31)]; }
    asm volatile("s_waitcnt lgkmcnt(0)" ::: "memory");
    const int c = lane & 7;
    const int r0 = interleave ? ilv(n0) : n0;
#pragma unroll
    for (int j = 0; j < 4; ++j) { const int n = (lane >> 3) + 8 * j; const LAS float* s = scr + (8 * c) * 33 + n;
        v4u o; o.x = pk2(s[0 * 33], s[1 * 33]); o.y = pk2(s[2 * 33], s[3 * 33]); o.z = pk2(s[4 * 33], s[5 * 33]); o.w = pk2(s[6 * 33], s[7 * 33]);
        *(v4u*)(WT + (size_t)(r0 + n) * K + k0 + 8 * c) = o; }
    asm volatile("s_waitcnt lgkmcnt(0)" ::: "memory");
}

template <class AP, class BP, class Epi>
__device__ __forceinline__ void ngemm_unit(LAS unsigned char* lds, int K, AP ap, BP bp, Epi epi) {
    LAS float* As = (LAS float*)lds;
    LAS float* Bs = As + 32 * 65;
    LAS float* Cs = Bs + 32 * 257;
    const int tid = threadIdx.x, rp = tid >> 4, cg = tid & 15;
    float acc[2][16];
#pragma unroll
    for (int i = 0; i < 2; ++i)
#pragma unroll
        for (int j = 0; j < 16; ++j) acc[i][j] = 0.f;
    const int arow = tid >> 3, akq = (tid & 7) * 4;
    const int bn = tid >> 1, bkh = (tid & 1) * 16;
    const bf16* aptr = ap(arow) + akq;
    const bf16* bptr = bp(bn) + bkh;
    for (int k0 = 0; k0 < K; k0 += 32) {
        const v2u av = *(const v2u*)(aptr + k0);
        const v4u bv0 = *(const v4u*)(bptr + k0), bv1 = *(const v4u*)(bptr + k0 + 8);
        __syncthreads();
        As[(akq + 0) * 65 + arow] = lo16(av.x); As[(akq + 1) * 65 + arow] = hi16(av.x); As[(akq + 2) * 65 + arow] = lo16(av.y); As[(akq + 3) * 65 + arow] = hi16(av.y);
        { float f[8]; unpack8(bv0, f);
#pragma unroll
          for (int i = 0; i < 8; ++i) Bs[(bkh + i) * 257 + bn] = f[i];
          unpack8(bv1, f);
#pragma unroll
          for (int i = 0; i < 8; ++i) Bs[(bkh + 8 + i) * 257 + bn] = f[i]; }
        __syncthreads();
#pragma unroll 4
        for (int kk = 0; kk < 32; ++kk) {
            const float a0 = As[kk * 65 + 2 * rp], a1 = As[kk * 65 + 2 * rp + 1];
#pragma unroll
            for (int j = 0; j < 16; ++j) { const float b = Bs[kk * 257 + cg + 16 * j]; acc[0][j] += a0 * b; acc[1][j] += a1 * b; }
        }
    }
#pragma unroll
    for (int i = 0; i < 2; ++i)
#pragma unroll
        for (int j = 0; j < 16; ++j) Cs[(2 * rp + i) * 257 + cg + 16 * j] = acc[i][j];
    __syncthreads();
#pragma unroll
    for (int i = 0; i < 2; ++i) {
        float v0[8], v1[8];
#pragma unroll
        for (int j = 0; j < 8; ++j) { v0[j] = Cs[(2 * rp + i) * 257 + 8 * cg + j]; v1[j] = Cs[(2 * rp + i) * 257 + 128 + 8 * cg + j]; }
        epi(2 * rp + i, 8 * cg, v0, v1);
    }
    __syncthreads();
}


namespace pg8 {
typedef short bf16x8 __attribute__((ext_vector_type(8)));
constexpr int BM = 256, BK = 64, HALF = 128, HTB = HALF * BK * 2, STAGE_BYTES = 8 * HTB, NXCD = 8, WGM = 8;
__host__ __device__ __forceinline__ int lds_byte(int r, int c) { const int st = (r >> 4) * 2 + (c >> 5), rr = r & 15, cc = c & 31, ob = rr * 64 + cc * 2; return st * 1024 + (ob ^ (((ob >> 9) & 1) << 5)); }
__host__ __device__ __forceinline__ void stage_rc(int b, int& R, int& C) { const int st = b / 1024, sb = b % 1024, swz = sb ^ (((sb >> 9) & 1) << 5); R = (st >> 1) * 16 + swz / 64; C = (st & 1) * 32 + (swz % 64) / 2; }
__host__ __device__ __forceinline__ int perm32(int rho) { const int n = rho >> 4, i = rho & 15; return 8 * (i >> 2) + 4 * n + (i & 3); }
struct Unit { int pm, pn, e, pad; const char* A; const char* B; };

struct DenseOrder {
    const char* A; const char* Bt; int nM, nN, nwg, G, c; size_t tstep;
    __device__ __forceinline__ void init(const void* A_, const void* Bt_, int M, int N, int K, int G_, int c_) { A = (const char*)A_; Bt = (const char*)Bt_; nM = M / BM; nN = N / BM; nwg = nM * nN; G = G_; c = c_; tstep = (size_t)BM * K * 2; }
    __device__ __forceinline__ bool next(int i, Unit& u) const {
        const long L = (long)i * G + c; if (L >= nwg) return false;
        int wgid = (int)L; { const int q = nwg / NXCD, r = nwg % NXCD, xcd = wgid % NXCD, off = wgid / NXCD; wgid = (xcd < r ? xcd * (q + 1) : r * (q + 1) + (xcd - r) * q) + off; }
        const int nig = WGM * nN, gid = wgid / nig, fm = gid * WGM, gsz = (nM - fm) < WGM ? (nM - fm) : WGM;
        u.pm = fm + ((wgid % nig) % gsz); u.pn = (wgid % nig) / gsz; u.e = 0; u.A = A + (size_t)u.pm * tstep; u.B = Bt + (size_t)u.pn * tstep; return true;
    }
    __device__ __forceinline__ unsigned rowoff(const Unit&, int) const { return 0u; }
};

template <class Epi, class Sched, bool GATHER>
__device__ __forceinline__ void gemm_phase(LAS unsigned char* lds, const int K, const Sched& S, const Epi& E, const int lda_ = 0) {
    int tid = threadIdx.x; asm volatile("" : "+v"(tid));
    const int wid = __builtin_amdgcn_readfirstlane(tid >> 6), lane = tid & 63, wr = wid >> 2, wc = wid & 3, fr = lane & 15, fq = lane >> 4;
    const int nt = K / BK, lda = lda_ ? lda_ : K;
    int sR[2], sC[2];
    unsigned voffA[2][2], nvoffA[2][2], voffB[2];
#pragma unroll
    for (int i = 0; i < 2; ++i) { int R, C; stage_rc(tid * 16 + i * 8192, R, C); sR[i] = R; sC[i] = C; const int Rb = (R & ~31) + perm32(R & 31);
        voffA[0][i] = (unsigned)(R * lda + C) * 2u; voffA[1][i] = (unsigned)((R + HALF) * lda + C) * 2u; voffB[i] = (unsigned)(Rb * K + C) * 2u;
        nvoffA[0][i] = voffA[0][i]; nvoffA[1][i] = voffA[1][i]; }
    const size_t kstep = (size_t)(BK * 2);
    const size_t hstep = (size_t)HALF * K * 2;
    const unsigned ldsw = (unsigned)wid * 1024u;
    const int aoff = lds_byte(wr * 64 + fr, fq * 8), boff = lds_byte(wc * 32 + fr, fq * 8);
#define PG8_SA(b, h) (((b) * 2 + (h)) * HTB)
#define PG8_SB(b, h) ((4 + (b) * 2 + (h)) * HTB)
#define PG8_STAGE(bufoff, gbase, v0, v1) do { \
        __builtin_amdgcn_global_load_lds((const unsigned*)((const char*)(gbase) + (v0)), (LAS unsigned*)(lds + (bufoff) + ldsw), 16, 0, 0); \
        __builtin_amdgcn_global_load_lds((const unsigned*)((const char*)(gbase) + (v1)), (LAS unsigned*)(lds + (bufoff) + ldsw + 8192), 16, 0, 0); } while (0)
#define PG8_LDA(dst, b, h) do { _Pragma("unroll") for (int m = 0; m < 4; ++m) _Pragma("unroll") for (int k = 0; k < 2; ++k) dst[m][k] = *(const LAS bf16x8*)(lds + PG8_SA(b, h) + aoff + m * 2048 + k * 1024); } while (0)
#define PG8_LDB(dst, b, h) do { _Pragma("unroll") for (int n = 0; n < 2; ++n) _Pragma("unroll") for (int k = 0; k < 2; ++k) dst[n][k] = *(const LAS bf16x8*)(lds + PG8_SB(b, h) + boff + n * 2048 + k * 1024); } while (0)
#define PG8_MMA(ai, bj, At, Bt) do { __builtin_amdgcn_s_setprio(1); _Pragma("unroll") for (int m = 0; m < 4; ++m) _Pragma("unroll") for (int n = 0; n < 2; ++n) _Pragma("unroll") for (int k = 0; k < 2; ++k) \
        acc[ai][bj][m][n] = __builtin_amdgcn_mfma_f32_16x16x32_bf16(Bt[n][k], At[m][k], acc[ai][bj][m][n], 0, 0, 0); __builtin_amdgcn_s_setprio(0); } while (0)
#define PG8_WAIT_V(n) asm volatile("s_waitcnt vmcnt(" #n ")" ::: "memory")
#define PG8_WAIT_L(n) asm volatile("s_waitcnt lgkmcnt(" #n ")" ::: "memory")
#define PG8_BAR __builtin_amdgcn_s_barrier()
#define PG8_SCHED __builtin_amdgcn_sched_barrier(0)
    Unit cur, nxt; int ui = 0;
    if (!S.next(0, cur)) return;
    if constexpr (GATHER) {
#pragma unroll
        for (int h = 0; h < 2; ++h)
#pragma unroll
            for (int i = 0; i < 2; ++i) voffA[h][i] = S.rowoff(cur, h * HALF + sR[i]) + (unsigned)sC[i] * 2u;
    }
    f32x4 acc[2][2][4][2];
#pragma unroll
    for (int a = 0; a < 2; ++a)
#pragma unroll
        for (int b = 0; b < 2; ++b)
#pragma unroll
            for (int m = 0; m < 4; ++m)
#pragma unroll
                for (int n = 0; n < 2; ++n) acc[a][b][m][n] = (f32x4){0.f, 0.f, 0.f, 0.f};
    bf16x8 At[4][2], B0[2][2], B1[2][2];
    const char* cA = cur.A; const char* cB = cur.B;
    PG8_STAGE(PG8_SB(0, 0), cB, voffB[0], voffB[1]); PG8_STAGE(PG8_SB(0, 1), cB + hstep, voffB[0], voffB[1]); PG8_STAGE(PG8_SA(0, 0), cA, voffA[0][0], voffA[0][1]); PG8_STAGE(PG8_SA(0, 1), cA, voffA[1][0], voffA[1][1]);
    if (wr == 1) PG8_BAR;
    PG8_WAIT_V(2); PG8_BAR;
    PG8_STAGE(PG8_SB(1, 0), cB + kstep, voffB[0], voffB[1]); PG8_STAGE(PG8_SA(1, 0), cA + kstep, voffA[0][0], voffA[0][1]); PG8_STAGE(PG8_SB(1, 1), cB + hstep + kstep, voffB[0], voffB[1]);
    PG8_WAIT_V(6); PG8_BAR;
    for (;;) {
        const bool has_next = S.next(ui + 1, nxt);
        const char* nA = has_next ? nxt.A : cA; const char* nB = has_next ? nxt.B : cB;
        if constexpr (GATHER) {
            if (has_next) {
#pragma unroll
                for (int h = 0; h < 2; ++h)
#pragma unroll
                    for (int i = 0; i < 2; ++i) nvoffA[h][i] = S.rowoff(nxt, h * HALF + sR[i]) + (unsigned)sC[i] * 2u;
            } else {
#pragma unroll
                for (int h = 0; h < 2; ++h)
#pragma unroll
                    for (int i = 0; i < 2; ++i) nvoffA[h][i] = voffA[h][i];
            }
        }
        for (int t = 0; t < nt; t += 2) {
            const bool last = (t == nt - 2);
            const char* a1 = cA + (size_t)(t + 1) * kstep;
            const char* a2 = last ? nA : cA + (size_t)(t + 2) * kstep; const char* b2 = last ? nB : cB + (size_t)(t + 2) * kstep;
            const char* a3 = a2 + kstep; const char* b3 = b2 + kstep;
            unsigned w00, w01, w10, w11;
            if constexpr (GATHER) { w00 = last ? nvoffA[0][0] : voffA[0][0]; w01 = last ? nvoffA[0][1] : voffA[0][1]; w10 = last ? nvoffA[1][0] : voffA[1][0]; w11 = last ? nvoffA[1][1] : voffA[1][1]; }
            else { w00 = voffA[0][0]; w01 = voffA[0][1]; w10 = voffA[1][0]; w11 = voffA[1][1]; }
            PG8_LDB(B0, 0, 0); PG8_LDB(B1, 0, 1); PG8_SCHED; PG8_LDA(At, 0, 0); PG8_STAGE(PG8_SA(1, 1), a1, voffA[1][0], voffA[1][1]);
            PG8_WAIT_V(8); PG8_WAIT_L(0); PG8_BAR; PG8_MMA(0, 0, At, B0); PG8_MMA(0, 1, At, B1); PG8_BAR; PG8_SCHED;
            PG8_LDA(At, 0, 1); PG8_STAGE(PG8_SB(0, 0), b2, voffB[0], voffB[1]); PG8_STAGE(PG8_SB(0, 1), b2 + hstep, voffB[0], voffB[1]); PG8_STAGE(PG8_SA(0, 0), a2, w00, w01);
            PG8_WAIT_V(8); PG8_WAIT_L(0); PG8_BAR; PG8_MMA(1, 0, At, B0); PG8_MMA(1, 1, At, B1); PG8_BAR; PG8_SCHED;
            PG8_LDB(B0, 1, 0); PG8_LDB(B1, 1, 1); PG8_SCHED; PG8_LDA(At, 1, 0); PG8_STAGE(PG8_SA(0, 1), a2, w10, w11);
            PG8_WAIT_V(8); PG8_WAIT_L(0); PG8_BAR; PG8_MMA(0, 0, At, B0); PG8_MMA(0, 1, At, B1); PG8_BAR; PG8_SCHED;
            PG8_LDA(At, 1, 1); PG8_STAGE(PG8_SB(1, 0), b3, voffB[0], voffB[1]); PG8_STAGE(PG8_SB(1, 1), b3 + hstep, voffB[0], voffB[1]); PG8_STAGE(PG8_SA(1, 0), a3, w00, w01);
            PG8_WAIT_V(8); PG8_WAIT_L(0); PG8_BAR; PG8_MMA(1, 0, At, B0); PG8_MMA(1, 1, At, B1); PG8_BAR; PG8_SCHED;
        }
        if (wr == 0) PG8_BAR;
        E(acc, cur, wr, wc, fr, fq);
        if (!has_next) break;
#pragma unroll
        for (int a = 0; a < 2; ++a)
#pragma unroll
            for (int b = 0; b < 2; ++b)
#pragma unroll
                for (int m = 0; m < 4; ++m)
#pragma unroll
                    for (int n = 0; n < 2; ++n) acc[a][b][m][n] = (f32x4){0.f, 0.f, 0.f, 0.f};
        cur = nxt; cA = nA; cB = nB; ++ui;
        if constexpr (GATHER) {
#pragma unroll
            for (int h = 0; h < 2; ++h)
#pragma unroll
                for (int i = 0; i < 2; ++i) voffA[h][i] = nvoffA[h][i];
        }
        if (wr == 1) PG8_BAR;
    }
    PG8_WAIT_V(0);
    PG8_BAR;
#undef PG8_SA
#undef PG8_SB
#undef PG8_STAGE
#undef PG8_LDA
#undef PG8_LDB
#undef PG8_MMA
#undef PG8_WAIT_V
#undef PG8_WAIT_L
#undef PG8_BAR
#undef PG8_SCHED
}

template <class F> struct EpiRows {
    F f;
    __device__ __forceinline__ void operator()(const f32x4 (&acc)[2][2][4][2], const Unit& u, int wr, int wc, int fr, int fq) const {
#pragma unroll
        for (int ai = 0; ai < 2; ++ai)
#pragma unroll
            for (int m = 0; m < 4; ++m) {
                float v0[8], v1[8];
#pragma unroll
                for (int j = 0; j < 4; ++j) { v0[j] = acc[ai][0][m][0][j]; v0[4 + j] = acc[ai][0][m][1][j]; v1[j] = acc[ai][1][m][0][j]; v1[4 + j] = acc[ai][1][m][1][j]; }
                f(u, ai * HALF + wr * 64 + m * 16 + fr, wc * 32 + 8 * fq, v0, v1);
            }
    }
};
template <class F> __device__ __forceinline__ EpiRows<F> make_epi(F f) { return EpiRows<F>{f}; }
}

struct MoeOrder {
    const char* A; const char* Bt; const int* tile_e; const int* rowtok; int nt, npn, G, c, tpg, K; bool gather; size_t estride, tstep;
    __device__ __forceinline__ void init(const void* A_, const void* Bt_, const int* tile_e_, const int* rowtok_, int npn_, size_t estride_, int K_, int G_, int c_, bool gather_) {
        A = (const char*)A_; Bt = (const char*)Bt_; tile_e = tile_e_; rowtok = rowtok_; npn = npn_; estride = estride_; K = K_; G = G_; c = c_; gather = gather_;
        nt = tile_e_[1023]; tpg = (G / 8) / npn; tstep = (size_t)256 * K_ * 2;
    }
    __device__ __forceinline__ bool next(int i, pg8::Unit& u) const {
        const int xc = c & 7, ci = c >> 3, group = i * 8 + xc, tile = group * tpg + ci / npn;
        if (tile >= nt) return false;
        u.pm = tile; u.pn = ci % npn; u.e = tile_e[tile];
        u.A = gather ? A : A + (size_t)tile * tstep; u.B = Bt + (size_t)u.e * estride + (size_t)u.pn * tstep; return true;
    }
    __device__ __forceinline__ unsigned rowoff(const pg8::Unit& u, int r) const { const int rt = rowtok[u.pm * 256 + r]; return (unsigned)(rt < 0 ? 0 : (rt >> 2)) * (unsigned)(K * 2); }
};


struct S5Order {
    const char* A; const char* Bt; int npn, c, G; size_t bstride, btile;
    __device__ __forceinline__ void init(const void* A_, const void* Bt_, int npn_, size_t bstride_, size_t btile_, int G_, int c_) { A = (const char*)A_; Bt = (const char*)Bt_; npn = npn_; bstride = bstride_; btile = btile_; G = G_; c = c_; }
    __device__ __forceinline__ bool next(int i, pg8::Unit& u) const {
        if (i > 0) return false;
        const int xc = c & 7, ci = c >> 3, per = 4 * npn;
        if (ci >= 4 * per) return false;
        const int g = 4 * xc + ci / per, rem = ci % per;
        u.e = g; u.pm = rem / npn; u.pn = rem % npn;
        u.A = A + ((size_t)g * 1024 + (size_t)u.pm * 256) * 640 * 2; u.B = Bt + (size_t)g * bstride + (size_t)u.pn * btile; return true;
    }
    __device__ __forceinline__ unsigned rowoff(const pg8::Unit&, int) const { return 0u; }
};

struct EpiInProj {
    unsigned char* ws;
    __device__ __forceinline__ void operator()(const f32x4 (&acc)[2][2][4][2], const pg8::Unit& u, int wr, int wc, int fr, int fq) const {
        const int pn = u.pn;
        size_t boff; int ld, cb;
        if (pn < 8) { boff = WS_U + (size_t)(pn >> 1) * (32 * MiB); ld = 512; cb = 256 * (pn & 1); }
        else { boff = WS_GA + (size_t)((pn - 8) >> 2) * (64 * MiB); ld = 1024; cb = 256 * ((pn - 8) & 3); }
        const int c8 = wc * 32 + 8 * fq;
        const bool rot = (pn >= 2 && pn < 6), isk = (pn == 4 || pn == 5);
        const bool t1 = (c8 & 63) == 0, t2 = (c8 & 63) == 8;
        const float* ROT = (const float*)(ws + WS_ROT);
        float cs0[8], cs1[8];
#pragma unroll
        for (int j = 0; j < 8; ++j) { cs0[j] = 0.f; cs1[j] = 0.f; }
#pragma unroll
        for (int ai = 0; ai < 2; ++ai)
#pragma unroll
            for (int m = 0; m < 4; ++m) {
                const int r = ai * 128 + wr * 64 + m * 16 + fr, row = u.pm * 256 + r;
                float v0[8], v1[8];
#pragma unroll
                for (int j = 0; j < 4; ++j) { v0[j] = acc[ai][0][m][0][j]; v0[4 + j] = acc[ai][0][m][1][j]; v1[j] = acc[ai][1][m][0][j]; v1[4 + j] = acc[ai][1][m][1][j]; }
                if (rot) {
                    float o0[8], o1[8];
#pragma unroll
                    for (int j = 0; j < 8; ++j) { o0[j] = __shfl_xor(v0[j], 16); o1[j] = __shfl_xor(v1[j], 16); }
                    if (t1 || t2) {
                        const f32x4* rp = (const f32x4*)(ROT + (size_t)(row & (SEQ - 1)) * 16);
                        const f32x4 q0 = rp[0], q1 = rp[1], q2 = rp[2], q3 = rp[3];
                        const float cs[8] = {q0.x, q0.z, q1.x, q1.z, q2.x, q2.z, q3.x, q3.z}, sn[8] = {q0.y, q0.w, q1.y, q1.w, q2.y, q2.w, q3.y, q3.w};
#pragma unroll
                        for (int j = 0; j < 8; ++j) {
                            v0[j] = t1 ? (v0[j] * cs[j] - o0[j] * sn[j]) : (v0[j] * cs[j] + o0[j] * sn[j]);
                            v1[j] = t1 ? (v1[j] * cs[j] - o1[j] * sn[j]) : (v1[j] * cs[j] + o1[j] * sn[j]);
                        }
                    }
                }
                if (isk) {
#pragma unroll
                    for (int j = 0; j < 8; ++j) { cs0[j] += v0[j]; cs1[j] += v1[j]; }
                }
                if (pn < 2) {
                    const int col = 256 * pn + c8, R = row >> 5, sl = row & 31;
                    bf16* ug = (bf16*)(ws + WS_UG);
                    *(v4u*)(ug + ((size_t)(col >> 4) * 1024 + R) * 640 + sl * 16 + (col & 15)) = pack8(v0);
                    *(v4u*)(ug + ((size_t)((col + 128) >> 4) * 1024 + R) * 640 + sl * 16 + (col & 15)) = pack8(v1);
                } else {
                    bf16* o = (bf16*)(ws + boff) + (size_t)row * ld + cb + c8;
                    *(v4u*)o = pack8(v0); *(v4u*)(o + 128) = pack8(v1);
                }
            }
        if (isk) {
#pragma unroll
            for (int j = 0; j < 8; ++j) {
#pragma unroll
                for (int o = 1; o < 16; o <<= 1) { cs0[j] += __shfl_xor(cs0[j], o); cs1[j] += __shfl_xor(cs1[j], o); }
            }
            if (fr == 0) {
                const int b = u.pm >> 5, jb = u.pm & 31, d = c8 & 63, h0 = 4 * (pn - 4) + (wc >> 1);
                float* kp = (float*)(ws + WS_KMEAN) + (size_t)wr * (BATCH * NH * 32 * 64);
                float* p0 = kp + ((b * NH + h0) * 32 + jb) * 64 + d; float* p1 = kp + ((b * NH + h0 + 2) * 32 + jb) * 64 + d;
                *(f32x4*)p0 = (f32x4){cs0[0], cs0[1], cs0[2], cs0[3]}; *(f32x4*)(p0 + 4) = (f32x4){cs0[4], cs0[5], cs0[6], cs0[7]};
                *(f32x4*)p1 = (f32x4){cs1[0], cs1[1], cs1[2], cs1[3]}; *(f32x4*)(p1 + 4) = (f32x4){cs1[4], cs1[5], cs1[6], cs1[7]};
            }
        }
    }
};

__device__ __forceinline__ const void* ldptr(LAS unsigned char* lds, int i) {
    const unsigned long long v = ((volatile LAS unsigned long long*)(lds + LDS_PAR))[i];
    const unsigned lo = __builtin_amdgcn_readfirstlane((unsigned)v), hi = __builtin_amdgcn_readfirstlane((unsigned)(v >> 32));
    return (const void*)(const GAS void*)(((unsigned long long)hi << 32) | lo);
}
#define INP(i) ((const float*)ldptr(lds, (i)))
#define WSB() ((unsigned char*)ldptr(lds, 26))
__global__ void __launch_bounds__(NTHR, 2) mega_fwd(Params P) {
    extern __shared__ __attribute__((aligned(16))) unsigned char lds_raw[];
    LAS unsigned char* lds = (LAS unsigned char*)lds_raw;
    volatile LAS unsigned* MISC = (volatile LAS unsigned*)(lds + LDS_MISC);
    const int tid = threadIdx.x, lane = tid & 63, wave = __builtin_amdgcn_readfirstlane(tid >> 6);
    const int G = gridDim.x, bid = blockIdx.x;
    const int gw = bid * NWAVES + wave, NGW = G * NWAVES;
    if (tid < 128) MISC[tid] = 0u;
    if (tid < 25) ((LAS unsigned long long*)(lds + LDS_PAR))[tid] = (unsigned long long)P.in[tid];
    if (tid == 25) ((LAS unsigned long long*)(lds + LDS_PAR))[25] = (unsigned long long)P.out;
    if (tid == 26) ((LAS unsigned long long*)(lds + LDS_PAR))[26] = (unsigned long long)P.ws;
    __syncthreads();
    XcdBarrier bar = xcd_barrier_post((unsigned*)(P.ws + WS_CTL) + 1024, MISC + 8);

    {
        unsigned char* ws = WSB(); float* MOD = (float*)(ws + WS_MOD); float* ROT = (float*)(ws + WS_ROT);
        for (int it = gw; it < 6144 / 64; it += NGW) {
            const int j = it * 64 + lane;
            float a0 = 0.f, a1 = 0.f, a2 = 0.f, a3 = 0.f;
            const float* c = INP(I_C); const float* w = INP(I_WADA);
#pragma unroll 8
            for (int k = 0; k < 1024; ++k) {
                const float wv = w[(size_t)k * 6144 + j];
                const float c0 = c[k], c1 = c[1024 + k], c2 = c[2048 + k], c3 = c[3072 + k];
                a0 += c0 * sigm(c0) * wv; a1 += c1 * sigm(c1) * wv; a2 += c2 * sigm(c2) * wv; a3 += c3 * sigm(c3) * wv;
            }
            const float bb = INP(I_BADA)[j];
            MOD[j] = a0 + bb; MOD[6144 + j] = a1 + bb; MOD[2 * 6144 + j] = a2 + bb; MOD[3 * 6144 + j] = a3 + bb;
        }
        for (int i = bid * NTHR + tid; i < SEQ * 8; i += G * NTHR) {
            const int s = i >> 3, d = i & 7;
            const float inv = 1.0f / powf(500000.0f, (float)(2 * d) / 16.0f);
            const float ang = (float)s * inv;
            float sn, cs; sincosf(ang, &sn, &cs);
            ROT[2 * i] = cs; ROT[2 * i + 1] = sn;
        }
        if (bid < NG) {
            const int g = bid;
            LAS float* APr = (LAS float*)lds;
            LAS float* APi = APr + 33 * 64;
            LAS float* BBr = APi + 33 * 64;
            LAS float* BBi = BBr + 1024;
            LAS float* CCr = BBi + 1024;
            LAS float* CCi = CCr + 1024;
            LAS float* KRN = CCi + 1024;
            const float dt = expf(INP(I_LOGDT)[g]);
            const float* are = INP(I_ARE) + g * 64; const float* aim = INP(I_AIM) + g * 64;
            for (int i = tid; i < 33 * 64; i += NTHR) { const int lag = i >> 6, p = i & 63; const float lr = are[p], li = aim[p];
                const float mg = expf(lr * dt * (float)lag); float sn, cs; sincosf(li * dt * (float)lag, &sn, &cs); APr[i] = mg * cs; APi[i] = mg * sn; }
            { const float* pbre = INP(I_BRE) + g * 1024; const float* pbim = INP(I_BIM) + g * 1024; const float* pcre = INP(I_CRE) + g * 1024; const float* pcim = INP(I_CIM) + g * 1024;
              for (int i = tid; i < 1024; i += NTHR) { const int p = i >> 4; const float lr = are[p], li = aim[p];
                const float mg = expf(lr * dt); float sn, cs; sincosf(li * dt, &sn, &cs); const float ar = mg * cs, ai = mg * sn, den = lr * lr + li * li;
                const float cfr = ((ar - 1.f) * lr + ai * li) / den, cfi = (ai * lr - (ar - 1.f) * li) / den;
                const float br = pbre[i], bi = pbim[i]; BBr[i] = cfr * br - cfi * bi; BBi[i] = cfr * bi + cfi * br;
                CCr[i] = pcre[i]; CCi[i] = pcim[i]; } }
            __syncthreads();
            for (int i = tid; i < 32 * 256; i += NTHR) { const int lag = i >> 8, co = (i >> 4) & 15, ci = i & 15; float a = 0.f;
                for (int p = 0; p < 64; ++p) { const float cr = CCr[co * 64 + p], cim = CCi[co * 64 + p], pr = APr[lag * 64 + p], pi = APi[lag * 64 + p];
                    const float car = cr * pr - cim * pi, cai = cr * pi + cim * pr; a += car * BBr[p * 16 + ci] - cai * BBi[p * 16 + ci]; }
                KRN[i] = a; }
            __syncthreads();
            bf16* T = (bf16*)(ws + WS_S5T) + (size_t)g * 512 * 640;
            for (int ch = tid; ch < 512 * 80; ch += NTHR) { const int row = ch / 80, col = (ch % 80) * 8, t = row >> 4, co = row & 15; float f[8];
                if (col < 512) { const int sx = col >> 4, ci0 = col & 15;
#pragma unroll
                    for (int j = 0; j < 8; ++j) f[j] = (sx <= t) ? KRN[((t - sx) * 16 + co) * 16 + ci0 + j] : 0.f; }
                else { const int cx = col - 512, ri = cx >> 6, p0 = cx & 63;
#pragma unroll
                    for (int j = 0; j < 8; ++j) { const int p = p0 + j; const float cr = CCr[co * 64 + p], cim = CCi[co * 64 + p], pr = APr[(t + 1) * 64 + p], pi = APi[(t + 1) * 64 + p];
                        f[j] = ri ? -(cr * pi + cim * pr) : (cr * pr - cim * pi); } }
                *(v4u*)(T + (size_t)row * 640 + col) = pack8(f); }
            bf16* W1 = (bf16*)(ws + WS_S5W) + (size_t)g * 256 * 512;
            for (int ch = tid; ch < 256 * 64; ch += NTHR) { const int row = ch >> 6, col = (ch & 63) * 8; float f[8];
                if (row < 128) { const int ri = row >> 6, p = row & 63, sx = col >> 4, ci0 = col & 15; const float pr = APr[(31 - sx) * 64 + p], pi = APi[(31 - sx) * 64 + p];
#pragma unroll
                    for (int j = 0; j < 8; ++j) { const float br = BBr[p * 16 + ci0 + j], bi = BBi[p * 16 + ci0 + j]; f[j] = ri ? (pr * bi + pi * br) : (pr * br - pi * bi); } }
                else {
#pragma unroll
                    for (int j = 0; j < 8; ++j) f[j] = 0.f; }
                *(v4u*)(W1 + (size_t)row * 512 + col) = pack8(f); }
            __syncthreads();
        }
        LAS float* scr = (LAS float*)(lds + wave * 16384);
        constexpr int I_IN = 16 * 128, I_GL = 8 * 64, I_AO = 8 * 32, I_OU = 16 * 32, I_GU1 = 16 * 64, I_D1 = 16 * 32;
        constexpr int NIT = I_IN + I_GL + I_AO + I_OU + NE * I_GU1 + NE * I_D1;
        for (int it = gw; it < NIT; it += NGW) {
            int r = it;
            if (r < I_IN) { transpose_item(INP(I_WIN), 1024, 4096, (bf16*)(ws + WS_WIN), false, scr, r, lane); continue; } r -= I_IN;
            if (r < I_GL) { transpose_item(INP(I_WGLU), 512, 2048, (bf16*)(ws + WS_WGLU), true, scr, r, lane); continue; } r -= I_GL;
            if (r < I_AO) { transpose_item(INP(I_WAO), 512, 1024, (bf16*)(ws + WS_WAO), false, scr, r, lane); continue; } r -= I_AO;
            if (r < I_OU) { transpose_item(INP(I_WOUT), 1024, 1024, (bf16*)(ws + WS_WOUT), false, scr, r, lane); continue; } r -= I_OU;
            if (r < NE * I_GU1) { const int e = r / I_GU1; transpose_item(INP(I_WGU) + (size_t)e * 1024 * 2048, 1024, 2048, (bf16*)(ws + WS_WGU) + (size_t)e * 2048 * 1024, true, scr, r % I_GU1, lane); continue; } r -= NE * I_GU1;
            { const int e = r / I_D1; transpose_item(INP(I_WD) + (size_t)e * 1024 * 1024, 1024, 1024, (bf16*)(ws + WS_WD) + (size_t)e * 1024 * 1024, false, scr, r % I_D1, lane); }
        }
    }
    xcd_barrier(bar);

    { unsigned char* ws = WSB(); const float* x = INP(I_X); const float* gmix = INP(I_GMIX); const float* MOD = (const float*)(ws + WS_MOD); bf16* Hb = (bf16*)(ws + WS_H);
    for (int m = gw; m < NTOK; m += NGW) {
        const int b = m >> 13;
        const f32x4* xr = (const f32x4*)(x + (size_t)m * DM) + lane;
        f32x4 v[4]; float s = 0.f;
#pragma unroll
        for (int j = 0; j < 4; ++j) { v[j] = xr[64 * j]; s += (v[j].x * v[j].x + v[j].y * v[j].y) + (v[j].z * v[j].z + v[j].w * v[j].w); }
        const float r = rsqrtf(wave_sum(s) * (1.f / DM) + RMS_EPS);
        v2u* o8 = (v2u*)(Hb + (size_t)m * DM) + lane;
#pragma unroll
        for (int j = 0; j < 4; ++j) {
            const int col = 4 * lane + 256 * j;
            const f32x4 g = *(const f32x4*)(gmix + col);
            const f32x4 sh = *(const f32x4*)(MOD + b * 6144 + col), sc = *(const f32x4*)(MOD + b * 6144 + 1024 + col);
            v2u w; w.x = pk2(v[j].x * r * g.x * (1.f + sc.x) + sh.x, v[j].y * r * g.y * (1.f + sc.y) + sh.y);
            w.y = pk2(v[j].z * r * g.z * (1.f + sc.z) + sh.z, v[j].w * r * g.w * (1.f + sc.w) + sh.w);
            o8[64 * j] = w;
        }
    } }
    xcd_barrier(bar);

    { unsigned char* ws = WSB();
      pg8::DenseOrder S; S.init(ws + WS_H, ws + WS_WIN, NTOK, INW, 1024, G, bid);
      EpiInProj E{ws};
      pg8::gemm_phase<EpiInProj, pg8::DenseOrder, false>(lds, 1024, S, E);
    }
    xcd_barrier(bar);

    { unsigned char* ws = WSB();
      S5Order S; S.init(ws + WS_UG, ws + WS_S5W, 1, (size_t)256 * 512 * 2, 0, G, bid);
      auto E = pg8::make_epi([=](const pg8::Unit& u, int r, int c8, const float (&v0)[8], const float (&v1)[8]) {
          float* xe = (float*)(ws + WS_XE) + ((size_t)u.e * 1024 + u.pm * 256 + r) * 128 + c8;
          *(f32x4*)xe = (f32x4){v0[0], v0[1], v0[2], v0[3]}; *(f32x4*)(xe + 4) = (f32x4){v0[4], v0[5], v0[6], v0[7]};
      });
      pg8::gemm_phase<decltype(E), S5Order, false>(lds, 512, S, E, 640);
    }
    xcd_barrier(bar);

    if (gw < BATCH * NG) {
        unsigned char* ws = WSB();
        const int b = gw >> 5, g = gw & 31, p = lane;
        const float lr = INP(I_ARE)[g * 64 + p], li = INP(I_AIM)[g * 64 + p], dt = expf(INP(I_LOGDT)[g]);
        const float mg = expf(lr * dt * 32.f); float sn, cs; sincosf(li * dt * 32.f, &sn, &cs);
        const float ar = mg * cs, ai = mg * sn;
        const float* xe = (const float*)(ws + WS_XE) + ((size_t)g * 1024 + b * 256) * 128 + p;
        bf16* xp = (bf16*)(ws + WS_UG) + ((size_t)g * 1024 + b * 256) * 640 + 512 + p;
        float xr = 0.f, xi = 0.f;
        for (int k0 = 0; k0 < 256; k0 += 8) {
            float er[8], ei[8];
#pragma unroll
            for (int k = 0; k < 8; ++k) { er[k] = xe[(size_t)(k0 + k) * 128]; ei[k] = xe[(size_t)(k0 + k) * 128 + 64]; }
#pragma unroll
            for (int k = 0; k < 8; ++k) {
                xp[(size_t)(k0 + k) * 640] = (bf16)f2bf(xr); xp[(size_t)(k0 + k) * 640 + 64] = (bf16)f2bf(xi);
                const float nr = ar * xr - ai * xi + er[k], ni = ar * xi + ai * xr + ei[k]; xr = nr; xi = ni;
            }
        }
    }
    xcd_barrier(bar);

    { unsigned char* ws = WSB(); const float* dsk = INP(I_SD);
      S5Order S; S.init(ws + WS_UG, ws + WS_S5T, 2, (size_t)512 * 640 * 2, (size_t)256 * 640 * 2, G, bid);
      auto E = pg8::make_epi([=](const pg8::Unit& u, int r, int c8, const float (&v0)[8], const float (&v1)[8]) {
          const int g = u.e, R = u.pm * 256 + r;
          const bf16* ug = (const bf16*)(ws + WS_UG) + ((size_t)g * 1024 + R) * 640;
#pragma unroll
          for (int h = 0; h < 2; ++h) {
              const int n = 256 * u.pn + 128 * h + c8, t = n >> 4, co = n & 15;
              float uu[8]; unpack8(*(const v4u*)(ug + t * 16 + co), uu);
              const f32x4 d0 = *(const f32x4*)(dsk + g * 16 + co), d1 = *(const f32x4*)(dsk + g * 16 + co + 4);
              const float dd[8] = {d0.x, d0.y, d0.z, d0.w, d1.x, d1.y, d1.z, d1.w};
              float f[8];
#pragma unroll
              for (int j = 0; j < 8; ++j) { const float y = (h ? v1[j] : v0[j]) + dd[j] * uu[j]; f[j] = y * sigm(1.5957691216f * (y + 0.044715f * y * y * y)); }
              *(v4u*)((bf16*)(ws + WS_Y) + ((size_t)R * 32 + t) * 512 + g * 16 + co) = pack8(f);
          }
      });
      pg8::gemm_phase<decltype(E), S5Order, false>(lds, 640, S, E, 640);
    }
    { unsigned char* ws = WSB();
    for (int it = gw; it < BATCH * NH * 128; it += NGW) {
        const int b = it >> 10, h = (it >> 7) & 7, chk = it & 127, s = chk * 64 + lane, nb = chk >> 2;
        const size_t qrow = (size_t)b * SEQ + s;
        const bf16* Qb_ = (const bf16*)(ws + WS_Q); const bf16* Kb_ = (const bf16*)(ws + WS_K); const bf16* Vb_ = (const bf16*)(ws + WS_V);
        v4u qp[8];
#pragma unroll
        for (int i = 0; i < 8; ++i) qp[i] = ((const v4u*)(Qb_ + qrow * 512 + h * 64))[i];
        float g0 = -INFINITY, g1 = -INFINITY, g2 = -INFINITY; int s0 = 0, s1 = 0, s2 = 0;
        for (int j = 0; j < nb; ++j) {
            const float* km = (const float*)(ws + WS_KMEAN) + ((b * NH + h) * 32 + j) * 64;
            float g = 0.f;
#pragma unroll
            for (int i = 0; i < 8; ++i) { float f[8]; unpack8(qp[i], f);
#pragma unroll
                for (int jj = 0; jj < 8; ++jj) g += f[jj] * (km[8 * i + jj] + km[BATCH * NH * 32 * 64 + 8 * i + jj]); }
            if (g > g0) { g2 = g1; s2 = s1; g1 = g0; s1 = s0; g0 = g; s0 = j; }
            else if (g > g1) { g2 = g1; s2 = s1; g1 = g; s1 = j; }
            else if (g > g2) { g2 = g; s2 = j; }
        }
        const int nsel = nb < 3 ? nb : 3;
        float m = -1e30f, l = 0.f, o[64];
#pragma unroll
        for (int d = 0; d < 64; ++d) o[d] = 0.f;
        for (int t = 0; t < 4; ++t) {
            if (t < 3 && t >= nsel) continue;
            const int j = (t == 0) ? s0 : (t == 1) ? s1 : (t == 2) ? s2 : nb;
            const int kend = (t == 3) ? ((s & 255) + 1) : 256;
            const int kmax = (t == 3) ? ((chk & 3) * 64 + 64) : 256;
            const size_t base = (size_t)b * SEQ + (size_t)j * 256;
#pragma unroll 1
            for (int key = 0; key < kmax; ++key) {
                const v4u* kp = (const v4u*)(Kb_ + (base + key) * 512 + h * 64);
                float d0 = 0.f;
#pragma unroll
                for (int i = 0; i < 8; ++i) { float f[8], qf[8]; unpack8(kp[i], f); unpack8(qp[i], qf);
#pragma unroll
                    for (int jj = 0; jj < 8; ++jj) d0 += qf[jj] * f[jj]; }
                const bool valid = key < kend;
                const float sc = valid ? d0 * 0.125f : -1e30f;
                if (sc > m) {
                    const float alpha = __expf(m - sc);
                    l *= alpha;
#pragma unroll
                    for (int d = 0; d < 64; ++d) o[d] *= alpha;
                    m = sc;
                }
                const float pexp = valid ? __expf(sc - m) : 0.f;
                l += pexp;
                const v4u* vp = (const v4u*)(Vb_ + (base + key) * 512 + h * 64);
#pragma unroll
                for (int i = 0; i < 8; ++i) { float f[8]; unpack8(vp[i], f);
#pragma unroll
                    for (int jj = 0; jj < 8; ++jj) o[8 * i + jj] += pexp * f[jj]; }
            }
        }
        const float il = 1.f / l;
        v4u* op = (v4u*)((bf16*)(ws + WS_O) + qrow * 512 + h * 64);
#pragma unroll
        for (int i = 0; i < 8; ++i) { float f[8];
#pragma unroll
            for (int j = 0; j < 8; ++j) f[j] = o[8 * i + j] * il;
            op[i] = pack8(f); }
    } }
    xcd_barrier(bar);

    { unsigned char* ws = WSB();
      pg8::DenseOrder S; S.init(ws + WS_Y, ws + WS_WGLU, NTOK, 2048, 512, G, bid);
      auto E = pg8::make_epi([=](const pg8::Unit& u, int r, int c8, const float (&v0)[8], const float (&v1)[8]) {
          const size_t off = (size_t)(u.pm * 256 + r) * 1024 + u.pn * 128 + c8;
          float ga[8]; unpack8(*(const v4u*)((const bf16*)(ws + WS_GA) + off), ga);
          float f[8];
#pragma unroll
          for (int j = 0; j < 8; ++j) f[j] = sigm(ga[j]) * v0[j] * sigm(v1[j]);
          *(v4u*)((bf16*)(ws + WS_MRG) + off) = pack8(f);
      });
      pg8::gemm_phase<decltype(E), pg8::DenseOrder, false>(lds, 512, S, E);
    }
    xcd_barrier(bar);

    { unsigned char* ws = WSB();
      pg8::DenseOrder S; S.init(ws + WS_O, ws + WS_WAO, NTOK, 1024, 512, G, bid);
      auto E = pg8::make_epi([=](const pg8::Unit& u, int r, int c8, const float (&v0)[8], const float (&v1)[8]) {
          const size_t off = (size_t)(u.pm * 256 + r) * 1024 + u.pn * 256 + c8;
          const bf16* GBb = (const bf16*)(ws + WS_GB); bf16* MRG = (bf16*)(ws + WS_MRG);
          float gb[8], ma[8], f[8];
          unpack8(*(const v4u*)(GBb + off), gb); unpack8(*(const v4u*)(MRG + off), ma);
#pragma unroll
          for (int j = 0; j < 8; ++j) f[j] = ma[j] + sigm(gb[j]) * v0[j];
          *(v4u*)(MRG + off) = pack8(f);
          unpack8(*(const v4u*)(GBb + off + 128), gb); unpack8(*(const v4u*)(MRG + off + 128), ma);
#pragma unroll
          for (int j = 0; j < 8; ++j) f[j] = ma[j] + sigm(gb[j]) * v1[j];
          *(v4u*)(MRG + off + 128) = pack8(f);
      });
      pg8::gemm_phase<decltype(E), pg8::DenseOrder, false>(lds, 512, S, E);
    }
    xcd_barrier(bar);

    { unsigned char* ws = WSB(); const float* x = INP(I_X);
      pg8::DenseOrder S; S.init(ws + WS_MRG, ws + WS_WOUT, NTOK, 1024, 1024, G, bid);
      auto E = pg8::make_epi([=](const pg8::Unit& u, int r, int c8, const float (&v0)[8], const float (&v1)[8]) {
          const int row = u.pm * 256 + r, b = row >> 13, col = u.pn * 256 + c8;
          const float* gt = (const float*)(ws + WS_MOD) + b * 6144 + 2048 + col;
          const float* xp = x + (size_t)row * 1024 + col; float* op = (float*)(ws + WS_X1) + (size_t)row * 1024 + col;
#pragma unroll
          for (int h = 0; h < 2; ++h) {
              const f32x4 g0 = *(const f32x4*)(gt + 128 * h), g1 = *(const f32x4*)(gt + 128 * h + 4), x0 = *(const f32x4*)(xp + 128 * h), x1 = *(const f32x4*)(xp + 128 * h + 4);
              const float (&v)[8] = h ? v1 : v0;
              f32x4 o0, o1;
              o0.x = x0.x + g0.x * v[0]; o0.y = x0.y + g0.y * v[1]; o0.z = x0.z + g0.z * v[2]; o0.w = x0.w + g0.w * v[3];
              o1.x = x1.x + g1.x * v[4]; o1.y = x1.y + g1.y * v[5]; o1.z = x1.z + g1.z * v[6]; o1.w = x1.w + g1.w * v[7];
              *(f32x4*)(op + 128 * h) = o0; *(f32x4*)(op + 128 * h + 4) = o1;
          }
      });
      pg8::gemm_phase<decltype(E), pg8::DenseOrder, false>(lds, 1024, S, E);
    }
    xcd_barrier(bar);

    {
        unsigned char* ws = WSB(); const float* X1 = (const float*)(ws + WS_X1); const float* MOD = (const float*)(ws + WS_MOD); bf16* Hb = (bf16*)(ws + WS_H);
        const float* gffn = INP(I_GFFN); const float* wrt = INP(I_WR); const float* brt = INP(I_BR);
        int* TOPI = (int*)(ws + WS_TOPI); float* TOPW = (float*)(ws + WS_TOPW); int* BLKCNT = (int*)(ws + WS_BLKCNT);
        LAS int* cnt = (LAS int*)lds;
        if (tid < 32) cnt[tid] = 0;
        __syncthreads();
        const int tpb = NTOK / G;
        for (int tl = wave; tl < tpb; tl += NWAVES) {
            const int m = bid * tpb + tl, b = m >> 13;
            const f32x4* xr = (const f32x4*)(X1 + (size_t)m * DM) + lane;
            float s = 0.f;
#pragma unroll
            for (int j = 0; j < 4; ++j) { const f32x4 t = xr[64 * j]; s += (t.x * t.x + t.y * t.y) + (t.z * t.z + t.w * t.w); }
            const float r = rsqrtf(wave_sum(s) * (1.f / DM) + RMS_EPS);
            float lg[32];
#pragma unroll
            for (int e = 0; e < 32; ++e) lg[e] = 0.f;
            v2u* o8 = (v2u*)(Hb + (size_t)m * DM) + lane;
#pragma unroll 1
            for (int j = 0; j < 4; ++j) {
                const int col = 4 * lane + 256 * j;
                const f32x4 t = xr[64 * j];
                const f32x4 g = *(const f32x4*)(gffn + col);
                const f32x4 sh = *(const f32x4*)(MOD + b * 6144 + 3072 + col), sc = *(const f32x4*)(MOD + b * 6144 + 4096 + col);
                float hv[4];
                hv[0] = t.x * r * g.x * (1.f + sc.x) + sh.x; hv[1] = t.y * r * g.y * (1.f + sc.y) + sh.y;
                hv[2] = t.z * r * g.z * (1.f + sc.z) + sh.z; hv[3] = t.w * r * g.w * (1.f + sc.w) + sh.w;
                v2u w; w.x = pk2(hv[0], hv[1]); w.y = pk2(hv[2], hv[3]); o8[64 * j] = w;
                const f32x4* wr = (const f32x4*)(wrt + (size_t)col * 32);
#pragma unroll
                for (int i = 0; i < 4; ++i) {
#pragma unroll
                    for (int e4 = 0; e4 < 8; ++e4) { const f32x4 w4 = wr[i * 8 + e4]; lg[4 * e4] += hv[i] * w4.x; lg[4 * e4 + 1] += hv[i] * w4.y; lg[4 * e4 + 2] += hv[i] * w4.z; lg[4 * e4 + 3] += hv[i] * w4.w; }
                }
            }
            float a16[16], a8[8], a4[4], a2[2], a1;
            { const bool hi = (lane & 32) != 0;
#pragma unroll
              for (int i = 0; i < 16; ++i) { const float keep = hi ? lg[i + 16] : lg[i], send = hi ? lg[i] : lg[i + 16]; a16[i] = keep + __shfl_xor(send, 32); } }
            { const bool hi = (lane & 16) != 0;
#pragma unroll
              for (int i = 0; i < 8; ++i) { const float keep = hi ? a16[i + 8] : a16[i], send = hi ? a16[i] : a16[i + 8]; a8[i] = keep + __shfl_xor(send, 16); } }
            { const bool hi = (lane & 8) != 0;
#pragma unroll
              for (int i = 0; i < 4; ++i) { const float keep = hi ? a8[i + 4] : a8[i], send = hi ? a8[i] : a8[i + 4]; a4[i] = keep + __shfl_xor(send, 8); } }
            { const bool hi = (lane & 4) != 0;
#pragma unroll
              for (int i = 0; i < 2; ++i) { const float keep = hi ? a4[i + 2] : a4[i], send = hi ? a4[i] : a4[i + 2]; a2[i] = keep + __shfl_xor(send, 4); } }
            { const bool hi = (lane & 2) != 0; const float keep = hi ? a2[1] : a2[0], send = hi ? a2[0] : a2[1]; a1 = keep + __shfl_xor(send, 2); }
            a1 += __shfl_xor(a1, 1);
            const int e_me = lane >> 1;
            float val = a1 + brt[e_me];
            float tv[4]; int ti[4];
#pragma unroll
            for (int k = 0; k < 4; ++k) {
                float bv = val; int bi = e_me;
#pragma unroll
                for (int o = 1; o < 64; o <<= 1) { const float ov = __shfl_xor(bv, o); const int oi = __shfl_xor(bi, o); if (ov > bv || (ov == bv && oi < bi)) { bv = ov; bi = oi; } }
                tv[k] = bv; ti[k] = bi;
                if (e_me == bi) val = -INFINITY;
            }
            const float e0 = 1.f, e1 = __expf(tv[1] - tv[0]), e2 = __expf(tv[2] - tv[0]), e3 = __expf(tv[3] - tv[0]);
            const float inv = 1.f / (e0 + e1 + e2 + e3);
            if (lane == 0) {
                TOPI[m * 4 + 0] = ti[0]; TOPI[m * 4 + 1] = ti[1]; TOPI[m * 4 + 2] = ti[2]; TOPI[m * 4 + 3] = ti[3];
                TOPW[m * 4 + 0] = e0 * inv; TOPW[m * 4 + 1] = e1 * inv; TOPW[m * 4 + 2] = e2 * inv; TOPW[m * 4 + 3] = e3 * inv;
                atomicAdd((int*)&cnt[ti[0]], 1); atomicAdd((int*)&cnt[ti[1]], 1); atomicAdd((int*)&cnt[ti[2]], 1); atomicAdd((int*)&cnt[ti[3]], 1);
            }
        }
        __syncthreads();
        if (tid < 32) BLKCNT[bid * 32 + tid] = cnt[tid];
    }
    xcd_barrier(bar);

    {
        unsigned char* ws = WSB(); const int* TOPI = (const int*)(ws + WS_TOPI); const float* TOPW = (const float*)(ws + WS_TOPW); const int* BLKCNT = (const int*)(ws + WS_BLKCNT);
        int* ROWTOK = (int*)(ws + WS_ROWTOK); float* ROWW = (float*)(ws + WS_ROWW); int* TILEE = (int*)(ws + WS_TILEE);
        LAS int* tot = (LAS int*)lds;
        LAS int* mine = tot + 32;
        LAS int* pst = mine + 32;
        LAS int* ent = pst + 64;
        const int tpb = NTOK / G;
        if (tid < 32) {
            int t = 0, mn = 0;
            for (int k = 0; k < G; ++k) { const int c = BLKCNT[k * 32 + tid]; t += c; if (k < bid) mn += c; }
            tot[tid] = t; mine[tid] = mn;
        }
        for (int i = tid; i < tpb * 4; i += NTHR) ent[i] = TOPI[bid * tpb * 4 + i];
        __syncthreads();
        if (tid == 0) { int a = 0; for (int e = 0; e < 32; ++e) { pst[e] = a; a += (tot[e] + 255) & ~255; } pst[32] = a; }
        __syncthreads();
        for (int i = tid; i < tpb * 4; i += NTHR) {
            const int e = ent[i]; int rank = 0;
            for (int k = 0; k < i; ++k) rank += (ent[k] == e) ? 1 : 0;
            const int pos = pst[e] + mine[e] + rank;
            ROWTOK[pos] = (bid * tpb + (i >> 2)) * 4 + (i & 3);
            ROWW[pos] = TOPW[bid * tpb * 4 + i];
        }
        if (bid < 32) { const int e = bid; for (int pos = pst[e] + tot[e] + tid; pos < pst[e + 1]; pos += NTHR) { ROWTOK[pos] = -1; ROWW[pos] = 0.f; } }
        if (bid == 32 % G) {
            const int nt = pst[32] >> 8;
            for (int t = tid; t < nt; t += NTHR) { int e = 0; for (int k = 0; k < 32; ++k) if ((t << 8) >= pst[k]) e = k; TILEE[t] = e; }
            if (tid == 0) TILEE[1023] = nt;
        }
    }
    xcd_barrier(bar);

    { unsigned char* ws = WSB(); const float* bgu = INP(I_BGU);
      MoeOrder S; S.init(ws + WS_H, ws + WS_WGU, (const int*)(ws + WS_TILEE), (const int*)(ws + WS_ROWTOK), 8, (size_t)2048 * 1024 * 2, 1024, G, bid, true);
      auto E = pg8::make_epi([=](const pg8::Unit& u, int r, int c8, const float (&v0)[8], const float (&v1)[8]) {
          const int col = u.pn * 128 + c8; float f[8];
          const float* bg = bgu + (size_t)u.e * 2048 + col;
          const f32x4 bg0 = *(const f32x4*)bg, bg1 = *(const f32x4*)(bg + 4), bu0 = *(const f32x4*)(bg + 1024), bu1 = *(const f32x4*)(bg + 1028);
          const float bgv[8] = {bg0.x, bg0.y, bg0.z, bg0.w, bg1.x, bg1.y, bg1.z, bg1.w}, buv[8] = {bu0.x, bu0.y, bu0.z, bu0.w, bu1.x, bu1.y, bu1.z, bu1.w};
#pragma unroll
          for (int j = 0; j < 8; ++j) {
              const float gt = fminf(v0[j] + bgv[j], 7.f);
              const float up = fminf(fmaxf(v1[j] + buv[j], -7.f), 7.f);
              f[j] = (up + 1.f) * gt * sigm(1.702f * gt);
          }
          *(v4u*)((bf16*)(ws + WS_ACT) + (size_t)(u.pm * 256 + r) * 1024 + col) = pack8(f);
      });
      pg8::gemm_phase<decltype(E), MoeOrder, true>(lds, 1024, S, E);
    }
    xcd_barrier(bar);

    { unsigned char* ws = WSB(); const float* bdn = INP(I_BD);
      MoeOrder S; S.init(ws + WS_ACT, ws + WS_WD, (const int*)(ws + WS_TILEE), (const int*)(ws + WS_ROWTOK), 4, (size_t)1024 * 1024 * 2, 1024, G, bid, false);
      auto E = pg8::make_epi([=](const pg8::Unit& u, int r, int c8, const float (&v0)[8], const float (&v1)[8]) {
          const int srow = u.pm * 256 + r;
          const int rt = ((const int*)(ws + WS_ROWTOK))[srow];
          if (rt >= 0) {
              const float w = ((const float*)(ws + WS_ROWW))[srow]; const int col = u.pn * 256 + c8; float f[8];
              const float* bd = bdn + (size_t)u.e * 1024 + col;
              bf16* yp = (bf16*)(ws + WS_YS) + (size_t)rt * 1024 + col;
#pragma unroll
              for (int j = 0; j < 8; ++j) f[j] = (v0[j] + bd[j]) * w;
              *(v4u*)yp = pack8(f);
#pragma unroll
              for (int j = 0; j < 8; ++j) f[j] = (v1[j] + bd[128 + j]) * w;
              *(v4u*)(yp + 128) = pack8(f);
          }
      });
      pg8::gemm_phase<decltype(E), MoeOrder, false>(lds, 1024, S, E);
    }
    xcd_barrier(bar);

    { unsigned char* ws = WSB(); const float* X1 = (const float*)(ws + WS_X1); const float* MOD = (const float*)(ws + WS_MOD); const bf16* YS = (const bf16*)(ws + WS_YS); const float* gfin = INP(I_GFIN); float* outp = (float*)ldptr(lds, 25);
    for (int m = gw; m < NTOK; m += NGW) {
        const int b = m >> 13;
        const f32x4* xr = (const f32x4*)(X1 + (size_t)m * DM) + lane;
        f32x4 v[4]; float s = 0.f;
#pragma unroll
        for (int j = 0; j < 4; ++j) {
            const int col = 4 * lane + 256 * j;
            f32x4 a = (f32x4){0.f, 0.f, 0.f, 0.f};
#pragma unroll
            for (int sl = 0; sl < 4; ++sl) { const v2u w = *(const v2u*)(YS + ((size_t)m * 4 + sl) * 1024 + col); a.x += lo16(w.x); a.y += hi16(w.x); a.z += lo16(w.y); a.w += hi16(w.y); }
            const f32x4 gt = *(const f32x4*)(MOD + b * 6144 + 5120 + col);
            v[j] = xr[64 * j] + gt * a;
            s += (v[j].x * v[j].x + v[j].y * v[j].y) + (v[j].z * v[j].z + v[j].w * v[j].w);
        }
        const float r = rsqrtf(wave_sum(s) * (1.f / DM) + RMS_EPS);
        f32x4* op = (f32x4*)(outp + (size_t)m * DM) + lane;
#pragma unroll
        for (int j = 0; j < 4; ++j) { const f32x4 g = *(const f32x4*)(gfin + 4 * lane + 256 * j); op[64 * j] = v[j] * r * g; }
    } }
}

extern "C" void kernel_launch(void* const* d_in, const int* in_sizes, int n_in, void* d_out, int out_size, void* d_ws, size_t ws_size, hipStream_t stream) {
    static int grid = 0;
    if (grid == 0) {
        if (n_in != 25 || in_sizes[0] != NTOK * DM || out_size != NTOK * DM || ws_size < WS_END) {
            fprintf(stderr, "kernel_launch: unexpected shapes (n_in %d, in0 %d, out %d, ws %zu); nothing launched\n", n_in, n_in > 0 ? in_sizes[0] : -1, out_size, ws_size); grid = -1; return; }
        int dev = 0, cus = 0, per_cu = 0;
        if (hipGetDevice(&dev) != hipSuccess || hipDeviceGetAttribute(&cus, hipDeviceAttributeMultiprocessorCount, dev) != hipSuccess) { grid = -1; return; }
        if (hipFuncSetAttribute((const void*)mega_fwd, hipFuncAttributeMaxDynamicSharedMemorySize, LDS_BYTES) != hipSuccess) { fprintf(stderr, "kernel_launch: hipFuncSetAttribute failed\n"); grid = -1; return; }
        if (hipOccupancyMaxActiveBlocksPerMultiprocessor(&per_cu, (const void*)mega_fwd, NTHR, LDS_BYTES) != hipSuccess || per_cu < 1) {
            fprintf(stderr, "kernel_launch: occupancy query reports %d blocks per CU\n", per_cu); (void)hipGetLastError(); grid = -1; return; }
        grid = cus;
        if (NTOK % grid != 0) { fprintf(stderr, "kernel_launch: grid %d does not divide the token count\n", grid); grid = -1; return; }
    }
    if (grid < 0) return;
    (void)hipMemsetAsync((char*)d_ws + WS_CTL, 0, CTL_ZERO_BYTES, stream);
    Params p{};
    for (int i = 0; i < 25; ++i) p.in[i] = (const float*)d_in[i];
    p.out = (float*)d_out; p.ws = (unsigned char*)d_ws;
    hipLaunchKernelGGL(mega_fwd, dim3(grid), dim3(NTHR), LDS_BYTES, stream, p);
}
```

```cpp
#include <hip/hip_runtime.h>
#include <cstdio>
#include <cstdint>

#define GAS __attribute__((address_space(1)))
#define LAS __attribute__((address_space(3)))
typedef unsigned short bf16;
typedef unsigned v4u __attribute__((ext_vector_type(4)));
typedef unsigned v2u __attribute__((ext_vector_type(2)));
typedef float f32x4 __attribute__((ext_vector_type(4)));

constexpr int BATCH = 4, SEQ = 8192, DM = 1024, NTOK = BATCH * SEQ, INW = 4096;
constexpr int NH = 8, HD = 64, AW = 512, SW = 512, NG = 32, NP = 64, NC = 16;
constexpr int NE = 32, TOPK = 4, DFF = 1024, MAXTILES = 544, MAXROWS = MAXTILES * 256;
constexpr int NWAVES = 8, NTHR = 512;
constexpr float RMS_EPS = 1e-5f;

constexpr size_t MiB = 1u << 20;
constexpr size_t WS_CTL = 0, CTL_ZERO_BYTES = 64 * 1024;
constexpr size_t WS_MOD = 1 * MiB;
constexpr size_t WS_ROT = 2 * MiB;
constexpr size_t WS_KMEAN = 3 * MiB;
constexpr size_t WS_TOPI = 4 * MiB;
constexpr size_t WS_TOPW = 5 * MiB;
constexpr size_t WS_BLKCNT = 6 * MiB;
constexpr size_t WS_ROWTOK = 7 * MiB;
constexpr size_t WS_ROWW = 8 * MiB;
constexpr size_t WS_TILEE = 9 * MiB;
constexpr size_t WS_WIN = 16 * MiB, WS_WGLU = 24 * MiB, WS_WAO = 26 * MiB, WS_WOUT = 27 * MiB, WS_WGU = 32 * MiB, WS_WD = 160 * MiB;
constexpr size_t WS_X1 = 224 * MiB;
constexpr size_t WS_U = 352 * MiB, WS_Q = 384 * MiB, WS_K = 416 * MiB, WS_V = 448 * MiB, WS_GA = 480 * MiB, WS_GB = 544 * MiB, WS_O = 608 * MiB, WS_Y = 640 * MiB;
constexpr size_t WS_ACT = 352 * MiB;
constexpr size_t WS_H = 672 * MiB;
constexpr size_t WS_MRG = 736 * MiB;
constexpr size_t WS_YS = 672 * MiB;
constexpr size_t WS_ACNT = 32768;
constexpr size_t WS_LSE = 10 * MiB;
constexpr size_t WS_ALIST = 352 * MiB;
constexpr size_t WS_PART = 800 * MiB;
constexpr size_t WS_S5T = 928 * MiB;
constexpr size_t WS_S5W = 952 * MiB;
constexpr size_t WS_XE = 960 * MiB;
constexpr size_t WS_UG = 976 * MiB;
constexpr size_t WS_END = 1016 * MiB;

constexpr int LDS_BYTES = 147456;
constexpr int LDS_MISC = 147456 - 512;
constexpr int LDS_PAR = 147456 - 1024;

__device__ __forceinline__ float bf2f(bf16 v) { return __builtin_bit_cast(float, (unsigned)v << 16); }
__device__ __forceinline__ unsigned f2bf(float f) { unsigned u = __builtin_bit_cast(unsigned, f); return (u + 0x7fffu + ((u >> 16) & 1u)) >> 16; }
__device__ __forceinline__ unsigned pk2(float lo, float hi) { return f2bf(lo) | (f2bf(hi) << 16); }
__device__ __forceinline__ float lo16(unsigned w) { return __builtin_bit_cast(float, w << 16); }
__device__ __forceinline__ float hi16(unsigned w) { return __builtin_bit_cast(float, w & 0xffff0000u); }
__device__ __forceinline__ float sigm(float x) { return 1.f / (1.f + __expf(-x)); }
__device__ __forceinline__ float wave_sum(float v) {
#pragma unroll
    for (int o = 1; o < 64; o <<= 1) v += __shfl_xor(v, o);
    return v;
}
__device__ __forceinline__ void unpack8(v4u w, float (&f)[8]) {
    f[0] = lo16(w.x); f[1] = hi16(w.x); f[2] = lo16(w.y); f[3] = hi16(w.y); f[4] = lo16(w.z); f[5] = hi16(w.z); f[6] = lo16(w.w); f[7] = hi16(w.w);
}
__device__ __forceinline__ v4u pack8(const float (&f)[8]) { v4u w; w.x = pk2(f[0], f[1]); w.y = pk2(f[2], f[3]); w.z = pk2(f[4], f[5]); w.w = pk2(f[6], f[7]); return w; }

#define XB_TMO      128
#define XB_XCNT(j)  (256  + 64 * (j))
#define XB_XSUB(j)  (1280 + 64 * (j))
#define XB_XGEN(j)  (2304 + 64 * (j))
#define XB_TOP      3328
#define XB_TOPGEN   3392
#define XCD_BAR_WORDS 3456
#define XB_SPIN_CAP (1u << 25)
__device__ __forceinline__ unsigned xb_ld(unsigned* p)              { return __hip_atomic_load(p, __ATOMIC_RELAXED, __HIP_MEMORY_SCOPE_AGENT); }
__device__ __forceinline__ unsigned xb_add(unsigned* p, unsigned v) { return __hip_atomic_fetch_add(p, v, __ATOMIC_RELAXED, __HIP_MEMORY_SCOPE_AGENT); }
__device__ __forceinline__ unsigned xb_xcc_id() { return (unsigned)__builtin_amdgcn_s_getreg((3 << 11) | 20) & 0xFu; }
#define XB_SPIN(cond, bar) do { unsigned _sp = 0; while (cond) { __builtin_amdgcn_s_sleep(1); \
    if ((++_sp & 255u) == 0u) { if (xb_ld(&(bar)[XB_TMO])) break; if (_sp > XB_SPIN_CAP) { atomicAdd(&(bar)[XB_TMO], 1u); break; } } } } while (0)
struct XcdBarrier { unsigned* bar; unsigned x; volatile LAS unsigned* st; };
__device__ __forceinline__ XcdBarrier xcd_barrier_post(unsigned* bar, volatile LAS unsigned* st) {
    XcdBarrier b; b.bar = bar; b.x = xb_xcc_id(); b.st = st;
    if (threadIdx.x == 0) (void)xb_add(&bar[XB_XCNT(b.x)], 1u);
    return b;
}
__device__ __forceinline__ void xcd_barrier_complete(unsigned* bar, unsigned x, unsigned& nloc, unsigned& nx) {
    const unsigned G = gridDim.x * gridDim.y * gridDim.z;
    unsigned sum, cnt, mine, sp = 0u;
    for (;;) {
        sum = 0u; cnt = 0u; mine = 0u;
#pragma unroll
        for (unsigned j = 0; j < 16; ++j) { const unsigned c = xb_ld(&bar[XB_XCNT(j)]); sum += c; cnt += (c > 0u) ? 1u : 0u; mine = (j == x) ? c : mine; }
        if (sum == G) break;
        __builtin_amdgcn_s_sleep(1);
        if ((++sp & 255u) == 0u) { if (xb_ld(&bar[XB_TMO])) break; if (sp > XB_SPIN_CAP) { atomicAdd(&bar[XB_TMO], 1u); break; } }
    }
    nloc = mine > 0u ? mine : 1u; nx = cnt > 0u ? cnt : 1u;
}
__device__ __forceinline__ void xcd_barrier(const XcdBarrier& b) {
    asm volatile("s_waitcnt vmcnt(0)" ::: "memory");
    __syncthreads();
    if (threadIdx.x == 0) {
        unsigned* bar = b.bar;
        __builtin_amdgcn_s_waitcnt(0);
        unsigned nloc = b.st[0], nx = b.st[1];
        if (nloc == 0u) { xcd_barrier_complete(bar, b.x, nloc, nx); b.st[0] = nloc; b.st[1] = nx; }
        const unsigned old = xb_add(&bar[XB_XSUB(b.x)], 1u);
        const unsigned gen = old / nloc;
        if (old + 1u == (gen + 1u) * nloc) {
            __builtin_amdgcn_fence(__ATOMIC_RELEASE, "agent");
            asm volatile("s_waitcnt vmcnt(0)" ::: "memory");
            const unsigned og = xb_add(&bar[XB_TOP], 1u);
            const unsigned tg = og / nx;
            if (og + 1u == (tg + 1u) * nx) xb_add(&bar[XB_TOPGEN], 1u);
            else XB_SPIN(xb_ld(&bar[XB_TOPGEN]) == tg, bar);
            __builtin_amdgcn_fence(__ATOMIC_ACQUIRE, "agent");
            xb_add(&bar[XB_XGEN(b.x)], 1u);
            asm volatile("s_waitcnt vmcnt(0)" ::: "memory");
        } else {
            XB_SPIN(xb_ld(&bar[XB_XGEN(b.x)]) == gen, bar);
            __builtin_amdgcn_fence(__ATOMIC_ACQUIRE, "agent");
            asm volatile("s_waitcnt vmcnt(0)" ::: "memory");
        }
    }
    __syncthreads();
}

struct Params { const float* in[25]; float* out; unsigned char* ws; };
enum { I_X = 0, I_C, I_WADA, I_BADA, I_GMIX, I_WIN, I_ARE, I_AIM, I_LOGDT, I_BRE, I_BIM, I_CRE, I_CIM, I_SD, I_WGLU, I_WAO, I_WOUT, I_GFFN, I_WR, I_BR, I_WGU, I_BGU, I_WD, I_BD, I_GFIN };

__device__ __forceinline__ int ilv(int n) { return n < 1024 ? ((n >> 7) * 256 + (n & 127)) : (((n - 1024) >> 7) * 256 + 128 + ((n - 1024) & 127)); }

__device__ __forceinline__ void transpose_item(const float* W, int K, int N, bf16* WT, bool interleave, LAS float* scr, int item, int lane) {
    const int nblk = N / 32, kb = item / nblk, nb = item % nblk, k0 = 64 * kb, n0 = 32 * nb;
#pragma unroll 8
    for (int i = 0; i < 32; ++i) { const int kk = 2 * i + (lane >> 5); scr[kk * 33 + (lane & 31)] = W[(size_t)(k0 + kk) * N + n0 + (lane & 31)]; }
    asm volatile("s_waitcnt lgkmcnt(0)" ::: "memory");
    const int c = lane & 7;
    const int r0 = interleave ? ilv(n0) : n0;
#pragma unroll
    for (int j = 0; j < 4; ++j) { const int n = (lane >> 3) + 8 * j; const LAS float* s = scr + (8 * c) * 33 + n;
        v4u o; o.x = pk2(s[0 * 33], s[1 * 33]); o.y = pk2(s[2 * 33], s[3 * 33]); o.z = pk2(s[4 * 33], s[5 * 33]); o.w = pk2(s[6 * 33], s[7 * 33]);
        *(v4u*)(WT + (size_t)(r0 + n) * K + k0 + 8 * c) = o; }
    asm volatile("s_waitcnt lgkmcnt(0)" ::: "memory");
}

template <class AP, class BP, class Epi>
__device__ __forceinline__ void ngemm_unit(LAS unsigned char* lds, int K, AP ap, BP bp, Epi epi) {
    LAS float* As = (LAS float*)lds;
    LAS float* Bs = As + 32 * 65;
    LAS float* Cs = Bs + 32 * 257;
    const int tid = threadIdx.x, rp = tid >> 4, cg = tid & 15;
    float acc[2][16];
#pragma unroll
    for (int i = 0; i < 2; ++i)
#pragma unroll
        for (int j = 0; j < 16; ++j) acc[i][j] = 0.f;
    const int arow = tid >> 3, akq = (tid & 7) * 4;
    const int bn = tid >> 1, bkh = (tid & 1) * 16;
    const bf16* aptr = ap(arow) + akq;
    const bf16* bptr = bp(bn) + bkh;
    for (int k0 = 0; k0 < K; k0 += 32) {
        const v2u av = *(const v2u*)(aptr + k0);
        const v4u bv0 = *(const v4u*)(bptr + k0), bv1 = *(const v4u*)(bptr + k0 + 8);
        __syncthreads();
        As[(akq + 0) * 65 + arow] = lo16(av.x); As[(akq + 1) * 65 + arow] = hi16(av.x); As[(akq + 2) * 65 + arow] = lo16(av.y); As[(akq + 3) * 65 + arow] = hi16(av.y);
        { float f[8]; unpack8(bv0, f);
#pragma unroll
          for (int i = 0; i < 8; ++i) Bs[(bkh + i) * 257 + bn] = f[i];
          unpack8(bv1, f);
#pragma unroll
          for (int i = 0; i < 8; ++i) Bs[(bkh + 8 + i) * 257 + bn] = f[i]; }
        __syncthreads();
#pragma unroll 4
        for (int kk = 0; kk < 32; ++kk) {
            const float a0 = As[kk * 65 + 2 * rp], a1 = As[kk * 65 + 2 * rp + 1];
#pragma unroll
            for (int j = 0; j < 16; ++j) { const float b = Bs[kk * 257 + cg + 16 * j]; acc[0][j] += a0 * b; acc[1][j] += a1 * b; }
        }
    }
#pragma unroll
    for (int i = 0; i < 2; ++i)
#pragma unroll
        for (int j = 0; j < 16; ++j) Cs[(2 * rp + i) * 257 + cg + 16 * j] = acc[i][j];
    __syncthreads();
#pragma unroll
    for (int i = 0; i < 2; ++i) {
        float v0[8], v1[8];
#pragma unroll
        for (int j = 0; j < 8; ++j) { v0[j] = Cs[(2 * rp + i) * 257 + 8 * cg + j]; v1[j] = Cs[(2 * rp + i) * 257 + 128 + 8 * cg + j]; }
        epi(2 * rp + i, 8 * cg, v0, v1);
    }
    __syncthreads();
}


namespace pg8 {
typedef short bf16x8 __attribute__((ext_vector_type(8)));
constexpr int BM = 256, BK = 64, HALF = 128, HTB = HALF * BK * 2, STAGE_BYTES = 8 * HTB, NXCD = 8, WGM = 8;
__host__ __device__ __forceinline__ int lds_byte(int r, int c) { const int st = (r >> 4) * 2 + (c >> 5), rr = r & 15, cc = c & 31, ob = rr * 64 + cc * 2; return st * 1024 + (ob ^ (((ob >> 9) & 1) << 5)); }
__host__ __device__ __forceinline__ void stage_rc(int b, int& R, int& C) { const int st = b / 1024, sb = b % 1024, swz = sb ^ (((sb >> 9) & 1) << 5); R = (st >> 1) * 16 + swz / 64; C = (st & 1) * 32 + (swz % 64) / 2; }
__host__ __device__ __forceinline__ int perm32(int rho) { const int n = rho >> 4, i = rho & 15; return 8 * (i >> 2) + 4 * n + (i & 3); }
struct Unit { int pm, pn, e, pad; const char* A; const char* B; };

struct DenseOrder {
    const char* A; const char* Bt; int nM, nN, nwg, G, c; size_t tstep;
    __device__ __forceinline__ void init(const void* A_, const void* Bt_, int M, int N, int K, int G_, int c_) { A = (const char*)A_; Bt = (const char*)Bt_; nM = M / BM; nN = N / BM; nwg = nM * nN; G = G_; c = c_; tstep = (size_t)BM * K * 2; }
    __device__ __forceinline__ bool next(int i, Unit& u) const {
        const long L = (long)i * G + c; if (L >= nwg) return false;
        int wgid = (int)L; { const int q = nwg / NXCD, r = nwg % NXCD, xcd = wgid % NXCD, off = wgid / NXCD; wgid = (xcd < r ? xcd * (q + 1) : r * (q + 1) + (xcd - r) * q) + off; }
        const int nig = WGM * nN, gid = wgid / nig, fm = gid * WGM, gsz = (nM - fm) < WGM ? (nM - fm) : WGM;
        u.pm = fm + ((wgid % nig) % gsz); u.pn = (wgid % nig) / gsz; u.e = 0; u.A = A + (size_t)u.pm * tstep; u.B = Bt + (size_t)u.pn * tstep; return true;
    }
    __device__ __forceinline__ unsigned rowoff(const Unit&, int) const { return 0u; }
};

template <class Epi, class Sched, bool GATHER>
__device__ __forceinline__ void gemm_phase(LAS unsigned char* lds, const int K, const Sched& S, const Epi& E, const int lda_ = 0) {
    int tid = threadIdx.x; asm volatile("" : "+v"(tid));
    const int wid = __builtin_amdgcn_readfirstlane(tid >> 6), lane = tid & 63, wr = wid >> 2, wc = wid & 3, fr = lane & 15, fq = lane >> 4;
    const int nt = K / BK, lda = lda_ ? lda_ : K;
    int sR[2], sC[2];
    unsigned voffA[2][2], nvoffA[2][2], voffB[2];
#pragma unroll
    for (int i = 0; i < 2; ++i) { int R, C; stage_rc(tid * 16 + i * 8192, R, C); sR[i] = R; sC[i] = C; const int Rb = (R & ~31) + perm32(R & 31);
        voffA[0][i] = (unsigned)(R * lda + C) * 2u; voffA[1][i] = (unsigned)((R + HALF) * lda + C) * 2u; voffB[i] = (unsigned)(Rb * K + C) * 2u;
        nvoffA[0][i] = voffA[0][i]; nvoffA[1][i] = voffA[1][i]; }
    const size_t kstep = (size_t)(BK * 2);
    const size_t hstep = (size_t)HALF * K * 2;
    const unsigned ldsw = (unsigned)wid * 1024u;
    const int aoff = lds_byte(wr * 64 + fr, fq * 8), boff = lds_byte(wc * 32 + fr, fq * 8);
#define PG8_SA(b, h) (((b) * 2 + (h)) * HTB)
#define PG8_SB(b, h) ((4 + (b) * 2 + (h)) * HTB)
#define PG8_STAGE(bufoff, gbase, v0, v1) do { \
        __builtin_amdgcn_global_load_lds((const unsigned*)((const char*)(gbase) + (v0)), (LAS unsigned*)(lds + (bufoff) + ldsw), 16, 0, 0); \
        __builtin_amdgcn_global_load_lds((const unsigned*)((const char*)(gbase) + (v1)), (LAS unsigned*)(lds + (bufoff) + ldsw + 8192), 16, 0, 0); } while (0)
#define PG8_LDA(dst, b, h) do { _Pragma("unroll") for (int m = 0; m < 4; ++m) _Pragma("unroll") for (int k = 0; k < 2; ++k) dst[m][k] = *(const LAS bf16x8*)(lds + PG8_SA(b, h) + aoff + m * 2048 + k * 1024); } while (0)
#define PG8_LDB(dst, b, h) do { _Pragma("unroll") for (int n = 0; n < 2; ++n) _Pragma("unroll") for (int k = 0; k < 2; ++k) dst[n][k] = *(const LAS bf16x8*)(lds + PG8_SB(b, h) + boff + n * 2048 + k * 1024); } while (0)
#define PG8_MMA(ai, bj, At, Bt) do { __builtin_amdgcn_s_setprio(1); _Pragma("unroll") for (int m = 0; m < 4; ++m) _Pragma("unroll") for (int n = 0; n < 2; ++n) _Pragma("unroll") for (int k = 0; k < 2; ++k) \
        acc[ai][bj][m][n] = __builtin_amdgcn_mfma_f32_16x16x32_bf16(Bt[n][k], At[m][k], acc[ai][bj][m][n], 0, 0, 0); __builtin_amdgcn_s_setprio(0); } while (0)
#define PG8_WAIT_V(n) asm volatile("s_waitcnt vmcnt(" #n ")" ::: "memory")
#define PG8_WAIT_L(n) asm volatile("s_waitcnt lgkmcnt(" #n ")" ::: "memory")
#define PG8_BAR __builtin_amdgcn_s_barrier()
#define PG8_SCHED __builtin_amdgcn_sched_barrier(0)
    Unit cur, nxt; int ui = 0;
    if (!S.next(0, cur)) return;
    if constexpr (GATHER) {
#pragma unroll
        for (int h = 0; h < 2; ++h)
#pragma unroll
            for (int i = 0; i < 2; ++i) voffA[h][i] = S.rowoff(cur, h * HALF + sR[i]) + (unsigned)sC[i] * 2u;
    }
    f32x4 acc[2][2][4][2];
#pragma unroll
    for (int a = 0; a < 2; ++a)
#pragma unroll
        for (int b = 0; b < 2; ++b)
#pragma unroll
            for (int m = 0; m < 4; ++m)
#pragma unroll
                for (int n = 0; n < 2; ++n) acc[a][b][m][n] = (f32x4){0.f, 0.f, 0.f, 0.f};
    bf16x8 At[4][2], B0[2][2], B1[2][2];
    const char* cA = cur.A; const char* cB = cur.B;
    PG8_STAGE(PG8_SB(0, 0), cB, voffB[0], voffB[1]); PG8_STAGE(PG8_SB(0, 1), cB + hstep, voffB[0], voffB[1]); PG8_STAGE(PG8_SA(0, 0), cA, voffA[0][0], voffA[0][1]); PG8_STAGE(PG8_SA(0, 1), cA, voffA[1][0], voffA[1][1]);
    if (wr == 1) PG8_BAR;
    PG8_WAIT_V(2); PG8_BAR;
    PG8_STAGE(PG8_SB(1, 0), cB + kstep, voffB[0], voffB[1]); PG8_STAGE(PG8_SA(1, 0), cA + kstep, voffA[0][0], voffA[0][1]); PG8_STAGE(PG8_SB(1, 1), cB + hstep + kstep, voffB[0], voffB[1]);
    PG8_WAIT_V(6); PG8_BAR;
    for (;;) {
        const bool has_next = S.next(ui + 1, nxt);
        const char* nA = has_next ? nxt.A : cA; const char* nB = has_next ? nxt.B : cB;
        if constexpr (GATHER) {
            if (has_next) {
#pragma unroll
                for (int h = 0; h < 2; ++h)
#pragma unroll
                    for (int i = 0; i < 2; ++i) nvoffA[h][i] = S.rowoff(nxt, h * HALF + sR[i]) + (unsigned)sC[i] * 2u;
            } else {
#pragma unroll
                for (int h = 0; h < 2; ++h)
#pragma unroll
                    for (int i = 0; i < 2; ++i) nvoffA[h][i] = voffA[h][i];
            }
        }
        for (int t = 0; t < nt; t += 2) {
            const bool last = (t == nt - 2);
            const char* a1 = cA + (size_t)(t + 1) * kstep;
            const char* a2 = last ? nA : cA + (size_t)(t + 2) * kstep; const char* b2 = last ? nB : cB + (size_t)(t + 2) * kstep;
            const char* a3 = a2 + kstep; const char* b3 = b2 + kstep;
            unsigned w00, w01, w10, w11;
            if constexpr (GATHER) { w00 = last ? nvoffA[0][0] : voffA[0][0]; w01 = last ? nvoffA[0][1] : voffA[0][1]; w10 = last ? nvoffA[1][0] : voffA[1][0]; w11 = last ? nvoffA[1][1] : voffA[1][1]; }
            else { w00 = voffA[0][0]; w01 = voffA[0][1]; w10 = voffA[1][0]; w11 = voffA[1][1]; }
            PG8_LDB(B0, 0, 0); PG8_LDB(B1, 0, 1); PG8_SCHED; PG8_LDA(At, 0, 0); PG8_STAGE(PG8_SA(1, 1), a1, voffA[1][0], voffA[1][1]);
            PG8_WAIT_V(8); PG8_WAIT_L(0); PG8_BAR; PG8_MMA(0, 0, At, B0); PG8_MMA(0, 1, At, B1); PG8_BAR; PG8_SCHED;
            PG8_LDA(At, 0, 1); PG8_STAGE(PG8_SB(0, 0), b2, voffB[0], voffB[1]); PG8_STAGE(PG8_SB(0, 1), b2 + hstep, voffB[0], voffB[1]); PG8_STAGE(PG8_SA(0, 0), a2, w00, w01);
            PG8_WAIT_V(8); PG8_WAIT_L(0); PG8_BAR; PG8_MMA(1, 0, At, B0); PG8_MMA(1, 1, At, B1); PG8_BAR; PG8_SCHED;
            PG8_LDB(B0, 1, 0); PG8_LDB(B1, 1, 1); PG8_SCHED; PG8_LDA(At, 1, 0); PG8_STAGE(PG8_SA(0, 1), a2, w10, w11);
            PG8_WAIT_V(8); PG8_WAIT_L(0); PG8_BAR; PG8_MMA(0, 0, At, B0); PG8_MMA(0, 1, At, B1); PG8_BAR; PG8_SCHED;
            PG8_LDA(At, 1, 1); PG8_STAGE(PG8_SB(1, 0), b3, voffB[0], voffB[1]); PG8_STAGE(PG8_SB(1, 1), b3 + hstep, voffB[0], voffB[1]); PG8_STAGE(PG8_SA(1, 0), a3, w00, w01);
            PG8_WAIT_V(8); PG8_WAIT_L(0); PG8_BAR; PG8_MMA(1, 0, At, B0); PG8_MMA(1, 1, At, B1); PG8_BAR; PG8_SCHED;
        }
        if (wr == 0) PG8_BAR;
        E(acc, cur, wr, wc, fr, fq);
        if (!has_next) break;
#pragma unroll
        for (int a = 0; a < 2; ++a)
#pragma unroll
            for (int b = 0; b < 2; ++b)
#pragma unroll
                for (int m = 0; m < 4; ++m)
#pragma unroll
                    for (int n = 0; n < 2; ++n) acc[a][b][m][n] = (f32x4){0.f, 0.f, 0.f, 0.f};
        cur = nxt; cA = nA; cB = nB; ++ui;
        if constexpr (GATHER) {
#pragma unroll
            for (int h = 0; h < 2; ++h)
#pragma unroll
                for (int i = 0; i < 2; ++i) voffA[h][i] = nvoffA[h][i];
        }
        if (wr == 1) PG8_BAR;
    }
    PG8_WAIT_V(0);
    PG8_BAR;
#undef PG8_SA
#undef PG8_SB
#undef PG8_STAGE
#undef PG8_LDA
#undef PG8_LDB
#undef PG8_MMA
#undef PG8_WAIT_V
#undef PG8_WAIT_L
#undef PG8_BAR
#undef PG8_SCHED
}

template <class F> struct EpiRows {
    F f;
    __device__ __forceinline__ void operator()(const f32x4 (&acc)[2][2][4][2], const Unit& u, int wr, int wc, int fr, int fq) const {
#pragma unroll
        for (int ai = 0; ai < 2; ++ai)
#pragma unroll
            for (int m = 0; m < 4; ++m) {
                float v0[8], v1[8];
#pragma unroll
                for (int j = 0; j < 4; ++j) { v0[j] = acc[ai][0][m][0][j]; v0[4 + j] = acc[ai][0][m][1][j]; v1[j] = acc[ai][1][m][0][j]; v1[4 + j] = acc[ai][1][m][1][j]; }
                f(u, ai * HALF + wr * 64 + m * 16 + fr, wc * 32 + 8 * fq, v0, v1);
            }
    }
};
template <class F> __device__ __forceinline__ EpiRows<F> make_epi(F f) { return EpiRows<F>{f}; }
}

struct MoeOrder {
    const char* A; const char* Bt; const int* tile_e; const int* rowtok; int nt, npn, G, c, tpg, K; bool gather; size_t estride, tstep;
    __device__ __forceinline__ void init(const void* A_, const void* Bt_, const int* tile_e_, const int* rowtok_, int npn_, size_t estride_, int K_, int G_, int c_, bool gather_) {
        A = (const char*)A_; Bt = (const char*)Bt_; tile_e = tile_e_; rowtok = rowtok_; npn = npn_; estride = estride_; K = K_; G = G_; c = c_; gather = gather_;
        nt = tile_e_[1023]; tpg = (G / 8) / npn; tstep = (size_t)256 * K_ * 2;
    }
    __device__ __forceinline__ bool next(int i, pg8::Unit& u) const {
        const int xc = c & 7, ci = c >> 3, group = i * 8 + xc, tile = group * tpg + ci / npn;
        if (tile >= nt) return false;
        u.pm = tile; u.pn = ci % npn; u.e = tile_e[tile];
        u.A = gather ? A : A + (size_t)tile * tstep; u.B = Bt + (size_t)u.e * estride + (size_t)u.pn * tstep; return true;
    }
    __device__ __forceinline__ unsigned rowoff(const pg8::Unit& u, int r) const { const int rt = rowtok[u.pm * 256 + r]; return (unsigned)(rt < 0 ? 0 : (rt >> 2)) * (unsigned)(K * 2); }
};


struct S5Order {
    const char* A; const char* Bt; int npn, c, G; size_t bstride, btile;
    __device__ __forceinline__ void init(const void* A_, const void* Bt_, int npn_, size_t bstride_, size_t btile_, int G_, int c_) { A = (const char*)A_; Bt = (const char*)Bt_; npn = npn_; bstride = bstride_; btile = btile_; G = G_; c = c_; }
    __device__ __forceinline__ bool next(int i, pg8::Unit& u) const {
        if (i > 0) return false;
        const int xc = c & 7, ci = c >> 3, per = 4 * npn;
        if (ci >= 4 * per) return false;
        const int g = 4 * xc + ci / per, rem = ci % per;
        u.e = g; u.pm = rem / npn; u.pn = rem % npn;
        u.A = A + ((size_t)g * 1024 + (size_t)u.pm * 256) * 640 * 2; u.B = Bt + (size_t)g * bstride + (size_t)u.pn * btile; return true;
    }
    __device__ __forceinline__ unsigned rowoff(const pg8::Unit&, int) const { return 0u; }
};

struct EpiInProj {
    unsigned char* ws;
    __device__ __forceinline__ void operator()(const f32x4 (&acc)[2][2][4][2], const pg8::Unit& u, int wr, int wc, int fr, int fq) const {
        const int pn = u.pn;
        size_t boff; int ld, cb;
        if (pn < 8) { boff = WS_U + (size_t)(pn >> 1) * (32 * MiB); ld = 512; cb = 256 * (pn & 1); }
        else { boff = WS_GA + (size_t)((pn - 8) >> 2) * (64 * MiB); ld = 1024; cb = 256 * ((pn - 8) & 3); }
        const int c8 = wc * 32 + 8 * fq;
        const bool rot = (pn >= 2 && pn < 6), isk = (pn == 4 || pn == 5);
        const bool t1 = (c8 & 63) == 0, t2 = (c8 & 63) == 8;
        const float* ROT = (const float*)(ws + WS_ROT);
        float cs0[8], cs1[8];
#pragma unroll
        for (int j = 0; j < 8; ++j) { cs0[j] = 0.f; cs1[j] = 0.f; }
#pragma unroll
        for (int ai = 0; ai < 2; ++ai)
#pragma unroll
            for (int m = 0; m < 4; ++m) {
                const int r = ai * 128 + wr * 64 + m * 16 + fr, row = u.pm * 256 + r;
                float v0[8], v1[8];
#pragma unroll
                for (int j = 0; j < 4; ++j) { v0[j] = acc[ai][0][m][0][j]; v0[4 + j] = acc[ai][0][m][1][j]; v1[j] = acc[ai][1][m][0][j]; v1[4 + j] = acc[ai][1][m][1][j]; }
                if (rot) {
                    float o0[8], o1[8];
#pragma unroll
                    for (int j = 0; j < 8; ++j) { o0[j] = __shfl_xor(v0[j], 16); o1[j] = __shfl_xor(v1[j], 16); }
                    if (t1 || t2) {
                        const f32x4* rp = (const f32x4*)(ROT + (size_t)(row & (SEQ - 1)) * 16);
                        const f32x4 q0 = rp[0], q1 = rp[1], q2 = rp[2], q3 = rp[3];
                        const float cs[8] = {q0.x, q0.z, q1.x, q1.z, q2.x, q2.z, q3.x, q3.z}, sn[8] = {q0.y, q0.w, q1.y, q1.w, q2.y, q2.w, q3.y, q3.w};
#pragma unroll
                        for (int j = 0; j < 8; ++j) {
                            v0[j] = t1 ? (v0[j] * cs[j] - o0[j] * sn[j]) : (v0[j] * cs[j] + o0[j] * sn[j]);
                            v1[j] = t1 ? (v1[j] * cs[j] - o1[j] * sn[j]) : (v1[j] * cs[j] + o1[j] * sn[j]);
                        }
                    }
                }
                if (isk) {
#pragma unroll
                    for (int j = 0; j < 8; ++j) { cs0[j] += v0[j]; cs1[j] += v1[j]; }
                }
                if (pn < 2) {
                    const int col = 256 * pn + c8, R = row >> 5, sl = row & 31;
                    bf16* ug = (bf16*)(ws + WS_UG);
                    *(v4u*)(ug + ((size_t)(col >> 4) * 1024 + R) * 640 + sl * 16 + (col & 15)) = pack8(v0);
                    *(v4u*)(ug + ((size_t)((col + 128) >> 4) * 1024 + R) * 640 + sl * 16 + (col & 15)) = pack8(v1);
                } else {
                    bf16* o = (bf16*)(ws + boff) + (size_t)row * ld + cb + c8;
                    *(v4u*)o = pack8(v0); *(v4u*)(o + 128) = pack8(v1);
                }
            }
        if (isk) {
#pragma unroll
            for (int j = 0; j < 8; ++j) {
#pragma unroll
                for (int o = 1; o < 16; o <<= 1) { cs0[j] += __shfl_xor(cs0[j], o); cs1[j] += __shfl_xor(cs1[j], o); }
            }
            if (fr == 0) {
                const int b = u.pm >> 5, jb = u.pm & 31, d = c8 & 63, h0 = 4 * (pn - 4) + (wc >> 1);
                float* kp = (float*)(ws + WS_KMEAN) + (size_t)wr * (BATCH * NH * 32 * 64);
                float* p0 = kp + ((b * NH + h0) * 32 + jb) * 64 + d; float* p1 = kp + ((b * NH + h0 + 2) * 32 + jb) * 64 + d;
                *(f32x4*)p0 = (f32x4){cs0[0], cs0[1], cs0[2], cs0[3]}; *(f32x4*)(p0 + 4) = (f32x4){cs0[4], cs0[5], cs0[6], cs0[7]};
                *(f32x4*)p1 = (f32x4){cs1[0], cs1[1], cs1[2], cs1[3]}; *(f32x4*)(p1 + 4) = (f32x4){cs1[4], cs1[5], cs1[6], cs1[7]};
            }
        }
    }
};

typedef short bf16x8_t __attribute__((ext_vector_type(8)));
typedef short v4i16_t __attribute__((ext_vector_type(4)));
typedef float f32x2_t __attribute__((ext_vector_type(2))); typedef __bf16 bf16x2_t __attribute__((ext_vector_type(2)));
__device__ __forceinline__ unsigned cvtpk(float lo, float hi) { f32x2_t v = {lo, hi}; bf16x2_t b = __builtin_convertvector(v, bf16x2_t); return __builtin_bit_cast(unsigned, b); }
constexpr int AT_STRIDE = 160, AT_K = 0, AT_V = 256 * AT_STRIDE, AT_PRE = 2 * 256 * AT_STRIDE, AT_CN = AT_PRE + 4096, AT_WT = AT_CN + 4096;

__device__ __forceinline__ void attn_load_kv(LAS unsigned char* lds, const bf16* Kb, const bf16* Vb, size_t row0, int h, int tid) {
    v4u kv[4], vv[4];
#pragma unroll
    for (int i = 0; i < 4; ++i) { const int ch = tid + 512 * i, row = ch >> 3, cc = ch & 7;
        kv[i] = *(const v4u*)(Kb + (row0 + row) * 512 + h * 64 + cc * 8); vv[i] = *(const v4u*)(Vb + (row0 + row) * 512 + h * 64 + cc * 8); }
#pragma unroll
    for (int i = 0; i < 4; ++i) { const int ch = tid + 512 * i, row = ch >> 3, cc = ch & 7;
        *(LAS v4u*)(lds + AT_K + row * AT_STRIDE + cc * 16) = kv[i]; *(LAS v4u*)(lds + AT_V + row * AT_STRIDE + cc * 16) = vv[i]; }
}
template <bool CAUSAL>
__device__ __forceinline__ void attn_tile(LAS unsigned char* lds, const bf16x8_t (&qf)[2], int qloc, int lane, f32x4 (&o)[4], float& mrow, float& lrow) {
    const int fr = lane & 15, fq = lane >> 4;
    f32x4 acc[16];
#pragma unroll
    for (int kb = 0; kb < 16; ++kb) {
        const LAS unsigned char* kp = lds + AT_K + (16 * kb + fr) * AT_STRIDE + fq * 16;
        const bf16x8_t a0 = *(const LAS bf16x8_t*)kp, a1 = *(const LAS bf16x8_t*)(kp + 64);
        f32x4 z = (f32x4){0.f, 0.f, 0.f, 0.f};
        z = __builtin_amdgcn_mfma_f32_16x16x32_bf16(a0, qf[0], z, 0, 0, 0);
        acc[kb] = __builtin_amdgcn_mfma_f32_16x16x32_bf16(a1, qf[1], z, 0, 0, 0);
    }
    if (CAUSAL) {
#pragma unroll
        for (int kb = 0; kb < 16; ++kb)
#pragma unroll
            for (int r = 0; r < 4; ++r) if (16 * kb + 4 * fq + r > qloc) acc[kb][r] = -1e30f;
    }
    float m = acc[0][0];
#pragma unroll
    for (int kb = 0; kb < 16; ++kb)
#pragma unroll
        for (int r = 0; r < 4; ++r) m = fmaxf(m, acc[kb][r]);
    m = fmaxf(m, __shfl_xor(m, 16)); m = fmaxf(m, __shfl_xor(m, 32));
    const float c = 0.125f * 1.4426950408889634f;
    float ls = 0.f;
#pragma unroll
    for (int kb = 0; kb < 16; ++kb)
#pragma unroll
        for (int r = 0; r < 4; ++r) { const float p = __builtin_amdgcn_exp2f((acc[kb][r] - m) * c); ls += p; acc[kb][r] = p; }
    ls += __shfl_xor(ls, 16); ls += __shfl_xor(ls, 32);
#pragma unroll
    for (int db = 0; db < 4; ++db) o[db] = (f32x4){0.f, 0.f, 0.f, 0.f};
    const LAS unsigned char* vbase = lds + AT_V + (4 * fq + (fr >> 2)) * AT_STRIDE + (fr & 3) * 8;
#pragma unroll
    for (int ks = 0; ks < 8; ++ks) {
        v4u pw; pw.x = cvtpk(acc[2 * ks][0], acc[2 * ks][1]); pw.y = cvtpk(acc[2 * ks][2], acc[2 * ks][3]); pw.z = cvtpk(acc[2 * ks + 1][0], acc[2 * ks + 1][1]); pw.w = cvtpk(acc[2 * ks + 1][2], acc[2 * ks + 1][3]);
        const bf16x8_t pf = __builtin_bit_cast(bf16x8_t, pw);
#pragma unroll
        for (int db = 0; db < 4; ++db) {
            const v4i16_t lo = __builtin_amdgcn_ds_read_tr16_b64_v4i16((LAS v4i16_t*)(vbase + (32 * ks) * AT_STRIDE + db * 32));
            const v4i16_t hi = __builtin_amdgcn_ds_read_tr16_b64_v4i16((LAS v4i16_t*)(vbase + (32 * ks + 16) * AT_STRIDE + db * 32));
            const bf16x8_t vt = (bf16x8_t){lo[0], lo[1], lo[2], lo[3], hi[0], hi[1], hi[2], hi[3]};
            o[db] = __builtin_amdgcn_mfma_f32_16x16x32_bf16(vt, pf, o[db], 0, 0, 0);
        }
    }
    mrow = m; lrow = ls;
}

__device__ __forceinline__ const void* ldptr(LAS unsigned char* lds, int i) {
    const unsigned long long v = ((volatile LAS unsigned long long*)(lds + LDS_PAR))[i];
    const unsigned lo = __builtin_amdgcn_readfirstlane((unsigned)v), hi = __builtin_amdgcn_readfirstlane((unsigned)(v >> 32));
    return (const void*)(const GAS void*)(((unsigned long long)hi << 32) | lo);
}
#define INP(i) ((const float*)ldptr(lds, (i)))
#define WSB() ((unsigned char*)ldptr(lds, 26))
__global__ void __launch_bounds__(NTHR, 2) mega_fwd(Params P) {
    extern __shared__ __attribute__((aligned(16))) unsigned char lds_raw[];
    LAS unsigned char* lds = (LAS unsigned char*)lds_raw;
    volatile LAS unsigned* MISC = (volatile LAS unsigned*)(lds + LDS_MISC);
    const int tid = threadIdx.x, lane = tid & 63, wave = __builtin_amdgcn_readfirstlane(tid >> 6);
    const int G = gridDim.x, bid = blockIdx.x;
    const int gw = bid * NWAVES + wave, NGW = G * NWAVES;
    if (tid < 128) MISC[tid] = 0u;
    if (tid < 25) ((LAS unsigned long long*)(lds + LDS_PAR))[tid] = (unsigned long long)P.in[tid];
    if (tid == 25) ((LAS unsigned long long*)(lds + LDS_PAR))[25] = (unsigned long long)P.out;
    if (tid == 26) ((LAS unsigned long long*)(lds + LDS_PAR))[26] = (unsigned long long)P.ws;
    __syncthreads();
    XcdBarrier bar = xcd_barrier_post((unsigned*)(P.ws + WS_CTL) + 1024, MISC + 8);

    {
        unsigned char* ws = WSB(); float* MOD = (float*)(ws + WS_MOD); float* ROT = (float*)(ws + WS_ROT);
        for (int it = gw; it < 6144 / 64; it += NGW) {
            const int j = it * 64 + lane;
            float a0 = 0.f, a1 = 0.f, a2 = 0.f, a3 = 0.f;
            const float* c = INP(I_C); const float* w = INP(I_WADA);
#pragma unroll 8
            for (int k = 0; k < 1024; ++k) {
                const float wv = w[(size_t)k * 6144 + j];
                const float c0 = c[k], c1 = c[1024 + k], c2 = c[2048 + k], c3 = c[3072 + k];
                a0 += c0 * sigm(c0) * wv; a1 += c1 * sigm(c1) * wv; a2 += c2 * sigm(c2) * wv; a3 += c3 * sigm(c3) * wv;
            }
            const float bb = INP(I_BADA)[j];
            MOD[j] = a0 + bb; MOD[6144 + j] = a1 + bb; MOD[2 * 6144 + j] = a2 + bb; MOD[3 * 6144 + j] = a3 + bb;
        }
        for (int i = bid * NTHR + tid; i < SEQ * 8; i += G * NTHR) {
            const int s = i >> 3, d = i & 7;
            const float inv = 1.0f / powf(500000.0f, (float)(2 * d) / 16.0f);
            const float ang = (float)s * inv;
            float sn, cs; sincosf(ang, &sn, &cs);
            ROT[2 * i] = cs; ROT[2 * i + 1] = sn;
        }
        if (bid < NG) {
            const int g = bid;
            LAS float* APr = (LAS float*)lds;
            LAS float* APi = APr + 33 * 64;
            LAS float* BBr = APi + 33 * 64;
            LAS float* BBi = BBr + 1024;
            LAS float* CCr = BBi + 1024;
            LAS float* CCi = CCr + 1024;
            LAS float* KRN = CCi + 1024;
            const float dt = expf(INP(I_LOGDT)[g]);
            const float* are = INP(I_ARE) + g * 64; const float* aim = INP(I_AIM) + g * 64;
            for (int i = tid; i < 33 * 64; i += NTHR) { const int lag = i >> 6, p = i & 63; const float lr = are[p], li = aim[p];
                const float mg = expf(lr * dt * (float)lag); float sn, cs; sincosf(li * dt * (float)lag, &sn, &cs); APr[i] = mg * cs; APi[i] = mg * sn; }
            { const float* pbre = INP(I_BRE) + g * 1024; const float* pbim = INP(I_BIM) + g * 1024; const float* pcre = INP(I_CRE) + g * 1024; const float* pcim = INP(I_CIM) + g * 1024;
              for (int i = tid; i < 1024; i += NTHR) { const int p = i >> 4; const float lr = are[p], li = aim[p];
                const float mg = expf(lr * dt); float sn, cs; sincosf(li * dt, &sn, &cs); const float ar = mg * cs, ai = mg * sn, den = lr * lr + li * li;
                const float cfr = ((ar - 1.f) * lr + ai * li) / den, cfi = (ai * lr - (ar - 1.f) * li) / den;
                const float br = pbre[i], bi = pbim[i]; BBr[i] = cfr * br - cfi * bi; BBi[i] = cfr * bi + cfi * br;
                CCr[i] = pcre[i]; CCi[i] = pcim[i]; } }
            __syncthreads();
            for (int i = tid; i < 32 * 256; i += NTHR) { const int lag = i >> 8, co = (i >> 4) & 15, ci = i & 15; float a = 0.f;
                for (int p = 0; p < 64; ++p) { const float cr = CCr[co * 64 + p], cim = CCi[co * 64 + p], pr = APr[lag * 64 + p], pi = APi[lag * 64 + p];
                    const float car = cr * pr - cim * pi, cai = cr * pi + cim * pr; a += car * BBr[p * 16 + ci] - cai * BBi[p * 16 + ci]; }
                KRN[i] = a; }
            __syncthreads();
            bf16* T = (bf16*)(ws + WS_S5T) + (size_t)g * 512 * 640;
            for (int ch = tid; ch < 512 * 80; ch += NTHR) { const int row = ch / 80, col = (ch % 80) * 8, t = row >> 4, co = row & 15; float f[8];
                if (col < 512) { const int sx = col >> 4, ci0 = col & 15;
#pragma unroll
                    for (int j = 0; j < 8; ++j) f[j] = (sx <= t) ? KRN[((t - sx) * 16 + co) * 16 + ci0 + j] : 0.f; }
                else { const int cx = col - 512, ri = cx >> 6, p0 = cx & 63;
#pragma unroll
                    for (int j = 0; j < 8; ++j) { const int p = p0 + j; const float cr = CCr[co * 64 + p], cim = CCi[co * 64 + p], pr = APr[(t + 1) * 64 + p], pi = APi[(t + 1) * 64 + p];
                        f[j] = ri ? -(cr * pi + cim * pr) : (cr * pr - cim * pi); } }
                *(v4u*)(T + (size_t)row * 640 + col) = pack8(f); }
            bf16* W1 = (bf16*)(ws + WS_S5W) + (size_t)g * 256 * 512;
            for (int ch = tid; ch < 256 * 64; ch += NTHR) { const int row = ch >> 6, col = (ch & 63) * 8; float f[8];
                if (row < 128) { const int ri = row >> 6, p = row & 63, sx = col >> 4, ci0 = col & 15; const float pr = APr[(31 - sx) * 64 + p], pi = APi[(31 - sx) * 64 + p];
#pragma unroll
                    for (int j = 0; j < 8; ++j) { const float br = BBr[p * 16 + ci0 + j], bi = BBi[p * 16 + ci0 + j]; f[j] = ri ? (pr * bi + pi * br) : (pr * br - pi * bi); } }
                else {
#pragma unroll
                    for (int j = 0; j < 8; ++j) f[j] = 0.f; }
                *(v4u*)(W1 + (size_t)row * 512 + col) = pack8(f); }
            __syncthreads();
        }
        LAS float* scr = (LAS float*)(lds + wave * 16384);
        constexpr int I_IN = 16 * 128, I_GL = 8 * 64, I_AO = 8 * 32, I_OU = 16 * 32, I_GU1 = 16 * 64, I_D1 = 16 * 32;
        constexpr int NIT = I_IN + I_GL + I_AO + I_OU + NE * I_GU1 + NE * I_D1;
        for (int it = gw; it < NIT; it += NGW) {
            int r = it;
            if (r < I_IN) { transpose_item(INP(I_WIN), 1024, 4096, (bf16*)(ws + WS_WIN), false, scr, r, lane); continue; } r -= I_IN;
            if (r < I_GL) { transpose_item(INP(I_WGLU), 512, 2048, (bf16*)(ws + WS_WGLU), true, scr, r, lane); continue; } r -= I_GL;
            if (r < I_AO) { transpose_item(INP(I_WAO), 512, 1024, (bf16*)(ws + WS_WAO), false, scr, r, lane); continue; } r -= I_AO;
            if (r < I_OU) { transpose_item(INP(I_WOUT), 1024, 1024, (bf16*)(ws + WS_WOUT), false, scr, r, lane); continue; } r -= I_OU;
            if (r < NE * I_GU1) { const int e = r / I_GU1; transpose_item(INP(I_WGU) + (size_t)e * 1024 * 2048, 1024, 2048, (bf16*)(ws + WS_WGU) + (size_t)e * 2048 * 1024, true, scr, r % I_GU1, lane); continue; } r -= NE * I_GU1;
            { const int e = r / I_D1; transpose_item(INP(I_WD) + (size_t)e * 1024 * 1024, 1024, 1024, (bf16*)(ws + WS_WD) + (size_t)e * 1024 * 1024, false, scr, r % I_D1, lane); }
        }
    }
    xcd_barrier(bar);

    { unsigned char* ws = WSB(); const float* x = INP(I_X); const float* gmix = INP(I_GMIX); const float* MOD = (const float*)(ws + WS_MOD); bf16* Hb = (bf16*)(ws + WS_H);
    for (int m = gw; m < NTOK; m += NGW) {
        const int b = m >> 13;
        const f32x4* xr = (const f32x4*)(x + (size_t)m * DM) + lane;
        f32x4 v[4]; float s = 0.f;
#pragma unroll
        for (int j = 0; j < 4; ++j) { v[j] = xr[64 * j]; s += (v[j].x * v[j].x + v[j].y * v[j].y) + (v[j].z * v[j].z + v[j].w * v[j].w); }
        const float r = rsqrtf(wave_sum(s) * (1.f / DM) + RMS_EPS);
        v2u* o8 = (v2u*)(Hb + (size_t)m * DM) + lane;
#pragma unroll
        for (int j = 0; j < 4; ++j) {
            const int col = 4 * lane + 256 * j;
            const f32x4 g = *(const f32x4*)(gmix + col);
            const f32x4 sh = *(const f32x4*)(MOD + b * 6144 + col), sc = *(const f32x4*)(MOD + b * 6144 + 1024 + col);
            v2u w; w.x = pk2(v[j].x * r * g.x * (1.f + sc.x) + sh.x, v[j].y * r * g.y * (1.f + sc.y) + sh.y);
            w.y = pk2(v[j].z * r * g.z * (1.f + sc.z) + sh.z, v[j].w * r * g.w * (1.f + sc.w) + sh.w);
            o8[64 * j] = w;
        }
    } }
    xcd_barrier(bar);

    { unsigned char* ws = WSB();
      pg8::DenseOrder S; S.init(ws + WS_H, ws + WS_WIN, NTOK, INW, 1024, G, bid);
      EpiInProj E{ws};
      pg8::gemm_phase<EpiInProj, pg8::DenseOrder, false>(lds, 1024, S, E);
    }
    xcd_barrier(bar);

    { unsigned char* ws = WSB();
      S5Order S; S.init(ws + WS_UG, ws + WS_S5W, 1, (size_t)256 * 512 * 2, 0, G, bid);
      auto E = pg8::make_epi([=](const pg8::Unit& u, int r, int c8, const float (&v0)[8], const float (&v1)[8]) {
          float* xe = (float*)(ws + WS_XE) + ((size_t)u.e * 1024 + u.pm * 256 + r) * 128 + c8;
          *(f32x4*)xe = (f32x4){v0[0], v0[1], v0[2], v0[3]}; *(f32x4*)(xe + 4) = (f32x4){v0[4], v0[5], v0[6], v0[7]};
      });
      pg8::gemm_phase<decltype(E), S5Order, false>(lds, 512, S, E, 640);
    }
    { unsigned char* ws = WSB();
      const bf16* Qb_ = (const bf16*)(ws + WS_Q); const float* km0 = (const float*)(ws + WS_KMEAN);
      int* acnt = (int*)(ws + WS_ACNT); unsigned short* alist = (unsigned short*)(ws + WS_ALIST);
      for (int it = gw; it < BATCH * NH * 128; it += NGW) {
        const int b = it >> 10, h = (it >> 7) & 7, chk = it & 127, s_ = chk * 64 + lane, nb = chk >> 2;
        if (nb == 0) continue;
        const size_t qrow = (size_t)b * SEQ + s_;
        v4u qp[8];
#pragma unroll
        for (int i = 0; i < 8; ++i) qp[i] = ((const v4u*)(Qb_ + qrow * 512 + h * 64))[i];
        float g0 = -INFINITY, g1 = -INFINITY, g2 = -INFINITY; int s0 = 0, s1 = 0, s2 = 0;
        for (int j = 0; j < nb; ++j) {
            const float* km = km0 + ((b * NH + h) * 32 + j) * 64;
            float g = 0.f;
#pragma unroll
            for (int i = 0; i < 8; ++i) { float f[8]; unpack8(qp[i], f);
#pragma unroll
                for (int jj = 0; jj < 8; ++jj) g += f[jj] * (km[8 * i + jj] + km[BATCH * NH * 32 * 64 + 8 * i + jj]); }
            if (g > g0) { g2 = g1; s2 = s1; g1 = g0; s1 = s0; g0 = g; s0 = j; }
            else if (g > g1) { g2 = g1; s2 = s1; g1 = g; s1 = j; }
            else if (g > g2) { g2 = g; s2 = j; }
        }
        const int nsel = nb < 3 ? nb : 3;
        if (nsel < 2) s1 = -1;
        if (nsel < 3) s2 = -1;
        int myn = 0;
        for (int j = 0; j < nb; ++j) { const bool mt = (s0 == j) || (s1 == j) || (s2 == j); const unsigned long long mask = __ballot(mt); if (lane == j) myn = __popcll(mask); }
        int basev = 0;
        if (lane < nb && myn > 0) basev = atomicAdd(&acnt[(b * NH + h) * 32 + lane], myn);
        for (int j = 0; j < nb; ++j) {
            const bool mt = (s0 == j) || (s1 == j) || (s2 == j); const unsigned long long mask = __ballot(mt); const int base = __shfl(basev, j);
            if (mt) { const int slot = (s0 == j) ? 0 : ((s1 == j) ? 1 : 2); const int pos = base + __popcll(mask & ((1ull << lane) - 1ull));
                alist[(size_t)((b * NH + h) * 32 + j) * 8192 + pos] = (unsigned short)(s_ | (slot << 13)); }
        }
      }
    }
    xcd_barrier(bar);

    if (gw < BATCH * NG) {
        unsigned char* ws = WSB();
        const int b = gw >> 5, g = gw & 31, p = lane;
        const float lr = INP(I_ARE)[g * 64 + p], li = INP(I_AIM)[g * 64 + p], dt = expf(INP(I_LOGDT)[g]);
        const float mg = expf(lr * dt * 32.f); float sn, cs; sincosf(li * dt * 32.f, &sn, &cs);
        const float ar = mg * cs, ai = mg * sn;
        const float* xe = (const float*)(ws + WS_XE) + ((size_t)g * 1024 + b * 256) * 128 + p;
        bf16* xp = (bf16*)(ws + WS_UG) + ((size_t)g * 1024 + b * 256) * 640 + 512 + p;
        float xr = 0.f, xi = 0.f;
        for (int k0 = 0; k0 < 256; k0 += 8) {
            float er[8], ei[8];
#pragma unroll
            for (int k = 0; k < 8; ++k) { er[k] = xe[(size_t)(k0 + k) * 128]; ei[k] = xe[(size_t)(k0 + k) * 128 + 64]; }
#pragma unroll
            for (int k = 0; k < 8; ++k) {
                xp[(size_t)(k0 + k) * 640] = (bf16)f2bf(xr); xp[(size_t)(k0 + k) * 640 + 64] = (bf16)f2bf(xi);
                const float nr = ar * xr - ai * xi + er[k], ni = ar * xi + ai * xr + ei[k]; xr = nr; xi = ni;
            }
        }
    }
    { unsigned char* ws = WSB();
      const bf16* Qb_ = (const bf16*)(ws + WS_Q); const bf16* Kb_ = (const bf16*)(ws + WS_K); const bf16* Vb_ = (const bf16*)(ws + WS_V);
      const int* acnt = (const int*)(ws + WS_ACNT); const unsigned short* alist = (const unsigned short*)(ws + WS_ALIST);
      bf16* part = (bf16*)(ws + WS_PART); float* lsep = (float*)(ws + WS_LSE);
      LAS int* pre = (LAS int*)(lds + AT_PRE); LAS int* cn = (LAS int*)(lds + AT_CN); LAS int* wt = (LAS int*)(lds + AT_WT);
      __syncthreads();
      { const int c0 = acnt[2 * tid], c1 = acnt[2 * tid + 1]; cn[2 * tid] = c0; cn[2 * tid + 1] = c1;
        const int n0 = (c0 + 127) >> 7, n1 = (c1 + 127) >> 7; int v = n0 + n1;
#pragma unroll
        for (int o = 1; o < 64; o <<= 1) { const int t = __shfl_up(v, o); if (lane >= o) v += t; }
        if (lane == 63) wt[wave] = v;
        __syncthreads();
        int off = 0;
        for (int w = 0; w < wave; ++w) off += wt[w];
        pre[2 * tid] = off + v - n1; pre[2 * tid + 1] = off + v; }
      __syncthreads();
      const int total = pre[1023];
      for (int item = bid; item < total; item += G) {
          int lo = 0, hi = 1023;
          while (lo < hi) { const int mid = (lo + hi) >> 1; if (pre[mid] > item) hi = mid; else lo = mid + 1; }
          const int l = lo, seg = item - (l ? pre[l - 1] : 0), cnt = cn[l];
          const int b = l >> 8, h = (l >> 5) & 7, j = l & 31;
          __syncthreads();
          attn_load_kv(lds, Kb_, Vb_, (size_t)b * SEQ + (size_t)j * 256, h, tid);
          const int fr = lane & 15, fq = lane >> 4;
          const int idx = seg * 128 + wave * 16 + fr; const bool valid = idx < cnt;
          const unsigned e = alist[(size_t)l * 8192 + (valid ? idx : seg * 128)];
          const int s_ = e & 8191, slot = e >> 13; const size_t tok = (size_t)b * SEQ + s_;
          bf16x8_t qf[2];
          qf[0] = *(const bf16x8_t*)(Qb_ + tok * 512 + h * 64 + 8 * fq); qf[1] = *(const bf16x8_t*)(Qb_ + tok * 512 + h * 64 + 32 + 8 * fq);
          __syncthreads();
          f32x4 o[4]; float m, ls;
          attn_tile<false>(lds, qf, 0, lane, o, m, ls);
          if (valid) {
              const float il = 1.f / ls; const size_t pidx = (tok * 8 + h) * 3 + slot;
#pragma unroll
              for (int db = 0; db < 4; ++db) { v2u w; w.x = cvtpk(o[db][0] * il, o[db][1] * il); w.y = cvtpk(o[db][2] * il, o[db][3] * il); *(v2u*)(part + pidx * 64 + 16 * db + 4 * fq) = w; }
              if (fq == 0) lsep[pidx] = m * 0.125f + __logf(ls);
          }
      }
    }
    xcd_barrier(bar);

    { unsigned char* ws = WSB(); const float* dsk = INP(I_SD);
      S5Order S; S.init(ws + WS_UG, ws + WS_S5T, 2, (size_t)512 * 640 * 2, (size_t)256 * 640 * 2, G, bid);
      auto E = pg8::make_epi([=](const pg8::Unit& u, int r, int c8, const float (&v0)[8], const float (&v1)[8]) {
          const int g = u.e, R = u.pm * 256 + r;
          const bf16* ug = (const bf16*)(ws + WS_UG) + ((size_t)g * 1024 + R) * 640;
#pragma unroll
          for (int h = 0; h < 2; ++h) {
              const int n = 256 * u.pn + 128 * h + c8, t = n >> 4, co = n & 15;
              float uu[8]; unpack8(*(const v4u*)(ug + t * 16 + co), uu);
              const f32x4 d0 = *(const f32x4*)(dsk + g * 16 + co), d1 = *(const f32x4*)(dsk + g * 16 + co + 4);
              const float dd[8] = {d0.x, d0.y, d0.z, d0.w, d1.x, d1.y, d1.z, d1.w};
              float f[8];
#pragma unroll
              for (int j = 0; j < 8; ++j) { const float y = (h ? v1[j] : v0[j]) + dd[j] * uu[j]; f[j] = y * sigm(1.5957691216f * (y + 0.044715f * y * y * y)); }
              *(v4u*)((bf16*)(ws + WS_Y) + ((size_t)R * 32 + t) * 512 + g * 16 + co) = pack8(f);
          }
      });
      pg8::gemm_phase<decltype(E), S5Order, false>(lds, 640, S, E, 640);
    }
    { unsigned char* ws = WSB();
      const bf16* Qb_ = (const bf16*)(ws + WS_Q); const bf16* Kb_ = (const bf16*)(ws + WS_K); const bf16* Vb_ = (const bf16*)(ws + WS_V);
      const bf16* part = (const bf16*)(ws + WS_PART); const float* lsep = (const float*)(ws + WS_LSE); bf16* Ob_ = (bf16*)(ws + WS_O);
      for (int item = bid; item < BATCH * NH * 32 * 2; item += G) {
          const int l = item >> 1, half = item & 1, b = l >> 8, h = (l >> 5) & 7, nb = l & 31;
          __syncthreads();
          attn_load_kv(lds, Kb_, Vb_, (size_t)b * SEQ + (size_t)nb * 256, h, tid);
          const int fr = lane & 15, fq = lane >> 4;
          const int qloc = half * 128 + wave * 16 + fr; const size_t tok = (size_t)b * SEQ + nb * 256 + qloc;
          bf16x8_t qf[2];
          qf[0] = *(const bf16x8_t*)(Qb_ + tok * 512 + h * 64 + 8 * fq); qf[1] = *(const bf16x8_t*)(Qb_ + tok * 512 + h * 64 + 32 + 8 * fq);
          __syncthreads();
          f32x4 o[4]; float m, ls;
          attn_tile<true>(lds, qf, qloc, lane, o, m, ls);
          const int nsel = nb < 3 ? nb : 3;
          const float lse_own = m * 0.125f + __logf(ls);
          float lt[3]; float M = lse_own;
#pragma unroll
          for (int t = 0; t < 3; ++t) { lt[t] = (t < nsel) ? lsep[(tok * 8 + h) * 3 + t] : -1e30f; M = fmaxf(M, lt[t]); }
          const float w0 = __expf(lse_own - M); float den = w0;
          const float sc0 = w0 / ls;
#pragma unroll
          for (int db = 0; db < 4; ++db) o[db] = o[db] * sc0;
#pragma unroll
          for (int t = 0; t < 3; ++t) {
              if (t < nsel) {
                  const float w = __expf(lt[t] - M); den += w;
#pragma unroll
                  for (int db = 0; db < 4; ++db) { const v2u pw = *(const v2u*)(part + ((tok * 8 + h) * 3 + t) * 64 + 16 * db + 4 * fq);
                      o[db][0] += w * lo16(pw.x); o[db][1] += w * hi16(pw.x); o[db][2] += w * lo16(pw.y); o[db][3] += w * hi16(pw.y); }
              }
          }
          const float id = 1.f / den;
#pragma unroll
          for (int db = 0; db < 4; ++db) { v2u w; w.x = cvtpk(o[db][0] * id, o[db][1] * id); w.y = cvtpk(o[db][2] * id, o[db][3] * id); *(v2u*)(Ob_ + tok * 512 + h * 64 + 16 * db + 4 * fq) = w; }
      }
    }
    xcd_barrier(bar);

    { unsigned char* ws = WSB();
      pg8::DenseOrder S; S.init(ws + WS_Y, ws + WS_WGLU, NTOK, 2048, 512, G, bid);
      auto E = pg8::make_epi([=](const pg8::Unit& u, int r, int c8, const float (&v0)[8], const float (&v1)[8]) {
          const size_t off = (size_t)(u.pm * 256 + r) * 1024 + u.pn * 128 + c8;
          float ga[8]; unpack8(*(const v4u*)((const bf16*)(ws + WS_GA) + off), ga);
          float f[8];
#pragma unroll
          for (int j = 0; j < 8; ++j) f[j] = sigm(ga[j]) * v0[j] * sigm(v1[j]);
          *(v4u*)((bf16*)(ws + WS_MRG) + off) = pack8(f);
      });
      pg8::gemm_phase<decltype(E), pg8::DenseOrder, false>(lds, 512, S, E);
    }
    xcd_barrier(bar);

    { unsigned char* ws = WSB();
      pg8::DenseOrder S; S.init(ws + WS_O, ws + WS_WAO, NTOK, 1024, 512, G, bid);
      auto E = pg8::make_epi([=](const pg8::Unit& u, int r, int c8, const float (&v0)[8], const float (&v1)[8]) {
          const size_t off = (size_t)(u.pm * 256 + r) * 1024 + u.pn * 256 + c8;
          const bf16* GBb = (const bf16*)(ws + WS_GB); bf16* MRG = (bf16*)(ws + WS_MRG);
          float gb[8], ma[8], f[8];
          unpack8(*(const v4u*)(GBb + off), gb); unpack8(*(const v4u*)(MRG + off), ma);
#pragma unroll
          for (int j = 0; j < 8; ++j) f[j] = ma[j] + sigm(gb[j]) * v0[j];
          *(v4u*)(MRG + off) = pack8(f);
          unpack8(*(const v4u*)(GBb + off + 128), gb); unpack8(*(const v4u*)(MRG + off + 128), ma);
#pragma unroll
          for (int j = 0; j < 8; ++j) f[j] = ma[j] + sigm(gb[j]) * v1[j];
          *(v4u*)(MRG + off + 128) = pack8(f);
      });
      pg8::gemm_phase<decltype(E), pg8::DenseOrder, false>(lds, 512, S, E);
    }
    xcd_barrier(bar);

    { unsigned char* ws = WSB(); const float* x = INP(I_X);
      pg8::DenseOrder S; S.init(ws + WS_MRG, ws + WS_WOUT, NTOK, 1024, 1024, G, bid);
      auto E = pg8::make_epi([=](const pg8::Unit& u, int r, int c8, const float (&v0)[8], const float (&v1)[8]) {
          const int row = u.pm * 256 + r, b = row >> 13, col = u.pn * 256 + c8;
          const float* gt = (const float*)(ws + WS_MOD) + b * 6144 + 2048 + col;
          const float* xp = x + (size_t)row * 1024 + col; float* op = (float*)(ws + WS_X1) + (size_t)row * 1024 + col;
#pragma unroll
          for (int h = 0; h < 2; ++h) {
              const f32x4 g0 = *(const f32x4*)(gt + 128 * h), g1 = *(const f32x4*)(gt + 128 * h + 4), x0 = *(const f32x4*)(xp + 128 * h), x1 = *(const f32x4*)(xp + 128 * h + 4);
              const float (&v)[8] = h ? v1 : v0;
              f32x4 o0, o1;
              o0.x = x0.x + g0.x * v[0]; o0.y = x0.y + g0.y * v[1]; o0.z = x0.z + g0.z * v[2]; o0.w = x0.w + g0.w * v[3];
              o1.x = x1.x + g1.x * v[4]; o1.y = x1.y + g1.y * v[5]; o1.z = x1.z + g1.z * v[6]; o1.w = x1.w + g1.w * v[7];
              *(f32x4*)(op + 128 * h) = o0; *(f32x4*)(op + 128 * h + 4) = o1;
          }
      });
      pg8::gemm_phase<decltype(E), pg8::DenseOrder, false>(lds, 1024, S, E);
    }
    xcd_barrier(bar);

    {
        unsigned char* ws = WSB(); const float* X1 = (const float*)(ws + WS_X1); const float* MOD = (const float*)(ws + WS_MOD); bf16* Hb = (bf16*)(ws + WS_H);
        const float* gffn = INP(I_GFFN); const float* wrt = INP(I_WR); const float* brt = INP(I_BR);
        int* TOPI = (int*)(ws + WS_TOPI); float* TOPW = (float*)(ws + WS_TOPW); int* BLKCNT = (int*)(ws + WS_BLKCNT);
        LAS int* cnt = (LAS int*)lds;
        if (tid < 32) cnt[tid] = 0;
        __syncthreads();
        const int tpb = NTOK / G;
        for (int tl = wave; tl < tpb; tl += NWAVES) {
            const int m = bid * tpb + tl, b = m >> 13;
            const f32x4* xr = (const f32x4*)(X1 + (size_t)m * DM) + lane;
            float s = 0.f;
#pragma unroll
            for (int j = 0; j < 4; ++j) { const f32x4 t = xr[64 * j]; s += (t.x * t.x + t.y * t.y) + (t.z * t.z + t.w * t.w); }
            const float r = rsqrtf(wave_sum(s) * (1.f / DM) + RMS_EPS);
            float lg[32];
#pragma unroll
            for (int e = 0; e < 32; ++e) lg[e] = 0.f;
            v2u* o8 = (v2u*)(Hb + (size_t)m * DM) + lane;
#pragma unroll 1
            for (int j = 0; j < 4; ++j) {
                const int col = 4 * lane + 256 * j;
                const f32x4 t = xr[64 * j];
                const f32x4 g = *(const f32x4*)(gffn + col);
                const f32x4 sh = *(const f32x4*)(MOD + b * 6144 + 3072 + col), sc = *(const f32x4*)(MOD + b * 6144 + 4096 + col);
                float hv[4];
                hv[0] = t.x * r * g.x * (1.f + sc.x) + sh.x; hv[1] = t.y * r * g.y * (1.f + sc.y) + sh.y;
                hv[2] = t.z * r * g.z * (1.f + sc.z) + sh.z; hv[3] = t.w * r * g.w * (1.f + sc.w) + sh.w;
                v2u w; w.x = pk2(hv[0], hv[1]); w.y = pk2(hv[2], hv[3]); o8[64 * j] = w;
                const f32x4* wr = (const f32x4*)(wrt + (size_t)col * 32);
#pragma unroll
                for (int i = 0; i < 4; ++i) {
#pragma unroll
                    for (int e4 = 0; e4 < 8; ++e4) { const f32x4 w4 = wr[i * 8 + e4]; lg[4 * e4] += hv[i] * w4.x; lg[4 * e4 + 1] += hv[i] * w4.y; lg[4 * e4 + 2] += hv[i] * w4.z; lg[4 * e4 + 3] += hv[i] * w4.w; }
                }
            }
            float a16[16], a8[8], a4[4], a2[2], a1;
            { const bool hi = (lane & 32) != 0;
#pragma unroll
              for (int i = 0; i < 16; ++i) { const float keep = hi ? lg[i + 16] : lg[i], send = hi ? lg[i] : lg[i + 16]; a16[i] = keep + __shfl_xor(send, 32); } }
            { const bool hi = (lane & 16) != 0;
#pragma unroll
              for (int i = 0; i < 8; ++i) { const float keep = hi ? a16[i + 8] : a16[i], send = hi ? a16[i] : a16[i + 8]; a8[i] = keep + __shfl_xor(send, 16); } }
            { const bool hi = (lane & 8) != 0;
#pragma unroll
              for (int i = 0; i < 4; ++i) { const float keep = hi ? a8[i + 4] : a8[i], send = hi ? a8[i] : a8[i + 4]; a4[i] = keep + __shfl_xor(send, 8); } }
            { const bool hi = (lane & 4) != 0;
#pragma unroll
              for (int i = 0; i < 2; ++i) { const float keep = hi ? a4[i + 2] : a4[i], send = hi ? a4[i] : a4[i + 2]; a2[i] = keep + __shfl_xor(send, 4); } }
            { const bool hi = (lane & 2) != 0; const float keep = hi ? a2[1] : a2[0], send = hi ? a2[0] : a2[1]; a1 = keep + __shfl_xor(send, 2); }
            a1 += __shfl_xor(a1, 1);
            const int e_me = lane >> 1;
            float val = a1 + brt[e_me];
            float tv[4]; int ti[4];
#pragma unroll
            for (int k = 0; k < 4; ++k) {
                float bv = val; int bi = e_me;
#pragma unroll
                for (int o = 1; o < 64; o <<= 1) { const float ov = __shfl_xor(bv, o); const int oi = __shfl_xor(bi, o); if (ov > bv || (ov == bv && oi < bi)) { bv = ov; bi = oi; } }
                tv[k] = bv; ti[k] = bi;
                if (e_me == bi) val = -INFINITY;
            }
            const float e0 = 1.f, e1 = __expf(tv[1] - tv[0]), e2 = __expf(tv[2] - tv[0]), e3 = __expf(tv[3] - tv[0]);
            const float inv = 1.f / (e0 + e1 + e2 + e3);
            if (lane == 0) {
                TOPI[m * 4 + 0] = ti[0]; TOPI[m * 4 + 1] = ti[1]; TOPI[m * 4 + 2] = ti[2]; TOPI[m * 4 + 3] = ti[3];
                TOPW[m * 4 + 0] = e0 * inv; TOPW[m * 4 + 1] = e1 * inv; TOPW[m * 4 + 2] = e2 * inv; TOPW[m * 4 + 3] = e3 * inv;
                atomicAdd((int*)&cnt[ti[0]], 1); atomicAdd((int*)&cnt[ti[1]], 1); atomicAdd((int*)&cnt[ti[2]], 1); atomicAdd((int*)&cnt[ti[3]], 1);
            }
        }
        __syncthreads();
        if (tid < 32) BLKCNT[bid * 32 + tid] = cnt[tid];
    }
    xcd_barrier(bar);

    {
        unsigned char* ws = WSB(); const int* TOPI = (const int*)(ws + WS_TOPI); const float* TOPW = (const float*)(ws + WS_TOPW); const int* BLKCNT = (const int*)(ws + WS_BLKCNT);
        int* ROWTOK = (int*)(ws + WS_ROWTOK); float* ROWW = (float*)(ws + WS_ROWW); int* TILEE = (int*)(ws + WS_TILEE);
        LAS int* tot = (LAS int*)lds;
        LAS int* mine = tot + 32;
        LAS int* pst = mine + 32;
        LAS int* ent = pst + 64;
        const int tpb = NTOK / G;
        if (tid < 32) {
            int t = 0, mn = 0;
            for (int k = 0; k < G; ++k) { const int c = BLKCNT[k * 32 + tid]; t += c; if (k < bid) mn += c; }
            tot[tid] = t; mine[tid] = mn;
        }
        for (int i = tid; i < tpb * 4; i += NTHR) ent[i] = TOPI[bid * tpb * 4 + i];
        __syncthreads();
        if (tid == 0) { int a = 0; for (int e = 0; e < 32; ++e) { pst[e] = a; a += (tot[e] + 255) & ~255; } pst[32] = a; }
        __syncthreads();
        for (int i = tid; i < tpb * 4; i += NTHR) {
            const int e = ent[i]; int rank = 0;
            for (int k = 0; k < i; ++k) rank += (ent[k] == e) ? 1 : 0;
            const int pos = pst[e] + mine[e] + rank;
            ROWTOK[pos] = (bid * tpb + (i >> 2)) * 4 + (i & 3);
            ROWW[pos] = TOPW[bid * tpb * 4 + i];
        }
        if (bid < 32) { const int e = bid; for (int pos = pst[e] + tot[e] + tid; pos < pst[e + 1]; pos += NTHR) { ROWTOK[pos] = -1; ROWW[pos] = 0.f; } }
        if (bid == 32 % G) {
            const int nt = pst[32] >> 8;
            for (int t = tid; t < nt; t += NTHR) { int e = 0; for (int k = 0; k < 32; ++k) if ((t << 8) >= pst[k]) e = k; TILEE[t] = e; }
            if (tid == 0) TILEE[1023] = nt;
        }
    }
    xcd_barrier(bar);

    { unsigned char* ws = WSB(); const float* bgu = INP(I_BGU);
      MoeOrder S; S.init(ws + WS_H, ws + WS_WGU, (const int*)(ws + WS_TILEE), (const int*)(ws + WS_ROWTOK), 8, (size_t)2048 * 1024 * 2, 1024, G, bid, true);
      auto E = pg8::make_epi([=](const pg8::Unit& u, int r, int c8, const float (&v0)[8], const float (&v1)[8]) {
          const int col = u.pn * 128 + c8; float f[8];
          const float* bg = bgu + (size_t)u.e * 2048 + col;
          const f32x4 bg0 = *(const f32x4*)bg, bg1 = *(const f32x4*)(bg + 4), bu0 = *(const f32x4*)(bg + 1024), bu1 = *(const f32x4*)(bg + 1028);
          const float bgv[8] = {bg0.x, bg0.y, bg0.z, bg0.w, bg1.x, bg1.y, bg1.z, bg1.w}, buv[8] = {bu0.x, bu0.y, bu0.z, bu0.w, bu1.x, bu1.y, bu1.z, bu1.w};
#pragma unroll
          for (int j = 0; j < 8; ++j) {
              const float gt = fminf(v0[j] + bgv[j], 7.f);
              const float up = fminf(fmaxf(v1[j] + buv[j], -7.f), 7.f);
              f[j] = (up + 1.f) * gt * sigm(1.702f * gt);
          }
          *(v4u*)((bf16*)(ws + WS_ACT) + (size_t)(u.pm * 256 + r) * 1024 + col) = pack8(f);
      });
      pg8::gemm_phase<decltype(E), MoeOrder, true>(lds, 1024, S, E);
    }
    xcd_barrier(bar);

    { unsigned char* ws = WSB(); const float* bdn = INP(I_BD);
      MoeOrder S; S.init(ws + WS_ACT, ws + WS_WD, (const int*)(ws + WS_TILEE), (const int*)(ws + WS_ROWTOK), 4, (size_t)1024 * 1024 * 2, 1024, G, bid, false);
      auto E = pg8::make_epi([=](const pg8::Unit& u, int r, int c8, const float (&v0)[8], const float (&v1)[8]) {
          const int srow = u.pm * 256 + r;
          const int rt = ((const int*)(ws + WS_ROWTOK))[srow];
          if (rt >= 0) {
              const float w = ((const float*)(ws + WS_ROWW))[srow]; const int col = u.pn * 256 + c8; float f[8];
              const float* bd = bdn + (size_t)u.e * 1024 + col;
              bf16* yp = (bf16*)(ws + WS_YS) + (size_t)rt * 1024 + col;
#pragma unroll
              for (int j = 0; j < 8; ++j) f[j] = (v0[j] + bd[j]) * w;
              *(v4u*)yp = pack8(f);
#pragma unroll
              for (int j = 0; j < 8; ++j) f[j] = (v1[j] + bd[128 + j]) * w;
              *(v4u*)(yp + 128) = pack8(f);
          }
      });
      pg8::gemm_phase<decltype(E), MoeOrder, false>(lds, 1024, S, E);
    }
    xcd_barrier(bar);

    { unsigned char* ws = WSB(); const float* X1 = (const float*)(ws + WS_X1); const float* MOD = (const float*)(ws + WS_MOD); const bf16* YS = (const bf16*)(ws + WS_YS); const float* gfin = INP(I_GFIN); float* outp = (float*)ldptr(lds, 25);
    for (int m = gw; m < NTOK; m += NGW) {
        const int b = m >> 13;
        const f32x4* xr = (const f32x4*)(X1 + (size_t)m * DM) + lane;
        f32x4 v[4]; float s = 0.f;
#pragma unroll
        for (int j = 0; j < 4; ++j) {
            const int col = 4 * lane + 256 * j;
            f32x4 a = (f32x4){0.f, 0.f, 0.f, 0.f};
#pragma unroll
            for (int sl = 0; sl < 4; ++sl) { const v2u w = *(const v2u*)(YS + ((size_t)m * 4 + sl) * 1024 + col); a.x += lo16(w.x); a.y += hi16(w.x); a.z += lo16(w.y); a.w += hi16(w.y); }
            const f32x4 gt = *(const f32x4*)(MOD + b * 6144 + 5120 + col);
            v[j] = xr[64 * j] + gt * a;
            s += (v[j].x * v[j].x + v[j].y * v[j].y) + (v[j].z * v[j].z + v[j].w * v[j].w);
        }
        const float r = rsqrtf(wave_sum(s) * (1.f / DM) + RMS_EPS);
        f32x4* op = (f32x4*)(outp + (size_t)m * DM) + lane;
#pragma unroll
        for (int j = 0; j < 4; ++j) { const f32x4 g = *(const f32x4*)(gfin + 4 * lane + 256 * j); op[64 * j] = v[j] * r * g; }
    } }
}

extern "C" void kernel_launch(void* const* d_in, const int* in_sizes, int n_in, void* d_out, int out_size, void* d_ws, size_t ws_size, hipStream_t stream) {
    static int grid = 0;
    if (grid == 0) {
        if (n_in != 25 || in_sizes[0] != NTOK * DM || out_size != NTOK * DM || ws_size < WS_END) {
            fprintf(stderr, "kernel_launch: unexpected shapes (n_in %d, in0 %d, out %d, ws %zu); nothing launched\n", n_in, n_in > 0 ? in_sizes[0] : -1, out_size, ws_size); grid = -1; return; }
        int dev = 0, cus = 0, per_cu = 0;
        if (hipGetDevice(&dev) != hipSuccess || hipDeviceGetAttribute(&cus, hipDeviceAttributeMultiprocessorCount, dev) != hipSuccess) { grid = -1; return; }
        if (hipFuncSetAttribute((const void*)mega_fwd, hipFuncAttributeMaxDynamicSharedMemorySize, LDS_BYTES) != hipSuccess) { fprintf(stderr, "kernel_launch: hipFuncSetAttribute failed\n"); grid = -1; return; }
        if (hipOccupancyMaxActiveBlocksPerMultiprocessor(&per_cu, (const void*)mega_fwd, NTHR, LDS_BYTES) != hipSuccess || per_cu < 1) {
            fprintf(stderr, "kernel_launch: occupancy query reports %d blocks per CU\n", per_cu); (void)hipGetLastError(); grid = -1; return; }
        grid = cus;
        if (NTOK % grid != 0) { fprintf(stderr, "kernel_launch: grid %d does not divide the token count\n", grid); grid = -1; return; }
    }
    if (grid < 0) return;
    (void)hipMemsetAsync((char*)d_ws + WS_CTL, 0, CTL_ZERO_BYTES, stream);
    Params p{};
    for (int i = 0; i < 25; ++i) p.in[i] = (const float*)d_in[i];
    p.out = (float*)d_out; p.ws = (unsigned char*)d_ws;
    hipLaunchKernelGGL(mega_fwd, dim3(grid), dim3(NTHR), LDS_BYTES, stream, p);
}
```

```cpp
#include <hip/hip_runtime.h>
#include <cstdio>
#include <cstdint>

#define GAS __attribute__((address_space(1)))
#define LAS __attribute__((address_space(3)))
typedef unsigned short bf16;
typedef unsigned v4u __attribute__((ext_vector_type(4)));
typedef unsigned v2u __attribute__((ext_vector_type(2)));
typedef float f32x4 __attribute__((ext_vector_type(4)));

constexpr int BATCH = 4, SEQ = 8192, DM = 1024, NTOK = BATCH * SEQ, INW = 4096;
constexpr int NH = 8, HD = 64, AW = 512, SW = 512, NG = 32, NP = 64, NC = 16;
constexpr int NE = 32, TOPK = 4, DFF = 1024, MAXTILES = 544, MAXROWS = MAXTILES * 256;
constexpr int NWAVES = 8, NTHR = 512;
constexpr float RMS_EPS = 1e-5f;

constexpr size_t MiB = 1u << 20;
constexpr size_t WS_CTL = 0, CTL_ZERO_BYTES = 64 * 1024;
constexpr size_t WS_MOD = 1 * MiB;
constexpr size_t WS_ROT = 2 * MiB;
constexpr size_t WS_KMEAN = 3 * MiB;
constexpr size_t WS_TOPI = 4 * MiB;
constexpr size_t WS_TOPW = 5 * MiB;
constexpr size_t WS_BLKCNT = 6 * MiB;
constexpr size_t WS_ROWTOK = 7 * MiB;
constexpr size_t WS_ROWW = 8 * MiB;
constexpr size_t WS_TILEE = 9 * MiB;
constexpr size_t WS_WIN = 16 * MiB, WS_WGLU = 24 * MiB, WS_WAO = 26 * MiB, WS_WOUT = 27 * MiB, WS_WGU = 32 * MiB, WS_WD = 160 * MiB;
constexpr size_t WS_X1 = 224 * MiB;
constexpr size_t WS_U = 352 * MiB, WS_Q = 384 * MiB, WS_K = 416 * MiB, WS_V = 448 * MiB, WS_GA = 480 * MiB, WS_GB = 544 * MiB, WS_O = 608 * MiB, WS_Y = 640 * MiB;
constexpr size_t WS_ACT = 352 * MiB;
constexpr size_t WS_H = 672 * MiB;
constexpr size_t WS_MRG = 736 * MiB;
constexpr size_t WS_YS = 672 * MiB;
constexpr size_t WS_ACNT = 32768;
constexpr size_t WS_LSE = 10 * MiB;
constexpr size_t WS_QCTR = 40960;
constexpr size_t WS_PSQ = 13 * MiB;
constexpr size_t WS_WRS = 15 * MiB;
constexpr size_t WS_ALIST = 352 * MiB;
constexpr size_t WS_PART = 800 * MiB;
constexpr size_t WS_S5T = 928 * MiB;
constexpr size_t WS_S5W = 952 * MiB;
constexpr size_t WS_XE = 960 * MiB;
constexpr size_t WS_UG = 976 * MiB;
constexpr size_t WS_END = 1016 * MiB;

constexpr int LDS_BYTES = 147456;
constexpr int LDS_MISC = 147456 - 512;
constexpr int LDS_PAR = 147456 - 1024;

__device__ __forceinline__ float bf2f(bf16 v) { return __builtin_bit_cast(float, (unsigned)v << 16); }
__device__ __forceinline__ unsigned f2bf(float f) { unsigned u = __builtin_bit_cast(unsigned, f); return (u + 0x7fffu + ((u >> 16) & 1u)) >> 16; }
__device__ __forceinline__ unsigned pk2(float lo, float hi) { return f2bf(lo) | (f2bf(hi) << 16); }
__device__ __forceinline__ float lo16(unsigned w) { return __builtin_bit_cast(float, w << 16); }
__device__ __forceinline__ float hi16(unsigned w) { return __builtin_bit_cast(float, w & 0xffff0000u); }
__device__ __forceinline__ float sigm(float x) { return 1.f / (1.f + __expf(-x)); }
__device__ __forceinline__ float wave_sum(float v) {
#pragma unroll
    for (int o = 1; o < 64; o <<= 1) v += __shfl_xor(v, o);
    return v;
}
__device__ __forceinline__ void unpack8(v4u w, float (&f)[8]) {
    f[0] = lo16(w.x); f[1] = hi16(w.x); f[2] = lo16(w.y); f[3] = hi16(w.y); f[4] = lo16(w.z); f[5] = hi16(w.z); f[6] = lo16(w.w); f[7] = hi16(w.w);
}
__device__ __forceinline__ v4u pack8(const float (&f)[8]) { v4u w; w.x = pk2(f[0], f[1]); w.y = pk2(f[2], f[3]); w.z = pk2(f[4], f[5]); w.w = pk2(f[6], f[7]); return w; }

#define XB_TMO      128
#define XB_XCNT(j)  (256  + 64 * (j))
#define XB_XSUB(j)  (1280 + 64 * (j))
#define XB_XGEN(j)  (2304 + 64 * (j))
#define XB_TOP      3328
#define XB_TOPGEN   3392
#define XCD_BAR_WORDS 3456
#define XB_SPIN_CAP (1u << 25)
__device__ __forceinline__ unsigned xb_ld(unsigned* p)              { return __hip_atomic_load(p, __ATOMIC_RELAXED, __HIP_MEMORY_SCOPE_AGENT); }
__device__ __forceinline__ unsigned xb_add(unsigned* p, unsigned v) { return __hip_atomic_fetch_add(p, v, __ATOMIC_RELAXED, __HIP_MEMORY_SCOPE_AGENT); }
__device__ __forceinline__ unsigned xb_xcc_id() { return (unsigned)__builtin_amdgcn_s_getreg((3 << 11) | 20) & 0xFu; }
#define XB_SPIN(cond, bar) do { unsigned _sp = 0; while (cond) { __builtin_amdgcn_s_sleep(1); \
    if ((++_sp & 255u) == 0u) { if (xb_ld(&(bar)[XB_TMO])) break; if (_sp > XB_SPIN_CAP) { atomicAdd(&(bar)[XB_TMO], 1u); break; } } } } while (0)
struct XcdBarrier { unsigned* bar; unsigned x; volatile LAS unsigned* st; };
__device__ __forceinline__ XcdBarrier xcd_barrier_post(unsigned* bar, volatile LAS unsigned* st) {
    XcdBarrier b; b.bar = bar; b.x = xb_xcc_id(); b.st = st;
    if (threadIdx.x == 0) (void)xb_add(&bar[XB_XCNT(b.x)], 1u);
    return b;
}
__device__ __forceinline__ void xcd_barrier_complete(unsigned* bar, unsigned x, unsigned& nloc, unsigned& nx) {
    const unsigned G = gridDim.x * gridDim.y * gridDim.z;
    unsigned sum, cnt, mine, sp = 0u;
    for (;;) {
        sum = 0u; cnt = 0u; mine = 0u;
#pragma unroll
        for (unsigned j = 0; j < 16; ++j) { const unsigned c = xb_ld(&bar[XB_XCNT(j)]); sum += c; cnt += (c > 0u) ? 1u : 0u; mine = (j == x) ? c : mine; }
        if (sum == G) break;
        __builtin_amdgcn_s_sleep(1);
        if ((++sp & 255u) == 0u) { if (xb_ld(&bar[XB_TMO])) break; if (sp > XB_SPIN_CAP) { atomicAdd(&bar[XB_TMO], 1u); break; } }
    }
    nloc = mine > 0u ? mine : 1u; nx = cnt > 0u ? cnt : 1u;
}
__device__ __forceinline__ void xcd_barrier(const XcdBarrier& b) {
    asm volatile("s_waitcnt vmcnt(0)" ::: "memory");
    __syncthreads();
    if (threadIdx.x == 0) {
        unsigned* bar = b.bar;
        __builtin_amdgcn_s_waitcnt(0);
        unsigned nloc = b.st[0], nx = b.st[1];
        if (nloc == 0u) { xcd_barrier_complete(bar, b.x, nloc, nx); b.st[0] = nloc; b.st[1] = nx; }
        const unsigned old = xb_add(&bar[XB_XSUB(b.x)], 1u);
        const unsigned gen = old / nloc;
        if (old + 1u == (gen + 1u) * nloc) {
            __builtin_amdgcn_fence(__ATOMIC_RELEASE, "agent");
            asm volatile("s_waitcnt vmcnt(0)" ::: "memory");
            const unsigned og = xb_add(&bar[XB_TOP], 1u);
            const unsigned tg = og / nx;
            if (og + 1u == (tg + 1u) * nx) xb_add(&bar[XB_TOPGEN], 1u);
            else XB_SPIN(xb_ld(&bar[XB_TOPGEN]) == tg, bar);
            __builtin_amdgcn_fence(__ATOMIC_ACQUIRE, "agent");
            xb_add(&bar[XB_XGEN(b.x)], 1u);
            asm volatile("s_waitcnt vmcnt(0)" ::: "memory");
        } else {
            XB_SPIN(xb_ld(&bar[XB_XGEN(b.x)]) == gen, bar);
            __builtin_amdgcn_fence(__ATOMIC_ACQUIRE, "agent");
            asm volatile("s_waitcnt vmcnt(0)" ::: "memory");
        }
    }
    __syncthreads();
}

struct Params { const float* in[25]; float* out; unsigned char* ws; };
enum { I_X = 0, I_C, I_WADA, I_BADA, I_GMIX, I_WIN, I_ARE, I_AIM, I_LOGDT, I_BRE, I_BIM, I_CRE, I_CIM, I_SD, I_WGLU, I_WAO, I_WOUT, I_GFFN, I_WR, I_BR, I_WGU, I_BGU, I_WD, I_BD, I_GFIN };

__device__ __forceinline__ int ilv(int n) { return n < 1024 ? ((n >> 7) * 256 + (n & 127)) : (((n - 1024) >> 7) * 256 + 128 + ((n - 1024) & 127)); }

__device__ __forceinline__ void transpose_item(const float* W, int K, int N, bf16* WT, bool interleave, LAS float* scr, int item, int lane) {
    const int nblk = N / 32, kb = item / nblk, nb = item % nblk, k0 = 64 * kb, n0 = 32 * nb;
#pragma unroll 8
    for (int i = 0; i < 32; ++i) { const int kk = 2 * i + (lane >> 5); scr[kk * 33 + (lane & 31)] = W[(size_t)(k0 + kk) * N + n0 + (lane & 31)]; }
    asm volatile("s_waitcnt lgkmcnt(0)" ::: "memory");
    const int c = lane & 7;
    const int r0 = interleave ? ilv(n0) : n0;
#pragma unroll
    for (int j = 0; j < 4; ++j) { const int n = (lane >> 3) + 8 * j; const LAS float* s = scr + (8 * c) * 33 + n;
        v4u o; o.x = pk2(s[0 * 33], s[1 * 33]); o.y = pk2(s[2 * 33], s[3 * 33]); o.z = pk2(s[4 * 33], s[5 * 33]); o.w = pk2(s[6 * 33], s[7 * 33]);
        *(v4u*)(WT + (size_t)(r0 + n) * K + k0 + 8 * c) = o; }
    asm volatile("s_waitcnt lgkmcnt(0)" ::: "memory");
}

template <class AP, class BP, class Epi>
__device__ __forceinline__ void ngemm_unit(LAS unsigned char* lds, int K, AP ap, BP bp, Epi epi) {
    LAS float* As = (LAS float*)lds;
    LAS float* Bs = As + 32 * 65;
    LAS float* Cs = Bs + 32 * 257;
    const int tid = threadIdx.x, rp = tid >> 4, cg = tid & 15;
    float acc[2][16];
#pragma unroll
    for (int i = 0; i < 2; ++i)
#pragma unroll
        for (int j = 0; j < 16; ++j) acc[i][j] = 0.f;
    const int arow = tid >> 3, akq = (tid & 7) * 4;
    const int bn = tid >> 1, bkh = (tid & 1) * 16;
    const bf16* aptr = ap(arow) + akq;
    const bf16* bptr = bp(bn) + bkh;
    for (int k0 = 0; k0 < K; k0 += 32) {
        const v2u av = *(const v2u*)(aptr + k0);
        const v4u bv0 = *(const v4u*)(bptr + k0), bv1 = *(const v4u*)(bptr + k0 + 8);
        __syncthreads();
        As[(akq + 0) * 65 + arow] = lo16(av.x); As[(akq + 1) * 65 + arow] = hi16(av.x); As[(akq + 2) * 65 + arow] = lo16(av.y); As[(akq + 3) * 65 + arow] = hi16(av.y);
        { float f[8]; unpack8(bv0, f);
#pragma unroll
          for (int i = 0; i < 8; ++i) Bs[(bkh + i) * 257 + bn] = f[i];
          unpack8(bv1, f);
#pragma unroll
          for (int i = 0; i < 8; ++i) Bs[(bkh + 8 + i) * 257 + bn] = f[i]; }
        __syncthreads();
#pragma unroll 4
        for (int kk = 0; kk < 32; ++kk) {
            const float a0 = As[kk * 65 + 2 * rp], a1 = As[kk * 65 + 2 * rp + 1];
#pragma unroll
            for (int j = 0; j < 16; ++j) { const float b = Bs[kk * 257 + cg + 16 * j]; acc[0][j] += a0 * b; acc[1][j] += a1 * b; }
        }
    }
#pragma unroll
    for (int i = 0; i < 2; ++i)
#pragma unroll
        for (int j = 0; j < 16; ++j) Cs[(2 * rp + i) * 257 + cg + 16 * j] = acc[i][j];
    __syncthreads();
#pragma unroll
    for (int i = 0; i < 2; ++i) {
        float v0[8], v1[8];
#pragma unroll
        for (int j = 0; j < 8; ++j) { v0[j] = Cs[(2 * rp + i) * 257 + 8 * cg + j]; v1[j] = Cs[(2 * rp + i) * 257 + 128 + 8 * cg + j]; }
        epi(2 * rp + i, 8 * cg, v0, v1);
    }
    __syncthreads();
}


namespace pg8 {
typedef short bf16x8 __attribute__((ext_vector_type(8)));
constexpr int BM = 256, BK = 64, HALF = 128, HTB = HALF * BK * 2, STAGE_BYTES = 8 * HTB, NXCD = 8, WGM = 8;
__host__ __device__ __forceinline__ int lds_byte(int r, int c) { const int st = (r >> 4) * 2 + (c >> 5), rr = r & 15, cc = c & 31, ob = rr * 64 + cc * 2; return st * 1024 + (ob ^ (((ob >> 9) & 1) << 5)); }
__host__ __device__ __forceinline__ void stage_rc(int b, int& R, int& C) { const int st = b / 1024, sb = b % 1024, swz = sb ^ (((sb >> 9) & 1) << 5); R = (st >> 1) * 16 + swz / 64; C = (st & 1) * 32 + (swz % 64) / 2; }
__host__ __device__ __forceinline__ int perm32(int rho) { const int n = rho >> 4, i = rho & 15; return 8 * (i >> 2) + 4 * n + (i & 3); }
struct Unit { int pm, pn, e, pad; const char* A; const char* B; };

struct DenseOrder {
    const char* A; const char* Bt; int nM, nN, nwg, G, c; size_t tstep;
    __device__ __forceinline__ void init(const void* A_, const void* Bt_, int M, int N, int K, int G_, int c_) { A = (const char*)A_; Bt = (const char*)Bt_; nM = M / BM; nN = N / BM; nwg = nM * nN; G = G_; c = c_; tstep = (size_t)BM * K * 2; }
    __device__ __forceinline__ bool next(int i, Unit& u) const {
        const long L = (long)i * G + c; if (L >= nwg) return false;
        int wgid = (int)L; { const int q = nwg / NXCD, r = nwg % NXCD, xcd = wgid % NXCD, off = wgid / NXCD; wgid = (xcd < r ? xcd * (q + 1) : r * (q + 1) + (xcd - r) * q) + off; }
        const int nig = WGM * nN, gid = wgid / nig, fm = gid * WGM, gsz = (nM - fm) < WGM ? (nM - fm) : WGM;
        u.pm = fm + ((wgid % nig) % gsz); u.pn = (wgid % nig) / gsz; u.e = 0; u.A = A + (size_t)u.pm * tstep; u.B = Bt + (size_t)u.pn * tstep; return true;
    }
    __device__ __forceinline__ unsigned rowoff(const Unit&, int) const { return 0u; }
};

template <class Epi, class Sched, bool GATHER>
__device__ __forceinline__ void gemm_phase(LAS unsigned char* lds, const int K, const Sched& S, const Epi& E, const int lda_ = 0) {
    int tid = threadIdx.x; asm volatile("" : "+v"(tid));
    const int wid = __builtin_amdgcn_readfirstlane(tid >> 6), lane = tid & 63, wr = wid >> 2, wc = wid & 3, fr = lane & 15, fq = lane >> 4;
    const int nt = K / BK, lda = lda_ ? lda_ : K;
    int sR[2], sC[2];
    unsigned voffA[2][2], nvoffA[2][2], voffB[2];
#pragma unroll
    for (int i = 0; i < 2; ++i) { int R, C; stage_rc(tid * 16 + i * 8192, R, C); sR[i] = R; sC[i] = C; const int Rb = (R & ~31) + perm32(R & 31);
        voffA[0][i] = (unsigned)(R * lda + C) * 2u; voffA[1][i] = (unsigned)((R + HALF) * lda + C) * 2u; voffB[i] = (unsigned)(Rb * K + C) * 2u;
        nvoffA[0][i] = voffA[0][i]; nvoffA[1][i] = voffA[1][i]; }
    const size_t kstep = (size_t)(BK * 2);
    const size_t hstep = (size_t)HALF * K * 2;
    const unsigned ldsw = (unsigned)wid * 1024u;
    const int aoff = lds_byte(wr * 64 + fr, fq * 8), boff = lds_byte(wc * 32 + fr, fq * 8);
#define PG8_SA(b, h) (((b) * 2 + (h)) * HTB)
#define PG8_SB(b, h) ((4 + (b) * 2 + (h)) * HTB)
#define PG8_STAGE(bufoff, gbase, v0, v1) do { \
        __builtin_amdgcn_global_load_lds((const unsigned*)((const char*)(gbase) + (v0)), (LAS unsigned*)(lds + (bufoff) + ldsw), 16, 0, 0); \
        __builtin_amdgcn_global_load_lds((const unsigned*)((const char*)(gbase) + (v1)), (LAS unsigned*)(lds + (bufoff) + ldsw + 8192), 16, 0, 0); } while (0)
#define PG8_LDA(dst, b, h) do { _Pragma("unroll") for (int m = 0; m < 4; ++m) _Pragma("unroll") for (int k = 0; k < 2; ++k) dst[m][k] = *(const LAS bf16x8*)(lds + PG8_SA(b, h) + aoff + m * 2048 + k * 1024); } while (0)
#define PG8_LDB(dst, b, h) do { _Pragma("unroll") for (int n = 0; n < 2; ++n) _Pragma("unroll") for (int k = 0; k < 2; ++k) dst[n][k] = *(const LAS bf16x8*)(lds + PG8_SB(b, h) + boff + n * 2048 + k * 1024); } while (0)
#define PG8_MMA(ai, bj, At, Bt) do { __builtin_amdgcn_s_setprio(1); _Pragma("unroll") for (int m = 0; m < 4; ++m) _Pragma("unroll") for (int n = 0; n < 2; ++n) _Pragma("unroll") for (int k = 0; k < 2; ++k) \
        acc[ai][bj][m][n] = __builtin_amdgcn_mfma_f32_16x16x32_bf16(Bt[n][k], At[m][k], acc[ai][bj][m][n], 0, 0, 0); __builtin_amdgcn_s_setprio(0); } while (0)
#define PG8_WAIT_V(n) asm volatile("s_waitcnt vmcnt(" #n ")" ::: "memory")
#define PG8_WAIT_L(n) asm volatile("s_waitcnt lgkmcnt(" #n ")" ::: "memory")
#define PG8_BAR __builtin_amdgcn_s_barrier()
#define PG8_SCHED __builtin_amdgcn_sched_barrier(0)
    Unit cur, nxt; int ui = 0;
    if (!S.next(0, cur)) return;
    if constexpr (GATHER) {
#pragma unroll
        for (int h = 0; h < 2; ++h)
#pragma unroll
            for (int i = 0; i < 2; ++i) voffA[h][i] = S.rowoff(cur, h * HALF + sR[i]) + (unsigned)sC[i] * 2u;
    }
    f32x4 acc[2][2][4][2];
#pragma unroll
    for (int a = 0; a < 2; ++a)
#pragma unroll
        for (int b = 0; b < 2; ++b)
#pragma unroll
            for (int m = 0; m < 4; ++m)
#pragma unroll
                for (int n = 0; n < 2; ++n) acc[a][b][m][n] = (f32x4){0.f, 0.f, 0.f, 0.f};
    bf16x8 At[4][2], B0[2][2], B1[2][2];
    const char* cA = cur.A; const char* cB = cur.B;
    PG8_STAGE(PG8_SB(0, 0), cB, voffB[0], voffB[1]); PG8_STAGE(PG8_SB(0, 1), cB + hstep, voffB[0], voffB[1]); PG8_STAGE(PG8_SA(0, 0), cA, voffA[0][0], voffA[0][1]); PG8_STAGE(PG8_SA(0, 1), cA, voffA[1][0], voffA[1][1]);
    if (wr == 1) PG8_BAR;
    PG8_WAIT_V(2); PG8_BAR;
    PG8_STAGE(PG8_SB(1, 0), cB + kstep, voffB[0], voffB[1]); PG8_STAGE(PG8_SA(1, 0), cA + kstep, voffA[0][0], voffA[0][1]); PG8_STAGE(PG8_SB(1, 1), cB + hstep + kstep, voffB[0], voffB[1]);
    PG8_WAIT_V(6); PG8_BAR;
    for (;;) {
        const bool has_next = S.next(ui + 1, nxt);
        const char* nA = has_next ? nxt.A : cA; const char* nB = has_next ? nxt.B : cB;
        if constexpr (GATHER) {
            if (has_next) {
#pragma unroll
                for (int h = 0; h < 2; ++h)
#pragma unroll
                    for (int i = 0; i < 2; ++i) nvoffA[h][i] = S.rowoff(nxt, h * HALF + sR[i]) + (unsigned)sC[i] * 2u;
            } else {
#pragma unroll
                for (int h = 0; h < 2; ++h)
#pragma unroll
                    for (int i = 0; i < 2; ++i) nvoffA[h][i] = voffA[h][i];
            }
        }
        for (int t = 0; t < nt; t += 2) {
            const bool last = (t == nt - 2);
            const char* a1 = cA + (size_t)(t + 1) * kstep;
            const char* a2 = last ? nA : cA + (size_t)(t + 2) * kstep; const char* b2 = last ? nB : cB + (size_t)(t + 2) * kstep;
            const char* a3 = a2 + kstep; const char* b3 = b2 + kstep;
            unsigned w00, w01, w10, w11;
            if constexpr (GATHER) { w00 = last ? nvoffA[0][0] : voffA[0][0]; w01 = last ? nvoffA[0][1] : voffA[0][1]; w10 = last ? nvoffA[1][0] : voffA[1][0]; w11 = last ? nvoffA[1][1] : voffA[1][1]; }
            else { w00 = voffA[0][0]; w01 = voffA[0][1]; w10 = voffA[1][0]; w11 = voffA[1][1]; }
            PG8_LDB(B0, 0, 0); PG8_LDB(B1, 0, 1); PG8_SCHED; PG8_LDA(At, 0, 0); PG8_STAGE(PG8_SA(1, 1), a1, voffA[1][0], voffA[1][1]);
            PG8_WAIT_V(8); PG8_WAIT_L(0); PG8_BAR; PG8_MMA(0, 0, At, B0); PG8_MMA(0, 1, At, B1); PG8_BAR; PG8_SCHED;
            PG8_LDA(At, 0, 1); PG8_STAGE(PG8_SB(0, 0), b2, voffB[0], voffB[1]); PG8_STAGE(PG8_SB(0, 1), b2 + hstep, voffB[0], voffB[1]); PG8_STAGE(PG8_SA(0, 0), a2, w00, w01);
            PG8_WAIT_V(8); PG8_WAIT_L(0); PG8_BAR; PG8_MMA(1, 0, At, B0); PG8_MMA(1, 1, At, B1); PG8_BAR; PG8_SCHED;
            PG8_LDB(B0, 1, 0); PG8_LDB(B1, 1, 1); PG8_SCHED; PG8_LDA(At, 1, 0); PG8_STAGE(PG8_SA(0, 1), a2, w10, w11);
            PG8_WAIT_V(8); PG8_WAIT_L(0); PG8_BAR; PG8_MMA(0, 0, At, B0); PG8_MMA(0, 1, At, B1); PG8_BAR; PG8_SCHED;
            PG8_LDA(At, 1, 1); PG8_STAGE(PG8_SB(1, 0), b3, voffB[0], voffB[1]); PG8_STAGE(PG8_SB(1, 1), b3 + hstep, voffB[0], voffB[1]); PG8_STAGE(PG8_SA(1, 0), a3, w00, w01);
            PG8_WAIT_V(8); PG8_WAIT_L(0); PG8_BAR; PG8_MMA(1, 0, At, B0); PG8_MMA(1, 1, At, B1); PG8_BAR; PG8_SCHED;
        }
        if (wr == 0) PG8_BAR;
        E(acc, cur, wr, wc, fr, fq);
        if (!has_next) break;
#pragma unroll
        for (int a = 0; a < 2; ++a)
#pragma unroll
            for (int b = 0; b < 2; ++b)
#pragma unroll
                for (int m = 0; m < 4; ++m)
#pragma unroll
                    for (int n = 0; n < 2; ++n) acc[a][b][m][n] = (f32x4){0.f, 0.f, 0.f, 0.f};
        cur = nxt; cA = nA; cB = nB; ++ui;
        if constexpr (GATHER) {
#pragma unroll
            for (int h = 0; h < 2; ++h)
#pragma unroll
                for (int i = 0; i < 2; ++i) voffA[h][i] = nvoffA[h][i];
        }
        if (wr == 1) PG8_BAR;
    }
    PG8_WAIT_V(0);
    PG8_BAR;
#undef PG8_SA
#undef PG8_SB
#undef PG8_STAGE
#undef PG8_LDA
#undef PG8_LDB
#undef PG8_MMA
#undef PG8_WAIT_V
#undef PG8_WAIT_L
#undef PG8_BAR
#undef PG8_SCHED
}

template <class F> struct EpiRows {
    F f;
    __device__ __forceinline__ void operator()(const f32x4 (&acc)[2][2][4][2], const Unit& u, int wr, int wc, int fr, int fq) const {
#pragma unroll
        for (int ai = 0; ai < 2; ++ai)
#pragma unroll
            for (int m = 0; m < 4; ++m) {
                float v0[8], v1[8];
#pragma unroll
                for (int j = 0; j < 4; ++j) { v0[j] = acc[ai][0][m][0][j]; v0[4 + j] = acc[ai][0][m][1][j]; v1[j] = acc[ai][1][m][0][j]; v1[4 + j] = acc[ai][1][m][1][j]; }
                f(u, ai * HALF + wr * 64 + m * 16 + fr, wc * 32 + 8 * fq, v0, v1);
            }
    }
};
template <class F> __device__ __forceinline__ EpiRows<F> make_epi(F f) { return EpiRows<F>{f}; }
}

struct MoeOrder {
    const char* A; const char* Bt; const int* tile_e; const int* rowtok; int nt, npn, G, c, tpg, K; bool gather; size_t estride, tstep;
    __device__ __forceinline__ void init(const void* A_, const void* Bt_, const int* tile_e_, const int* rowtok_, int npn_, size_t estride_, int K_, int G_, int c_, bool gather_) {
        A = (const char*)A_; Bt = (const char*)Bt_; tile_e = tile_e_; rowtok = rowtok_; npn = npn_; estride = estride_; K = K_; G = G_; c = c_; gather = gather_;
        nt = tile_e_[1023]; tpg = (G / 8) / npn; tstep = (size_t)256 * K_ * 2;
    }
    __device__ __forceinline__ bool next(int i, pg8::Unit& u) const {
        const int xc = c & 7, ci = c >> 3, group = i * 8 + xc, tile = group * tpg + ci / npn;
        if (tile >= nt) return false;
        u.pm = tile; u.pn = ci % npn; u.e = tile_e[tile];
        u.A = gather ? A : A + (size_t)tile * tstep; u.B = Bt + (size_t)u.e * estride + (size_t)u.pn * tstep; return true;
    }
    __device__ __forceinline__ unsigned rowoff(const pg8::Unit& u, int r) const { const int rt = rowtok[u.pm * 256 + r]; return (unsigned)(rt < 0 ? 0 : (rt >> 2)) * (unsigned)(K * 2); }
};


struct S5Order {
    const char* A; const char* Bt; int npn, c, G; size_t bstride, btile;
    __device__ __forceinline__ void init(const void* A_, const void* Bt_, int npn_, size_t bstride_, size_t btile_, int G_, int c_) { A = (const char*)A_; Bt = (const char*)Bt_; npn = npn_; bstride = bstride_; btile = btile_; G = G_; c = c_; }
    __device__ __forceinline__ bool next(int i, pg8::Unit& u) const {
        if (i > 0) return false;
        const int xc = c & 7, ci = c >> 3, per = 4 * npn;
        if (ci >= 4 * per) return false;
        const int g = 4 * xc + ci / per, rem = ci % per;
        u.e = g; u.pm = rem / npn; u.pn = rem % npn;
        u.A = A + ((size_t)g * 1024 + (size_t)u.pm * 256) * 640 * 2; u.B = Bt + (size_t)g * bstride + (size_t)u.pn * btile; return true;
    }
    __device__ __forceinline__ unsigned rowoff(const pg8::Unit&, int) const { return 0u; }
};

struct EpiInProj {
    unsigned char* ws;
    __device__ __forceinline__ void operator()(const f32x4 (&acc)[2][2][4][2], const pg8::Unit& u, int wr, int wc, int fr, int fq) const {
        const int pn = u.pn;
        size_t boff; int ld, cb;
        if (pn < 8) { boff = WS_U + (size_t)(pn >> 1) * (32 * MiB); ld = 512; cb = 256 * (pn & 1); }
        else { boff = WS_GA + (size_t)((pn - 8) >> 2) * (64 * MiB); ld = 1024; cb = 256 * ((pn - 8) & 3); }
        const int c8 = wc * 32 + 8 * fq;
        const bool rot = (pn >= 2 && pn < 6), isk = (pn == 4 || pn == 5);
        const bool t1 = (c8 & 63) == 0, t2 = (c8 & 63) == 8;
        const float* ROT = (const float*)(ws + WS_ROT);
        float cs0[8], cs1[8];
#pragma unroll
        for (int j = 0; j < 8; ++j) { cs0[j] = 0.f; cs1[j] = 0.f; }
#pragma unroll
        for (int ai = 0; ai < 2; ++ai)
#pragma unroll
            for (int m = 0; m < 4; ++m) {
                const int r = ai * 128 + wr * 64 + m * 16 + fr, row = u.pm * 256 + r;
                float v0[8], v1[8];
#pragma unroll
                for (int j = 0; j < 4; ++j) { v0[j] = acc[ai][0][m][0][j]; v0[4 + j] = acc[ai][0][m][1][j]; v1[j] = acc[ai][1][m][0][j]; v1[4 + j] = acc[ai][1][m][1][j]; }
                if (rot) {
                    float o0[8], o1[8];
#pragma unroll
                    for (int j = 0; j < 8; ++j) { o0[j] = __shfl_xor(v0[j], 16); o1[j] = __shfl_xor(v1[j], 16); }
                    if (t1 || t2) {
                        const f32x4* rp = (const f32x4*)(ROT + (size_t)(row & (SEQ - 1)) * 16);
                        const f32x4 q0 = rp[0], q1 = rp[1], q2 = rp[2], q3 = rp[3];
                        const float cs[8] = {q0.x, q0.z, q1.x, q1.z, q2.x, q2.z, q3.x, q3.z}, sn[8] = {q0.y, q0.w, q1.y, q1.w, q2.y, q2.w, q3.y, q3.w};
#pragma unroll
                        for (int j = 0; j < 8; ++j) {
                            v0[j] = t1 ? (v0[j] * cs[j] - o0[j] * sn[j]) : (v0[j] * cs[j] + o0[j] * sn[j]);
                            v1[j] = t1 ? (v1[j] * cs[j] - o1[j] * sn[j]) : (v1[j] * cs[j] + o1[j] * sn[j]);
                        }
                    }
                }
                if (isk) {
#pragma unroll
                    for (int j = 0; j < 8; ++j) { cs0[j] += v0[j]; cs1[j] += v1[j]; }
                }
                if (pn < 2) {
                    const int col = 256 * pn + c8, R = row >> 5, sl = row & 31;
                    bf16* ug = (bf16*)(ws + WS_UG);
                    *(v4u*)(ug + ((size_t)(col >> 4) * 1024 + R) * 640 + sl * 16 + (col & 15)) = pack8(v0);
                    *(v4u*)(ug + ((size_t)((col + 128) >> 4) * 1024 + R) * 640 + sl * 16 + (col & 15)) = pack8(v1);
                } else {
                    bf16* o = (bf16*)(ws + boff) + (size_t)row * ld + cb + c8;
                    *(v4u*)o = pack8(v0); *(v4u*)(o + 128) = pack8(v1);
                }
            }
        if (isk) {
#pragma unroll
            for (int j = 0; j < 8; ++j) {
#pragma unroll
                for (int o = 1; o < 16; o <<= 1) { cs0[j] += __shfl_xor(cs0[j], o); cs1[j] += __shfl_xor(cs1[j], o); }
            }
            if (fr == 0) {
                const int b = u.pm >> 5, jb = u.pm & 31, d = c8 & 63, h0 = 4 * (pn - 4) + (wc >> 1);
                float* kp = (float*)(ws + WS_KMEAN) + (size_t)wr * (BATCH * NH * 32 * 64);
                float* p0 = kp + ((b * NH + h0) * 32 + jb) * 64 + d; float* p1 = kp + ((b * NH + h0 + 2) * 32 + jb) * 64 + d;
                *(f32x4*)p0 = (f32x4){cs0[0], cs0[1], cs0[2], cs0[3]}; *(f32x4*)(p0 + 4) = (f32x4){cs0[4], cs0[5], cs0[6], cs0[7]};
                *(f32x4*)p1 = (f32x4){cs1[0], cs1[1], cs1[2], cs1[3]}; *(f32x4*)(p1 + 4) = (f32x4){cs1[4], cs1[5], cs1[6], cs1[7]};
            }
        }
    }
};

typedef short bf16x8_t __attribute__((ext_vector_type(8)));
typedef short v4i16_t __attribute__((ext_vector_type(4)));
typedef float f32x2_t __attribute__((ext_vector_type(2))); typedef __bf16 bf16x2_t __attribute__((ext_vector_type(2)));
__device__ __forceinline__ unsigned cvtpk(float lo, float hi) { f32x2_t v = {lo, hi}; bf16x2_t b = __builtin_convertvector(v, bf16x2_t); return __builtin_bit_cast(unsigned, b); }
constexpr int AT_STRIDE = 160, AT_K = 0, AT_V = 256 * AT_STRIDE, AT_PRE = 2 * 256 * AT_STRIDE, AT_CN = AT_PRE + 4096, AT_WT = AT_CN + 4096;

__device__ __forceinline__ void attn_load_kv(LAS unsigned char* lds, const bf16* Kb, const bf16* Vb, size_t row0, int h, int tid) {
    v4u kv[4], vv[4];
#pragma unroll
    for (int i = 0; i < 4; ++i) { const int ch = tid + 512 * i, row = ch >> 3, cc = ch & 7;
        kv[i] = *(const v4u*)(Kb + (row0 + row) * 512 + h * 64 + cc * 8); vv[i] = *(const v4u*)(Vb + (row0 + row) * 512 + h * 64 + cc * 8); }
#pragma unroll
    for (int i = 0; i < 4; ++i) { const int ch = tid + 512 * i, row = ch >> 3, cc = ch & 7;
        *(LAS v4u*)(lds + AT_K + row * AT_STRIDE + cc * 16) = kv[i]; *(LAS v4u*)(lds + AT_V + row * AT_STRIDE + cc * 16) = vv[i]; }
}
template <bool CAUSAL>
__device__ __forceinline__ void attn_tile(LAS unsigned char* lds, const bf16x8_t (&qf)[2], int qloc, int lane, f32x4 (&o)[4], float& mrow, float& lrow) {
    const int fr = lane & 15, fq = lane >> 4;
    f32x4 acc[16];
#pragma unroll
    for (int kb = 0; kb < 16; ++kb) {
        const LAS unsigned char* kp = lds + AT_K + (16 * kb + fr) * AT_STRIDE + fq * 16;
        const bf16x8_t a0 = *(const LAS bf16x8_t*)kp, a1 = *(const LAS bf16x8_t*)(kp + 64);
        f32x4 z = (f32x4){0.f, 0.f, 0.f, 0.f};
        z = __builtin_amdgcn_mfma_f32_16x16x32_bf16(a0, qf[0], z, 0, 0, 0);
        acc[kb] = __builtin_amdgcn_mfma_f32_16x16x32_bf16(a1, qf[1], z, 0, 0, 0);
    }
    if (CAUSAL) {
#pragma unroll
        for (int kb = 0; kb < 16; ++kb)
#pragma unroll
            for (int r = 0; r < 4; ++r) if (16 * kb + 4 * fq + r > qloc) acc[kb][r] = -1e30f;
    }
    float m = acc[0][0];
#pragma unroll
    for (int kb = 0; kb < 16; ++kb)
#pragma unroll
        for (int r = 0; r < 4; ++r) m = fmaxf(m, acc[kb][r]);
    m = fmaxf(m, __shfl_xor(m, 16)); m = fmaxf(m, __shfl_xor(m, 32));
    const float c = 0.125f * 1.4426950408889634f;
    float ls = 0.f;
#pragma unroll
    for (int kb = 0; kb < 16; ++kb)
#pragma unroll
        for (int r = 0; r < 4; ++r) { const float p = __builtin_amdgcn_exp2f((acc[kb][r] - m) * c); ls += p; acc[kb][r] = p; }
    ls += __shfl_xor(ls, 16); ls += __shfl_xor(ls, 32);
#pragma unroll
    for (int db = 0; db < 4; ++db) o[db] = (f32x4){0.f, 0.f, 0.f, 0.f};
    const LAS unsigned char* vbase = lds + AT_V + (4 * fq + (fr >> 2)) * AT_STRIDE + (fr & 3) * 8;
#pragma unroll
    for (int ks = 0; ks < 8; ++ks) {
        v4u pw; pw.x = cvtpk(acc[2 * ks][0], acc[2 * ks][1]); pw.y = cvtpk(acc[2 * ks][2], acc[2 * ks][3]); pw.z = cvtpk(acc[2 * ks + 1][0], acc[2 * ks + 1][1]); pw.w = cvtpk(acc[2 * ks + 1][2], acc[2 * ks + 1][3]);
        const bf16x8_t pf = __builtin_bit_cast(bf16x8_t, pw);
#pragma unroll
        for (int db = 0; db < 4; ++db) {
            const v4i16_t lo = __builtin_amdgcn_ds_read_tr16_b64_v4i16((LAS v4i16_t*)(vbase + (32 * ks) * AT_STRIDE + db * 32));
            const v4i16_t hi = __builtin_amdgcn_ds_read_tr16_b64_v4i16((LAS v4i16_t*)(vbase + (32 * ks + 16) * AT_STRIDE + db * 32));
            const bf16x8_t vt = (bf16x8_t){lo[0], lo[1], lo[2], lo[3], hi[0], hi[1], hi[2], hi[3]};
            o[db] = __builtin_amdgcn_mfma_f32_16x16x32_bf16(vt, pf, o[db], 0, 0, 0);
        }
    }
    mrow = m; lrow = ls;
}

__device__ __forceinline__ const void* ldptr(LAS unsigned char* lds, int i) {
    const unsigned long long v = ((volatile LAS unsigned long long*)(lds + LDS_PAR))[i];
    const unsigned lo = __builtin_amdgcn_readfirstlane((unsigned)v), hi = __builtin_amdgcn_readfirstlane((unsigned)(v >> 32));
    return (const void*)(const GAS void*)(((unsigned long long)hi << 32) | lo);
}
#define INP(i) ((const float*)ldptr(lds, (i)))
#define WSB() ((unsigned char*)ldptr(lds, 26))
__global__ void __launch_bounds__(NTHR, 2) mega_fwd(Params P) {
    extern __shared__ __attribute__((aligned(16))) unsigned char lds_raw[];
    LAS unsigned char* lds = (LAS unsigned char*)lds_raw;
    volatile LAS unsigned* MISC = (volatile LAS unsigned*)(lds + LDS_MISC);
    const int tid = threadIdx.x, lane = tid & 63, wave = __builtin_amdgcn_readfirstlane(tid >> 6);
    const int G = gridDim.x, bid = blockIdx.x;
    const int gw = bid * NWAVES + wave, NGW = G * NWAVES;
    if (tid < 128) MISC[tid] = 0u;
    if (tid < 25) ((LAS unsigned long long*)(lds + LDS_PAR))[tid] = (unsigned long long)P.in[tid];
    if (tid == 25) ((LAS unsigned long long*)(lds + LDS_PAR))[25] = (unsigned long long)P.out;
    if (tid == 26) ((LAS unsigned long long*)(lds + LDS_PAR))[26] = (unsigned long long)P.ws;
    __syncthreads();
    XcdBarrier bar = xcd_barrier_post((unsigned*)(P.ws + WS_CTL) + 1024, MISC + 8);

    {
        unsigned char* ws = WSB(); float* MOD = (float*)(ws + WS_MOD); float* ROT = (float*)(ws + WS_ROT);
        if (bid >= 64) {
            LAS float* cond = (LAS float*)lds;
            LAS float* red = cond + 4096;
            const float* c = INP(I_C);
            for (int i = tid; i < 4096; i += NTHR) { const float v = c[i]; cond[i] = v * sigm(v); }
            __syncthreads();
            const int hw = wave * 2 + (lane >> 5), col = (bid - 64) * 32 + (lane & 31);
            const float* w = INP(I_WADA) + (size_t)(hw * 64) * 6144 + col;
            float a0 = 0.f, a1 = 0.f, a2 = 0.f, a3 = 0.f;
#pragma unroll 16
            for (int k = 0; k < 64; ++k) { const float wv = w[(size_t)k * 6144]; const int kk = hw * 64 + k;
                a0 += cond[kk] * wv; a1 += cond[1024 + kk] * wv; a2 += cond[2048 + kk] * wv; a3 += cond[3072 + kk] * wv; }
            red[(hw * 4 + 0) * 32 + (lane & 31)] = a0; red[(hw * 4 + 1) * 32 + (lane & 31)] = a1; red[(hw * 4 + 2) * 32 + (lane & 31)] = a2; red[(hw * 4 + 3) * 32 + (lane & 31)] = a3;
            __syncthreads();
            if (tid < 128) { const int b = tid >> 5, cc = tid & 31; float a = 0.f;
#pragma unroll
                for (int h = 0; h < 16; ++h) a += red[(h * 4 + b) * 32 + cc];
                const int j = (bid - 64) * 32 + cc; MOD[b * 6144 + j] = a + INP(I_BADA)[j]; }
            __syncthreads();
        }
        if (bid >= 32 && bid < 64) {
            for (int i = (bid - 32) * NTHR + tid; i < SEQ * 8; i += 32 * NTHR) {
                const int s = i >> 3, d = i & 7;
                const float inv = 1.0f / powf(500000.0f, (float)(2 * d) / 16.0f);
                const float ang = (float)s * inv;
                float sn, cs; sincosf(ang, &sn, &cs);
                ROT[2 * i] = cs; ROT[2 * i + 1] = sn;
            }
            const float* wr = INP(I_WR); bf16* wrs = (bf16*)(ws + WS_WRS);
            for (int i = (bid - 32) * NTHR + tid; i < 32 * 1024; i += 32 * NTHR) { const int e = i >> 10, k = i & 1023; const float v = wr[k * 32 + e];
                const unsigned hb = f2bf(v); const float hv = bf2f((bf16)hb); wrs[i] = (bf16)hb; wrs[32768 + i] = (bf16)f2bf(v - hv); }
        }
        if (bid < NG) {
            const int g = bid;
            LAS float* APr = (LAS float*)lds;
            LAS float* APi = APr + 33 * 64;
            LAS float* BBr = APi + 33 * 64;
            LAS float* BBi = BBr + 1024;
            LAS float* CCr = BBi + 1024;
            LAS float* CCi = CCr + 1024;
            LAS float* KRN = CCi + 1024;
            const float dt = expf(INP(I_LOGDT)[g]);
            const float* are = INP(I_ARE) + g * 64; const float* aim = INP(I_AIM) + g * 64;
            for (int i = tid; i < 33 * 64; i += NTHR) { const int lag = i >> 6, p = i & 63; const float lr = are[p], li = aim[p];
                const float mg = expf(lr * dt * (float)lag); float sn, cs; sincosf(li * dt * (float)lag, &sn, &cs); APr[i] = mg * cs; APi[i] = mg * sn; }
            { const float* pbre = INP(I_BRE) + g * 1024; const float* pbim = INP(I_BIM) + g * 1024; const float* pcre = INP(I_CRE) + g * 1024; const float* pcim = INP(I_CIM) + g * 1024;
              for (int i = tid; i < 1024; i += NTHR) { const int p = i >> 4; const float lr = are[p], li = aim[p];
                const float mg = expf(lr * dt); float sn, cs; sincosf(li * dt, &sn, &cs); const float ar = mg * cs, ai = mg * sn, den = lr * lr + li * li;
                const float cfr = ((ar - 1.f) * lr + ai * li) / den, cfi = (ai * lr - (ar - 1.f) * li) / den;
                const float br = pbre[i], bi = pbim[i]; BBr[i] = cfr * br - cfi * bi; BBi[i] = cfr * bi + cfi * br;
                CCr[i] = pcre[i]; CCi[i] = pcim[i]; } }
            __syncthreads();
            for (int i = tid; i < 32 * 256; i += NTHR) { const int lag = i >> 8, co = (i >> 4) & 15, ci = i & 15; float a = 0.f;
                for (int p = 0; p < 64; ++p) { const float cr = CCr[co * 64 + p], cim = CCi[co * 64 + p], pr = APr[lag * 64 + p], pi = APi[lag * 64 + p];
                    const float car = cr * pr - cim * pi, cai = cr * pi + cim * pr; a += car * BBr[p * 16 + ci] - cai * BBi[p * 16 + ci]; }
                KRN[i] = a; }
            __syncthreads();
            bf16* T = (bf16*)(ws + WS_S5T) + (size_t)g * 512 * 640;
            for (int ch = tid; ch < 512 * 80; ch += NTHR) { const int row = ch / 80, col = (ch % 80) * 8, t = row >> 4, co = row & 15; float f[8];
                if (col < 512) { const int sx = col >> 4, ci0 = col & 15;
#pragma unroll
                    for (int j = 0; j < 8; ++j) f[j] = (sx <= t) ? KRN[((t - sx) * 16 + co) * 16 + ci0 + j] : 0.f; }
                else { const int cx = col - 512, ri = cx >> 6, p0 = cx & 63;
#pragma unroll
                    for (int j = 0; j < 8; ++j) { const int p = p0 + j; const float cr = CCr[co * 64 + p], cim = CCi[co * 64 + p], pr = APr[(t + 1) * 64 + p], pi = APi[(t + 1) * 64 + p];
                        f[j] = ri ? -(cr * pi + cim * pr) : (cr * pr - cim * pi); } }
                *(v4u*)(T + (size_t)row * 640 + col) = pack8(f); }
            bf16* W1 = (bf16*)(ws + WS_S5W) + (size_t)g * 256 * 512;
            for (int ch = tid; ch < 256 * 64; ch += NTHR) { const int row = ch >> 6, col = (ch & 63) * 8; float f[8];
                if (row < 128) { const int ri = row >> 6, p = row & 63, sx = col >> 4, ci0 = col & 15; const float pr = APr[(31 - sx) * 64 + p], pi = APi[(31 - sx) * 64 + p];
#pragma unroll
                    for (int j = 0; j < 8; ++j) { const float br = BBr[p * 16 + ci0 + j], bi = BBi[p * 16 + ci0 + j]; f[j] = ri ? (pr * bi + pi * br) : (pr * br - pi * bi); } }
                else {
#pragma unroll
                    for (int j = 0; j < 8; ++j) f[j] = 0.f; }
                *(v4u*)(W1 + (size_t)row * 512 + col) = pack8(f); }
            __syncthreads();
        }
        LAS float* scr = (LAS float*)(lds + wave * 16384);
        constexpr int I_IN = 16 * 128, I_GL = 8 * 64, I_AO = 8 * 32, I_OU = 16 * 32, I_GU1 = 16 * 64, I_D1 = 16 * 32;
        constexpr int NIT = I_IN + I_GL + I_AO + I_OU + NE * I_GU1 + NE * I_D1;
        int* qctr = (int*)(ws + WS_QCTR);
        for (;;) {
          int qb = 0; if (lane == 0) qb = atomicAdd(qctr, 4); qb = __builtin_amdgcn_readfirstlane(qb);
          if (qb >= NIT) break;
          for (int it = qb; it < qb + 4 && it < NIT; ++it) {
            int r = it;
            if (r < I_IN) { transpose_item(INP(I_WIN), 1024, 4096, (bf16*)(ws + WS_WIN), false, scr, r, lane); continue; } r -= I_IN;
            if (r < I_GL) { transpose_item(INP(I_WGLU), 512, 2048, (bf16*)(ws + WS_WGLU), true, scr, r, lane); continue; } r -= I_GL;
            if (r < I_AO) { transpose_item(INP(I_WAO), 512, 1024, (bf16*)(ws + WS_WAO), false, scr, r, lane); continue; } r -= I_AO;
            if (r < I_OU) { transpose_item(INP(I_WOUT), 1024, 1024, (bf16*)(ws + WS_WOUT), false, scr, r, lane); continue; } r -= I_OU;
            if (r < NE * I_GU1) { const int e = r / I_GU1; transpose_item(INP(I_WGU) + (size_t)e * 1024 * 2048, 1024, 2048, (bf16*)(ws + WS_WGU) + (size_t)e * 2048 * 1024, true, scr, r % I_GU1, lane); continue; } r -= NE * I_GU1;
            { const int e = r / I_D1; transpose_item(INP(I_WD) + (size_t)e * 1024 * 1024, 1024, 1024, (bf16*)(ws + WS_WD) + (size_t)e * 1024 * 1024, false, scr, r % I_D1, lane); }
          }
        }
    }
    xcd_barrier(bar);

    { unsigned char* ws = WSB(); const float* x = INP(I_X); const float* gmix = INP(I_GMIX); const float* MOD = (const float*)(ws + WS_MOD); bf16* Hb = (bf16*)(ws + WS_H);
    for (int m = gw; m < NTOK; m += NGW) {
        const int b = m >> 13;
        const f32x4* xr = (const f32x4*)(x + (size_t)m * DM) + lane;
        f32x4 v[4]; float s = 0.f;
#pragma unroll
        for (int j = 0; j < 4; ++j) { v[j] = xr[64 * j]; s += (v[j].x * v[j].x + v[j].y * v[j].y) + (v[j].z * v[j].z + v[j].w * v[j].w); }
        const float r = rsqrtf(wave_sum(s) * (1.f / DM) + RMS_EPS);
        v2u* o8 = (v2u*)(Hb + (size_t)m * DM) + lane;
#pragma unroll
        for (int j = 0; j < 4; ++j) {
            const int col = 4 * lane + 256 * j;
            const f32x4 g = *(const f32x4*)(gmix + col);
            const f32x4 sh = *(const f32x4*)(MOD + b * 6144 + col), sc = *(const f32x4*)(MOD + b * 6144 + 1024 + col);
            v2u w; w.x = pk2(v[j].x * r * g.x * (1.f + sc.x) + sh.x, v[j].y * r * g.y * (1.f + sc.y) + sh.y);
            w.y = pk2(v[j].z * r * g.z * (1.f + sc.z) + sh.z, v[j].w * r * g.w * (1.f + sc.w) + sh.w);
            o8[64 * j] = w;
        }
    } }
    xcd_barrier(bar);

    { unsigned char* ws = WSB();
      pg8::DenseOrder S; S.init(ws + WS_H, ws + WS_WIN, NTOK, INW, 1024, G, bid);
      EpiInProj E{ws};
      pg8::gemm_phase<EpiInProj, pg8::DenseOrder, false>(lds, 1024, S, E);
    }
    xcd_barrier(bar);

    { unsigned char* ws = WSB();
      S5Order S; S.init(ws + WS_UG, ws + WS_S5W, 1, (size_t)256 * 512 * 2, 0, G, bid);
      auto E = pg8::make_epi([=](const pg8::Unit& u, int r, int c8, const float (&v0)[8], const float (&v1)[8]) {
          float* xe = (float*)(ws + WS_XE) + ((size_t)u.e * 1024 + u.pm * 256 + r) * 128 + c8;
          *(f32x4*)xe = (f32x4){v0[0], v0[1], v0[2], v0[3]}; *(f32x4*)(xe + 4) = (f32x4){v0[4], v0[5], v0[6], v0[7]};
      });
      pg8::gemm_phase<decltype(E), S5Order, false>(lds, 512, S, E, 640);
    }
    { unsigned char* ws = WSB();
      const bf16* Qb_ = (const bf16*)(ws + WS_Q); const float* km0 = (const float*)(ws + WS_KMEAN);
      int* acnt = (int*)(ws + WS_ACNT); unsigned short* alist = (unsigned short*)(ws + WS_ALIST);
      for (int it = gw; it < BATCH * NH * 128; it += NGW) {
        const int b = it >> 10, h = (it >> 7) & 7, chk = it & 127, s_ = chk * 64 + lane, nb = chk >> 2;
        if (nb == 0) continue;
        const size_t qrow = (size_t)b * SEQ + s_;
        v4u qp[8];
#pragma unroll
        for (int i = 0; i < 8; ++i) qp[i] = ((const v4u*)(Qb_ + qrow * 512 + h * 64))[i];
        float g0 = -INFINITY, g1 = -INFINITY, g2 = -INFINITY; int s0 = 0, s1 = 0, s2 = 0;
        for (int j = 0; j < nb; ++j) {
            const float* km = km0 + ((b * NH + h) * 32 + j) * 64;
            float g = 0.f;
#pragma unroll
            for (int i = 0; i < 8; ++i) { float f[8]; unpack8(qp[i], f);
#pragma unroll
                for (int jj = 0; jj < 8; ++jj) g += f[jj] * (km[8 * i + jj] + km[BATCH * NH * 32 * 64 + 8 * i + jj]); }
            if (g > g0) { g2 = g1; s2 = s1; g1 = g0; s1 = s0; g0 = g; s0 = j; }
            else if (g > g1) { g2 = g1; s2 = s1; g1 = g; s1 = j; }
            else if (g > g2) { g2 = g; s2 = j; }
        }
        const int nsel = nb < 3 ? nb : 3;
        if (nsel < 2) s1 = -1;
        if (nsel < 3) s2 = -1;
        int myn = 0;
        for (int j = 0; j < nb; ++j) { const bool mt = (s0 == j) || (s1 == j) || (s2 == j); const unsigned long long mask = __ballot(mt); if (lane == j) myn = __popcll(mask); }
        int basev = 0;
        if (lane < nb && myn > 0) basev = atomicAdd(&acnt[(b * NH + h) * 32 + lane], myn);
        for (int j = 0; j < nb; ++j) {
            const bool mt = (s0 == j) || (s1 == j) || (s2 == j); const unsigned long long mask = __ballot(mt); const int base = __shfl(basev, j);
            if (mt) { const int slot = (s0 == j) ? 0 : ((s1 == j) ? 1 : 2); const int pos = base + __popcll(mask & ((1ull << lane) - 1ull));
                alist[(size_t)((b * NH + h) * 32 + j) * 8192 + pos] = (unsigned short)(s_ | (slot << 13)); }
        }
      }
    }
    xcd_barrier(bar);

    if (gw < BATCH * NG) {
        unsigned char* ws = WSB();
        const int b = gw >> 5, g = gw & 31, p = lane;
        const float lr = INP(I_ARE)[g * 64 + p], li = INP(I_AIM)[g * 64 + p], dt = expf(INP(I_LOGDT)[g]);
        const float mg = expf(lr * dt * 32.f); float sn, cs; sincosf(li * dt * 32.f, &sn, &cs);
        const float ar = mg * cs, ai = mg * sn;
        const float* xe = (const float*)(ws + WS_XE) + ((size_t)g * 1024 + b * 256) * 128 + p;
        bf16* xp = (bf16*)(ws + WS_UG) + ((size_t)g * 1024 + b * 256) * 640 + 512 + p;
        float xr = 0.f, xi = 0.f;
        for (int k0 = 0; k0 < 256; k0 += 8) {
            float er[8], ei[8];
#pragma unroll
            for (int k = 0; k < 8; ++k) { er[k] = xe[(size_t)(k0 + k) * 128]; ei[k] = xe[(size_t)(k0 + k) * 128 + 64]; }
#pragma unroll
            for (int k = 0; k < 8; ++k) {
                xp[(size_t)(k0 + k) * 640] = (bf16)f2bf(xr); xp[(size_t)(k0 + k) * 640 + 64] = (bf16)f2bf(xi);
                const float nr = ar * xr - ai * xi + er[k], ni = ar * xi + ai * xr + ei[k]; xr = nr; xi = ni;
            }
        }
    }
    { unsigned char* ws = WSB();
      const bf16* Qb_ = (const bf16*)(ws + WS_Q); const bf16* Kb_ = (const bf16*)(ws + WS_K); const bf16* Vb_ = (const bf16*)(ws + WS_V);
      const int* acnt = (const int*)(ws + WS_ACNT); const unsigned short* alist = (const unsigned short*)(ws + WS_ALIST);
      bf16* part = (bf16*)(ws + WS_PART); float* lsep = (float*)(ws + WS_LSE);
      LAS int* pre = (LAS int*)(lds + AT_PRE); LAS int* cn = (LAS int*)(lds + AT_CN); LAS int* wt = (LAS int*)(lds + AT_WT);
      __syncthreads();
      { const int c0 = acnt[2 * tid], c1 = acnt[2 * tid + 1]; cn[2 * tid] = c0; cn[2 * tid + 1] = c1;
        const int n0 = (c0 + 127) >> 7, n1 = (c1 + 127) >> 7; int v = n0 + n1;
#pragma unroll
        for (int o = 1; o < 64; o <<= 1) { const int t = __shfl_up(v, o); if (lane >= o) v += t; }
        if (lane == 63) wt[wave] = v;
        __syncthreads();
        int off = 0;
        for (int w = 0; w < wave; ++w) off += wt[w];
        pre[2 * tid] = off + v - n1; pre[2 * tid + 1] = off + v; }
      __syncthreads();
      const int total = pre[1023];
      for (int item = bid; item < total; item += G) {
          int lo = 0, hi = 1023;
          while (lo < hi) { const int mid = (lo + hi) >> 1; if (pre[mid] > item) hi = mid; else lo = mid + 1; }
          const int l = lo, seg = item - (l ? pre[l - 1] : 0), cnt = cn[l];
          const int b = l >> 8, h = (l >> 5) & 7, j = l & 31;
          __syncthreads();
          attn_load_kv(lds, Kb_, Vb_, (size_t)b * SEQ + (size_t)j * 256, h, tid);
          const int fr = lane & 15, fq = lane >> 4;
          const int idx = seg * 128 + wave * 16 + fr; const bool valid = idx < cnt;
          const unsigned e = alist[(size_t)l * 8192 + (valid ? idx : seg * 128)];
          const int s_ = e & 8191, slot = e >> 13; const size_t tok = (size_t)b * SEQ + s_;
          bf16x8_t qf[2];
          qf[0] = *(const bf16x8_t*)(Qb_ + tok * 512 + h * 64 + 8 * fq); qf[1] = *(const bf16x8_t*)(Qb_ + tok * 512 + h * 64 + 32 + 8 * fq);
          __syncthreads();
          f32x4 o[4]; float m, ls;
          attn_tile<false>(lds, qf, 0, lane, o, m, ls);
          if (valid) {
              const float il = 1.f / ls; const size_t pidx = (tok * 8 + h) * 3 + slot;
#pragma unroll
              for (int db = 0; db < 4; ++db) { v2u w; w.x = cvtpk(o[db][0] * il, o[db][1] * il); w.y = cvtpk(o[db][2] * il, o[db][3] * il); *(v2u*)(part + pidx * 64 + 16 * db + 4 * fq) = w; }
              if (fq == 0) lsep[pidx] = m * 0.125f + __logf(ls);
          }
      }
    }
    xcd_barrier(bar);

    { unsigned char* ws = WSB(); const float* dsk = INP(I_SD);
      S5Order S; S.init(ws + WS_UG, ws + WS_S5T, 2, (size_t)512 * 640 * 2, (size_t)256 * 640 * 2, G, bid);
      auto E = pg8::make_epi([=](const pg8::Unit& u, int r, int c8, const float (&v0)[8], const float (&v1)[8]) {
          const int g = u.e, R = u.pm * 256 + r;
          const bf16* ug = (const bf16*)(ws + WS_UG) + ((size_t)g * 1024 + R) * 640;
#pragma unroll
          for (int h = 0; h < 2; ++h) {
              const int n = 256 * u.pn + 128 * h + c8, t = n >> 4, co = n & 15;
              float uu[8]; unpack8(*(const v4u*)(ug + t * 16 + co), uu);
              const f32x4 d0 = *(const f32x4*)(dsk + g * 16 + co), d1 = *(const f32x4*)(dsk + g * 16 + co + 4);
              const float dd[8] = {d0.x, d0.y, d0.z, d0.w, d1.x, d1.y, d1.z, d1.w};
              float f[8];
#pragma unroll
              for (int j = 0; j < 8; ++j) { const float y = (h ? v1[j] : v0[j]) + dd[j] * uu[j]; f[j] = y * sigm(1.5957691216f * (y + 0.044715f * y * y * y)); }
              *(v4u*)((bf16*)(ws + WS_Y) + ((size_t)R * 32 + t) * 512 + g * 16 + co) = pack8(f);
          }
      });
      pg8::gemm_phase<decltype(E), S5Order, false>(lds, 640, S, E, 640);
    }
    { unsigned char* ws = WSB();
      const bf16* Qb_ = (const bf16*)(ws + WS_Q); const bf16* Kb_ = (const bf16*)(ws + WS_K); const bf16* Vb_ = (const bf16*)(ws + WS_V);
      const bf16* part = (const bf16*)(ws + WS_PART); const float* lsep = (const float*)(ws + WS_LSE); bf16* Ob_ = (bf16*)(ws + WS_O);
      for (int item = bid; item < BATCH * NH * 32 * 2; item += G) {
          const int l = item >> 1, half = item & 1, b = l >> 8, h = (l >> 5) & 7, nb = l & 31;
          __syncthreads();
          attn_load_kv(lds, Kb_, Vb_, (size_t)b * SEQ + (size_t)nb * 256, h, tid);
          const int fr = lane & 15, fq = lane >> 4;
          const int qloc = half * 128 + wave * 16 + fr; const size_t tok = (size_t)b * SEQ + nb * 256 + qloc;
          bf16x8_t qf[2];
          qf[0] = *(const bf16x8_t*)(Qb_ + tok * 512 + h * 64 + 8 * fq); qf[1] = *(const bf16x8_t*)(Qb_ + tok * 512 + h * 64 + 32 + 8 * fq);
          __syncthreads();
          f32x4 o[4]; float m, ls;
          attn_tile<true>(lds, qf, qloc, lane, o, m, ls);
          const int nsel = nb < 3 ? nb : 3;
          const float lse_own = m * 0.125f + __logf(ls);
          float lt[3]; float M = lse_own;
#pragma unroll
          for (int t = 0; t < 3; ++t) { lt[t] = (t < nsel) ? lsep[(tok * 8 + h) * 3 + t] : -1e30f; M = fmaxf(M, lt[t]); }
          const float w0 = __expf(lse_own - M); float den = w0;
          const float sc0 = w0 / ls;
#pragma unroll
          for (int db = 0; db < 4; ++db) o[db] = o[db] * sc0;
#pragma unroll
          for (int t = 0; t < 3; ++t) {
              if (t < nsel) {
                  const float w = __expf(lt[t] - M); den += w;
#pragma unroll
                  for (int db = 0; db < 4; ++db) { const v2u pw = *(const v2u*)(part + ((tok * 8 + h) * 3 + t) * 64 + 16 * db + 4 * fq);
                      o[db][0] += w * lo16(pw.x); o[db][1] += w * hi16(pw.x); o[db][2] += w * lo16(pw.y); o[db][3] += w * hi16(pw.y); }
              }
          }
          const float id = 1.f / den;
#pragma unroll
          for (int db = 0; db < 4; ++db) { v2u w; w.x = cvtpk(o[db][0] * id, o[db][1] * id); w.y = cvtpk(o[db][2] * id, o[db][3] * id); *(v2u*)(Ob_ + tok * 512 + h * 64 + 16 * db + 4 * fq) = w; }
      }
    }
    xcd_barrier(bar);

    { unsigned char* ws = WSB();
      pg8::DenseOrder S; S.init(ws + WS_Y, ws + WS_WGLU, NTOK, 2048, 512, G, bid);
      auto E = pg8::make_epi([=](const pg8::Unit& u, int r, int c8, const float (&v0)[8], const float (&v1)[8]) {
          const size_t off = (size_t)(u.pm * 256 + r) * 1024 + u.pn * 128 + c8;
          float ga[8]; unpack8(*(const v4u*)((const bf16*)(ws + WS_GA) + off), ga);
          float f[8];
#pragma unroll
          for (int j = 0; j < 8; ++j) f[j] = sigm(ga[j]) * v0[j] * sigm(v1[j]);
          *(v4u*)((bf16*)(ws + WS_MRG) + off) = pack8(f);
      });
      pg8::gemm_phase<decltype(E), pg8::DenseOrder, false>(lds, 512, S, E);
    }
    xcd_barrier(bar);

    { unsigned char* ws = WSB();
      pg8::DenseOrder S; S.init(ws + WS_O, ws + WS_WAO, NTOK, 1024, 512, G, bid);
      auto E = pg8::make_epi([=](const pg8::Unit& u, int r, int c8, const float (&v0)[8], const float (&v1)[8]) {
          const size_t off = (size_t)(u.pm * 256 + r) * 1024 + u.pn * 256 + c8;
          const bf16* GBb = (const bf16*)(ws + WS_GB); bf16* MRG = (bf16*)(ws + WS_MRG);
          float gb[8], ma[8], f[8];
          unpack8(*(const v4u*)(GBb + off), gb); unpack8(*(const v4u*)(MRG + off), ma);
#pragma unroll
          for (int j = 0; j < 8; ++j) f[j] = ma[j] + sigm(gb[j]) * v0[j];
          *(v4u*)(MRG + off) = pack8(f);
          unpack8(*(const v4u*)(GBb + off + 128), gb); unpack8(*(const v4u*)(MRG + off + 128), ma);
#pragma unroll
          for (int j = 0; j < 8; ++j) f[j] = ma[j] + sigm(gb[j]) * v1[j];
          *(v4u*)(MRG + off + 128) = pack8(f);
      });
      pg8::gemm_phase<decltype(E), pg8::DenseOrder, false>(lds, 512, S, E);
    }
    xcd_barrier(bar);

    { unsigned char* ws = WSB(); const float* x = INP(I_X);
      pg8::DenseOrder S; S.init(ws + WS_MRG, ws + WS_WOUT, NTOK, 1024, 1024, G, bid);
      auto E = pg8::make_epi([=](const pg8::Unit& u, int r, int c8, const float (&v0)[8], const float (&v1)[8]) {
          const int row = u.pm * 256 + r, b = row >> 13, col = u.pn * 256 + c8;
          const float* gt = (const float*)(ws + WS_MOD) + b * 6144 + 2048 + col;
          const float* xp = x + (size_t)row * 1024 + col; float* op = (float*)(ws + WS_X1) + (size_t)row * 1024 + col;
          float ss = 0.f;
#pragma unroll
          for (int h = 0; h < 2; ++h) {
              const f32x4 g0 = *(const f32x4*)(gt + 128 * h), g1 = *(const f32x4*)(gt + 128 * h + 4), x0 = *(const f32x4*)(xp + 128 * h), x1 = *(const f32x4*)(xp + 128 * h + 4);
              const float (&v)[8] = h ? v1 : v0;
              f32x4 o0, o1;
              o0.x = x0.x + g0.x * v[0]; o0.y = x0.y + g0.y * v[1]; o0.z = x0.z + g0.z * v[2]; o0.w = x0.w + g0.w * v[3];
              o1.x = x1.x + g1.x * v[4]; o1.y = x1.y + g1.y * v[5]; o1.z = x1.z + g1.z * v[6]; o1.w = x1.w + g1.w * v[7];
              *(f32x4*)(op + 128 * h) = o0; *(f32x4*)(op + 128 * h + 4) = o1;
              ss += (o0.x * o0.x + o0.y * o0.y) + (o0.z * o0.z + o0.w * o0.w) + (o1.x * o1.x + o1.y * o1.y) + (o1.z * o1.z + o1.w * o1.w);
          }
          ss += __shfl_xor(ss, 16); ss += __shfl_xor(ss, 32);
          if (((c8 >> 3) & 3) == 0) ((float*)(ws + WS_PSQ))[(size_t)row * 16 + u.pn * 4 + (c8 >> 5)] = ss;
      });
      pg8::gemm_phase<decltype(E), pg8::DenseOrder, false>(lds, 1024, S, E);
    }
    xcd_barrier(bar);

    {
        unsigned char* ws = WSB(); const float* X1 = (const float*)(ws + WS_X1); const float* MOD = (const float*)(ws + WS_MOD); bf16* Hb = (bf16*)(ws + WS_H);
        const float* gffn = INP(I_GFFN); const float* wrt = INP(I_WR); const float* brt = INP(I_BR);
        const bf16* wrs = (const bf16*)(ws + WS_WRS); const float* psq = (const float*)(ws + WS_PSQ);
        int* TOPI = (int*)(ws + WS_TOPI); float* TOPW = (float*)(ws + WS_TOPW); int* BLKCNT = (int*)(ws + WS_BLKCNT);
        constexpr int WLS = 2064, WLO = 32 * WLS;
        LAS float* gsL = (LAS float*)(lds + 2 * WLO); LAS float* shL = gsL + 1024; LAS float* cvec = shL + 1024; LAS int* cnt = (LAS int*)(cvec + 32); LAS float* red = (LAS float*)(cnt + 32);
        const int tpb = NTOK / G, b = (bid * tpb) >> 13;
        for (int i = tid; i < 8192; i += NTHR) { const int hl = i >> 12, row = (i >> 7) & 31, cc = i & 127;
            *(LAS v4u*)(lds + hl * WLO + row * WLS + cc * 16) = *(const v4u*)(wrs + hl * 32768 + row * 1024 + cc * 8); }
        for (int i = tid; i < 1024; i += NTHR) { gsL[i] = gffn[i] * (1.f + MOD[b * 6144 + 4096 + i]); shL[i] = MOD[b * 6144 + 3072 + i]; }
        if (tid < 32) cnt[tid] = 0;
        __syncthreads();
        { const int part = tid >> 5, e = tid & 31; float a = 0.f;
          for (int k = 0; k < 64; ++k) a += shL[64 * part + k] * wrt[(64 * part + k) * 32 + e];
          red[part * 32 + e] = a;
          __syncthreads();
          if (tid < 32) { float t = brt[tid];
#pragma unroll
              for (int p = 0; p < 16; ++p) t += red[p * 32 + tid];
              cvec[tid] = t; }
          __syncthreads(); }
        const int fr = lane & 15, kq = lane >> 4;
        const int m = bid * tpb + wave * 16 + fr;
        float r;
        { const f32x4* pq = (const f32x4*)(psq + (size_t)m * 16); const f32x4 p0 = pq[0], p1 = pq[1], p2 = pq[2], p3 = pq[3];
          const float ss = ((p0.x + p0.y) + (p0.z + p0.w)) + ((p1.x + p1.y) + (p1.z + p1.w)) + ((p2.x + p2.y) + (p2.z + p2.w)) + ((p3.x + p3.y) + (p3.z + p3.w));
          r = rsqrtf(ss * (1.f / DM) + RMS_EPS); }
        f32x4 acc[2]; acc[0] = (f32x4){0.f, 0.f, 0.f, 0.f}; acc[1] = acc[0];
        const float* xr = X1 + (size_t)m * DM + 8 * kq; bf16* hr = Hb + (size_t)m * DM + 8 * kq;
#pragma unroll 4
        for (int ks = 0; ks < 32; ++ks) {
            const f32x4 xa = *(const f32x4*)(xr + 32 * ks), xb = *(const f32x4*)(xr + 32 * ks + 4);
            const int k0 = 32 * ks + 8 * kq;
            const f32x4 ga = *(const LAS f32x4*)(gsL + k0), gb = *(const LAS f32x4*)(gsL + k0 + 4), sa = *(const LAS f32x4*)(shL + k0), sb = *(const LAS f32x4*)(shL + k0 + 4);
            const float y[8] = {xa.x * ga.x, xa.y * ga.y, xa.z * ga.z, xa.w * ga.w, xb.x * gb.x, xb.y * gb.y, xb.z * gb.z, xb.w * gb.w};
            const float sh[8] = {sa.x, sa.y, sa.z, sa.w, sb.x, sb.y, sb.z, sb.w};
            float hv[8], yl[8]; v4u yhw;
#pragma unroll
            for (int j = 0; j < 8; ++j) hv[j] = y[j] * r + sh[j];
            *(v4u*)(hr + 32 * ks) = pack8(hv);
            yhw = pack8(y);
            { float yh[8]; unpack8(yhw, yh);
#pragma unroll
              for (int j = 0; j < 8; ++j) yl[j] = y[j] - yh[j]; }
            const bf16x8_t fyh = __builtin_bit_cast(bf16x8_t, yhw), fyl = __builtin_bit_cast(bf16x8_t, pack8(yl));
#pragma unroll
            for (int nt = 0; nt < 2; ++nt) {
                const bf16x8_t wh = *(const LAS bf16x8_t*)(lds + (16 * nt + fr) * WLS + k0 * 2), wl = *(const LAS bf16x8_t*)(lds + WLO + (16 * nt + fr) * WLS + k0 * 2);
                acc[nt] = __builtin_amdgcn_mfma_f32_16x16x32_bf16(wh, fyh, acc[nt], 0, 0, 0);
                acc[nt] = __builtin_amdgcn_mfma_f32_16x16x32_bf16(wh, fyl, acc[nt], 0, 0, 0);
                acc[nt] = __builtin_amdgcn_mfma_f32_16x16x32_bf16(wl, fyh, acc[nt], 0, 0, 0);
            }
        }
        float lv[8];
#pragma unroll
        for (int nt = 0; nt < 2; ++nt)
#pragma unroll
            for (int j = 0; j < 4; ++j) lv[4 * nt + j] = r * acc[nt][j] + cvec[16 * nt + 4 * kq + j];
        float tv[4]; int ti[4];
#pragma unroll
        for (int k = 0; k < 4; ++k) {
            float bv = lv[0]; int bi = 4 * kq;
#pragma unroll
            for (int j = 1; j < 8; ++j) { const int e = 16 * (j >> 2) + 4 * kq + (j & 3); if (lv[j] > bv) { bv = lv[j]; bi = e; } }
#pragma unroll
            for (int o = 16; o < 64; o <<= 1) { const float ov = __shfl_xor(bv, o); const int oi = __shfl_xor(bi, o); if (ov > bv || (ov == bv && oi < bi)) { bv = ov; bi = oi; } }
            tv[k] = bv; ti[k] = bi;
#pragma unroll
            for (int j = 0; j < 8; ++j) { const int e = 16 * (j >> 2) + 4 * kq + (j & 3); if (e == bi) lv[j] = -INFINITY; }
        }
        const float e1 = __expf(tv[1] - tv[0]), e2 = __expf(tv[2] - tv[0]), e3 = __expf(tv[3] - tv[0]);
        const float inv = 1.f / (1.f + e1 + e2 + e3);
        if (kq == 0) {
            *(int4*)(TOPI + (size_t)m * 4) = make_int4(ti[0], ti[1], ti[2], ti[3]);
            *(f32x4*)(TOPW + (size_t)m * 4) = (f32x4){inv, e1 * inv, e2 * inv, e3 * inv};
            atomicAdd((int*)&cnt[ti[0]], 1); atomicAdd((int*)&cnt[ti[1]], 1); atomicAdd((int*)&cnt[ti[2]], 1); atomicAdd((int*)&cnt[ti[3]], 1);
        }
        __syncthreads();
        if (tid < 32) BLKCNT[bid * 32 + tid] = cnt[tid];
    }
    xcd_barrier(bar);

    {
        unsigned char* ws = WSB(); const int* TOPI = (const int*)(ws + WS_TOPI); const float* TOPW = (const float*)(ws + WS_TOPW); const int* BLKCNT = (const int*)(ws + WS_BLKCNT);
        int* ROWTOK = (int*)(ws + WS_ROWTOK); float* ROWW = (float*)(ws + WS_ROWW); int* TILEE = (int*)(ws + WS_TILEE);
        LAS int* tot = (LAS int*)lds;
        LAS int* mine = tot + 32;
        LAS int* pst = mine + 32;
        LAS int* wcn = pst + 64;
        LAS int* rt = wcn + 256;
        LAS int* rm = rt + 512;
        const int tpb = NTOK / G;
        { const int part = tid >> 5, e = tid & 31; int t = 0, mn = 0;
          for (int k = part * (G / 16); k < (part + 1) * (G / 16); ++k) { const int c = BLKCNT[k * 32 + e]; t += c; if (k < bid) mn += c; }
          rt[part * 32 + e] = t; rm[part * 32 + e] = mn; }
        const int ent = TOPI[bid * tpb * 4 + tid];
        __syncthreads();
        if (tid < 32) { int t = 0, mn = 0;
#pragma unroll
            for (int p = 0; p < 16; ++p) { t += rt[p * 32 + tid]; mn += rm[p * 32 + tid]; }
            tot[tid] = t; mine[tid] = mn; }
        int rk = 0;
        for (int ex = 0; ex < 32; ++ex) { const unsigned long long mask = __ballot(ent == ex); if (ent == ex) rk = __popcll(mask & ((1ull << lane) - 1ull)); if (lane == ex) wcn[wave * 32 + ex] = __popcll(mask); }
        __syncthreads();
        if (tid == 0) { int a = 0; for (int e = 0; e < 32; ++e) { pst[e] = a; a += (tot[e] + 255) & ~255; } pst[32] = a; }
        __syncthreads();
        { int woff = 0;
          for (int w = 0; w < wave; ++w) woff += wcn[w * 32 + ent];
          const int pos = pst[ent] + mine[ent] + woff + rk;
          ROWTOK[pos] = (bid * tpb + (tid >> 2)) * 4 + (tid & 3);
          ROWW[pos] = TOPW[bid * tpb * 4 + tid]; }
        if (bid < 32) { const int e = bid; for (int pos = pst[e] + tot[e] + tid; pos < pst[e + 1]; pos += NTHR) { ROWTOK[pos] = -1; ROWW[pos] = 0.f; } }
        if (bid == 32 % G) {
            const int nt = pst[32] >> 8;
            for (int t = tid; t < nt; t += NTHR) { int e = 0; for (int k = 0; k < 32; ++k) if ((t << 8) >= pst[k]) e = k; TILEE[t] = e; }
            if (tid == 0) TILEE[1023] = nt;
        }
    }
    xcd_barrier(bar);

    { unsigned char* ws = WSB(); const float* bgu = INP(I_BGU);
      MoeOrder S; S.init(ws + WS_H, ws + WS_WGU, (const int*)(ws + WS_TILEE), (const int*)(ws + WS_ROWTOK), 8, (size_t)2048 * 1024 * 2, 1024, G, bid, true);
      auto E = pg8::make_epi([=](const pg8::Unit& u, int r, int c8, const float (&v0)[8], const float (&v1)[8]) {
          const int col = u.pn * 128 + c8; float f[8];
          const float* bg = bgu + (size_t)u.e * 2048 + col;
          const f32x4 bg0 = *(const f32x4*)bg, bg1 = *(const f32x4*)(bg + 4), bu0 = *(const f32x4*)(bg + 1024), bu1 = *(const f32x4*)(bg + 1028);
          const float bgv[8] = {bg0.x, bg0.y, bg0.z, bg0.w, bg1.x, bg1.y, bg1.z, bg1.w}, buv[8] = {bu0.x, bu0.y, bu0.z, bu0.w, bu1.x, bu1.y, bu1.z, bu1.w};
#pragma unroll
          for (int j = 0; j < 8; ++j) {
              const float gt = fminf(v0[j] + bgv[j], 7.f);
              const float up = fminf(fmaxf(v1[j] + buv[j], -7.f), 7.f);
              f[j] = (up + 1.f) * gt * sigm(1.702f * gt);
          }
          *(v4u*)((bf16*)(ws + WS_ACT) + (size_t)(u.pm * 256 + r) * 1024 + col) = pack8(f);
      });
      pg8::gemm_phase<decltype(E), MoeOrder, true>(lds, 1024, S, E);
    }
    xcd_barrier(bar);

    { unsigned char* ws = WSB(); const float* bdn = INP(I_BD);
      MoeOrder S; S.init(ws + WS_ACT, ws + WS_WD, (const int*)(ws + WS_TILEE), (const int*)(ws + WS_ROWTOK), 4, (size_t)1024 * 1024 * 2, 1024, G, bid, false);
      auto E = pg8::make_epi([=](const pg8::Unit& u, int r, int c8, const float (&v0)[8], const float (&v1)[8]) {
          const int srow = u.pm * 256 + r;
          const int rt = ((const int*)(ws + WS_ROWTOK))[srow];
          if (rt >= 0) {
              const float w = ((const float*)(ws + WS_ROWW))[srow]; const int col = u.pn * 256 + c8; float f[8];
              const float* bd = bdn + (size_t)u.e * 1024 + col;
              bf16* yp = (bf16*)(ws + WS_YS) + (size_t)rt * 1024 + col;
#pragma unroll
              for (int j = 0; j < 8; ++j) f[j] = (v0[j] + bd[j]) * w;
              *(v4u*)yp = pack8(f);
#pragma unroll
              for (int j = 0; j < 8; ++j) f[j] = (v1[j] + bd[128 + j]) * w;
              *(v4u*)(yp + 128) = pack8(f);
          }
      });
      pg8::gemm_phase<decltype(E), MoeOrder, false>(lds, 1024, S, E);
    }
    xcd_barrier(bar);

    { unsigned char* ws = WSB(); const float* X1 = (const float*)(ws + WS_X1); const float* MOD = (const float*)(ws + WS_MOD); const bf16* YS = (const bf16*)(ws + WS_YS); const float* gfin = INP(I_GFIN); float* outp = (float*)ldptr(lds, 25);
    for (int m = gw; m < NTOK; m += NGW) {
        const int b = m >> 13;
        const f32x4* xr = (const f32x4*)(X1 + (size_t)m * DM) + lane;
        f32x4 v[4]; float s = 0.f;
#pragma unroll
        for (int j = 0; j < 4; ++j) {
            const int col = 4 * lane + 256 * j;
            f32x4 a = (f32x4){0.f, 0.f, 0.f, 0.f};
#pragma unroll
            for (int sl = 0; sl < 4; ++sl) { const v2u w = *(const v2u*)(YS + ((size_t)m * 4 + sl) * 1024 + col); a.x += lo16(w.x); a.y += hi16(w.x); a.z += lo16(w.y); a.w += hi16(w.y); }
            const f32x4 gt = *(const f32x4*)(MOD + b * 6144 + 5120 + col);
            v[j] = xr[64 * j] + gt * a;
            s += (v[j].x * v[j].x + v[j].y * v[j].y) + (v[j].z * v[j].z + v[j].w * v[j].w);
        }
        const float r = rsqrtf(wave_sum(s) * (1.f / DM) + RMS_EPS);
        f32x4* op = (f32x4*)(outp + (size_t)m * DM) + lane;
#pragma unroll
        for (int j = 0; j < 4; ++j) { const f32x4 g = *(const f32x4*)(gfin + 4 * lane + 256 * j); op[64 * j] = v[j] * r * g; }
    } }
}

extern "C" void kernel_launch(void* const* d_in, const int* in_sizes, int n_in, void* d_out, int out_size, void* d_ws, size_t ws_size, hipStream_t stream) {
    static int grid = 0;
    if (grid == 0) {
        if (n_in != 25 || in_sizes[0] != NTOK * DM || out_size != NTOK * DM || ws_size < WS_END) {
            fprintf(stderr, "kernel_launch: unexpected shapes (n_in %d, in0 %d, out %d, ws %zu); nothing launched\n", n_in, n_in > 0 ? in_sizes[0] : -1, out_size, ws_size); grid = -1; return; }
        int dev = 0, cus = 0, per_cu = 0;
        if (hipGetDevice(&dev) != hipSuccess || hipDeviceGetAttribute(&cus, hipDeviceAttributeMultiprocessorCount, dev) != hipSuccess) { grid = -1; return; }
        if (hipFuncSetAttribute((const void*)mega_fwd, hipFuncAttributeMaxDynamicSharedMemorySize, LDS_BYTES) != hipSuccess) { fprintf(stderr, "kernel_launch: hipFuncSetAttribute failed\n"); grid = -1; return; }
        if (hipOccupancyMaxActiveBlocksPerMultiprocessor(&per_cu, (const void*)mega_fwd, NTHR, LDS_BYTES) != hipSuccess || per_cu < 1) {
            fprintf(stderr, "kernel_launch: occupancy query reports %d blocks per CU\n", per_cu); (void)hipGetLastError(); grid = -1; return; }
        grid = cus;
        if (NTOK % grid != 0) { fprintf(stderr, "kernel_launch: grid %d does not divide the token count\n", grid); grid = -1; return; }
    }
    if (grid < 0) return;
    (void)hipMemsetAsync((char*)d_ws + WS_CTL, 0, CTL_ZERO_BYTES, stream);
    Params p{};
    for (int i = 0; i < 25; ++i) p.in[i] = (const float*)d_in[i];
    p.out = (float*)d_out; p.ws = (unsigned char*)d_ws;
    hipLaunchKernelGGL(mega_fwd, dim3(grid), dim3(NTHR), LDS_BYTES, stream, p);
}
```

```cpp
#include <hip/hip_runtime.h>
#include <cstdio>
#include <cstdint>

#define GAS __attribute__((address_space(1)))
#define LAS __attribute__((address_space(3)))
typedef unsigned short bf16;
typedef unsigned v4u __attribute__((ext_vector_type(4)));
typedef unsigned v2u __attribute__((ext_vector_type(2)));
typedef float f32x4 __attribute__((ext_vector_type(4)));

constexpr int BATCH = 4, SEQ = 8192, DM = 1024, NTOK = BATCH * SEQ, INW = 4096;
constexpr int NH = 8, HD = 64, AW = 512, SW = 512, NG = 32, NP = 64, NC = 16;
constexpr int NE = 32, TOPK = 4, DFF = 1024, MAXTILES = 544, MAXROWS = MAXTILES * 256;
constexpr int NWAVES = 8, NTHR = 512;
constexpr float RMS_EPS = 1e-5f;

constexpr size_t MiB = 1u << 20;
constexpr size_t WS_CTL = 0, CTL_ZERO_BYTES = 64 * 1024;
constexpr size_t WS_MOD = 1 * MiB;
constexpr size_t WS_ROT = 2 * MiB;
constexpr size_t WS_KMEAN = 3 * MiB;
constexpr size_t WS_TOPI = 4 * MiB;
constexpr size_t WS_TOPW = 5 * MiB;
constexpr size_t WS_BLKCNT = 6 * MiB;
constexpr size_t WS_ROWTOK = 7 * MiB;
constexpr size_t WS_ROWW = 8 * MiB;
constexpr size_t WS_TILEE = 9 * MiB;
constexpr size_t WS_WIN = 16 * MiB, WS_WGLU = 24 * MiB, WS_WAO = 26 * MiB, WS_WOUT = 27 * MiB, WS_WGU = 32 * MiB, WS_WD = 160 * MiB;
constexpr size_t WS_X1 = 224 * MiB;
constexpr size_t WS_U = 352 * MiB, WS_Q = 384 * MiB, WS_K = 416 * MiB, WS_V = 448 * MiB, WS_GA = 480 * MiB, WS_GB = 544 * MiB, WS_O = 608 * MiB, WS_Y = 640 * MiB;
constexpr size_t WS_ACT = 352 * MiB;
constexpr size_t WS_H = 672 * MiB;
constexpr size_t WS_MRG = 736 * MiB;
constexpr size_t WS_YS = 672 * MiB;
constexpr size_t WS_ACNT = 32768;
constexpr size_t WS_LSE = 10 * MiB;
constexpr size_t WS_QCTR = 40960;
constexpr size_t WS_PSQ = 13 * MiB;
constexpr size_t WS_WRS = 15 * MiB;
constexpr size_t WS_ALIST = 352 * MiB;
constexpr size_t WS_PART = 800 * MiB;
constexpr size_t WS_S5T = 928 * MiB;
constexpr size_t WS_S5W = 952 * MiB;
constexpr size_t WS_XE = 960 * MiB;
constexpr size_t WS_UG = 976 * MiB;
constexpr size_t WS_END = 1016 * MiB;

constexpr int LDS_BYTES = 147456;
constexpr int LDS_MISC = 147456 - 512;
constexpr int LDS_PAR = 147456 - 1024;

__device__ __forceinline__ float bf2f(bf16 v) { return __builtin_bit_cast(float, (unsigned)v << 16); }
__device__ __forceinline__ unsigned f2bf(float f) { unsigned u = __builtin_bit_cast(unsigned, f); return (u + 0x7fffu + ((u >> 16) & 1u)) >> 16; }
__device__ __forceinline__ unsigned pk2(float lo, float hi) { return f2bf(lo) | (f2bf(hi) << 16); }
__device__ __forceinline__ float lo16(unsigned w) { return __builtin_bit_cast(float, w << 16); }
__device__ __forceinline__ float hi16(unsigned w) { return __builtin_bit_cast(float, w & 0xffff0000u); }
__device__ __forceinline__ float sigm(float x) { return __builtin_amdgcn_rcpf(1.f + __builtin_amdgcn_exp2f(-1.4426950408889634f * x)); }
__device__ __forceinline__ float wave_sum(float v) {
#pragma unroll
    for (int o = 1; o < 64; o <<= 1) v += __shfl_xor(v, o);
    return v;
}
__device__ __forceinline__ void unpack8(v4u w, float (&f)[8]) {
    f[0] = lo16(w.x); f[1] = hi16(w.x); f[2] = lo16(w.y); f[3] = hi16(w.y); f[4] = lo16(w.z); f[5] = hi16(w.z); f[6] = lo16(w.w); f[7] = hi16(w.w);
}
typedef float f32x2_t __attribute__((ext_vector_type(2))); typedef __bf16 bf16x2_t __attribute__((ext_vector_type(2)));
__device__ __forceinline__ unsigned cvtpk(float lo, float hi) { f32x2_t v = {lo, hi}; bf16x2_t b = __builtin_convertvector(v, bf16x2_t); return __builtin_bit_cast(unsigned, b); }
__device__ __forceinline__ v4u pack8(const float (&f)[8]) { v4u w; w.x = cvtpk(f[0], f[1]); w.y = cvtpk(f[2], f[3]); w.z = cvtpk(f[4], f[5]); w.w = cvtpk(f[6], f[7]); return w; }

#define XB_TMO      128
#define XB_XCNT(j)  (256  + 64 * (j))
#define XB_XSUB(j)  (1280 + 64 * (j))
#define XB_XGEN(j)  (2304 + 64 * (j))
#define XB_TOP      3328
#define XB_TOPGEN   3392
#define XCD_BAR_WORDS 3456
#define XB_SPIN_CAP (1u << 25)
__device__ __forceinline__ unsigned xb_ld(unsigned* p)              { return __hip_atomic_load(p, __ATOMIC_RELAXED, __HIP_MEMORY_SCOPE_AGENT); }
__device__ __forceinline__ unsigned xb_add(unsigned* p, unsigned v) { return __hip_atomic_fetch_add(p, v, __ATOMIC_RELAXED, __HIP_MEMORY_SCOPE_AGENT); }
__device__ __forceinline__ unsigned xb_xcc_id() { return (unsigned)__builtin_amdgcn_s_getreg((3 << 11) | 20) & 0xFu; }
#define XB_SPIN(cond, bar) do { unsigned _sp = 0; while (cond) { __builtin_amdgcn_s_sleep(1); \
    if ((++_sp & 255u) == 0u) { if (xb_ld(&(bar)[XB_TMO])) break; if (_sp > XB_SPIN_CAP) { atomicAdd(&(bar)[XB_TMO], 1u); break; } } } } while (0)
struct XcdBarrier { unsigned* bar; unsigned x; volatile LAS unsigned* st; };
__device__ __forceinline__ XcdBarrier xcd_barrier_post(unsigned* bar, volatile LAS unsigned* st) {
    XcdBarrier b; b.bar = bar; b.x = xb_xcc_id(); b.st = st;
    if (threadIdx.x == 0) (void)xb_add(&bar[XB_XCNT(b.x)], 1u);
    return b;
}
__device__ __forceinline__ void xcd_barrier_complete(unsigned* bar, unsigned x, unsigned& nloc, unsigned& nx) {
    const unsigned G = gridDim.x * gridDim.y * gridDim.z;
    unsigned sum, cnt, mine, sp = 0u;
    for (;;) {
        sum = 0u; cnt = 0u; mine = 0u;
#pragma unroll
        for (unsigned j = 0; j < 16; ++j) { const unsigned c = xb_ld(&bar[XB_XCNT(j)]); sum += c; cnt += (c > 0u) ? 1u : 0u; mine = (j == x) ? c : mine; }
        if (sum == G) break;
        __builtin_amdgcn_s_sleep(1);
        if ((++sp & 255u) == 0u) { if (xb_ld(&bar[XB_TMO])) break; if (sp > XB_SPIN_CAP) { atomicAdd(&bar[XB_TMO], 1u); break; } }
    }
    nloc = mine > 0u ? mine : 1u; nx = cnt > 0u ? cnt : 1u;
}
__device__ __forceinline__ void xcd_barrier(const XcdBarrier& b) {
    asm volatile("s_waitcnt vmcnt(0)" ::: "memory");
    __syncthreads();
    if (threadIdx.x == 0) {
        unsigned* bar = b.bar;
        __builtin_amdgcn_s_waitcnt(0);
        unsigned nloc = b.st[0], nx = b.st[1];
        if (nloc == 0u) { xcd_barrier_complete(bar, b.x, nloc, nx); b.st[0] = nloc; b.st[1] = nx; }
        const unsigned old = xb_add(&bar[XB_XSUB(b.x)], 1u);
        const unsigned gen = old / nloc;
        if (old + 1u == (gen + 1u) * nloc) {
            __builtin_amdgcn_fence(__ATOMIC_RELEASE, "agent");
            asm volatile("s_waitcnt vmcnt(0)" ::: "memory");
            const unsigned og = xb_add(&bar[XB_TOP], 1u);
            const unsigned tg = og / nx;
            if (og + 1u == (tg + 1u) * nx) xb_add(&bar[XB_TOPGEN], 1u);
            else XB_SPIN(xb_ld(&bar[XB_TOPGEN]) == tg, bar);
            __builtin_amdgcn_fence(__ATOMIC_ACQUIRE, "agent");
            xb_add(&bar[XB_XGEN(b.x)], 1u);
            asm volatile("s_waitcnt vmcnt(0)" ::: "memory");
        } else {
            XB_SPIN(xb_ld(&bar[XB_XGEN(b.x)]) == gen, bar);
            __builtin_amdgcn_fence(__ATOMIC_ACQUIRE, "agent");
            asm volatile("s_waitcnt vmcnt(0)" ::: "memory");
        }
    }
    __syncthreads();
}

struct Params { const float* in[25]; float* out; unsigned char* ws; };
enum { I_X = 0, I_C, I_WADA, I_BADA, I_GMIX, I_WIN, I_ARE, I_AIM, I_LOGDT, I_BRE, I_BIM, I_CRE, I_CIM, I_SD, I_WGLU, I_WAO, I_WOUT, I_GFFN, I_WR, I_BR, I_WGU, I_BGU, I_WD, I_BD, I_GFIN };

__device__ __forceinline__ int ilv(int n) { const int g = n >= 1024, m = n - 1024 * g; return (m >> 7) * 256 + ((m & 127) >> 5) * 64 + 32 * g + (m & 31); }

__device__ __forceinline__ void transpose_item(const float* W, int K, int N, bf16* WT, bool interleave, LAS float* scr, int item, int lane) {
    const int nblk = N / 32, kb = item / nblk, nb = item % nblk, k0 = 64 * kb, n0 = 32 * nb;
#pragma unroll 8
    for (int i = 0; i < 32; ++i) { const int kk = 2 * i + (lane >> 5); scr[kk * 33 + (lane & 31)] = W[(size_t)(k0 + kk) * N + n0 + (lane & 31)]; }
    asm volatile("s_waitcnt lgkmcnt(0)" ::: "memory");
    const int c = lane & 7;
    const int r0 = interleave ? ilv(n0) : n0;
#pragma unroll
    for (int j = 0; j < 4; ++j) { const int n = (lane >> 3) + 8 * j; const LAS float* s = scr + (8 * c) * 33 + n;
        v4u o; o.x = pk2(s[0 * 33], s[1 * 33]); o.y = pk2(s[2 * 33], s[3 * 33]); o.z = pk2(s[4 * 33], s[5 * 33]); o.w = pk2(s[6 * 33], s[7 * 33]);
        *(v4u*)(WT + (size_t)(r0 + n) * K + k0 + 8 * c) = o; }
    asm volatile("s_waitcnt lgkmcnt(0)" ::: "memory");
}

namespace pg8 {
typedef short bf16x8 __attribute__((ext_vector_type(8)));
constexpr int BM = 256, BK = 64, HALF = 128, HTB = HALF * BK * 2, STAGE_BYTES = 8 * HTB, NXCD = 8, WGM = 8;
__host__ __device__ __forceinline__ int lds_byte(int r, int c) { const int st = (r >> 4) * 2 + (c >> 5), rr = r & 15, cc = c & 31, ob = rr * 64 + cc * 2; return st * 1024 + (ob ^ (((ob >> 9) & 1) << 5)); }
__host__ __device__ __forceinline__ void stage_rc(int b, int& R, int& C) { const int st = b / 1024, sb = b % 1024, swz = sb ^ (((sb >> 9) & 1) << 5); R = (st >> 1) * 16 + swz / 64; C = (st & 1) * 32 + (swz % 64) / 2; }
__host__ __device__ __forceinline__ int perm32(int rho) { const int n = rho >> 4, i = rho & 15; return 8 * (i >> 2) + 4 * n + (i & 3); }
struct Unit { int pm, pn, e, pad; const char* A; const char* B; };

struct DenseOrder {
    const char* A; const char* Bt; int nM, nN, nwg, G, c; size_t tstep;
    __device__ __forceinline__ void init(const void* A_, const void* Bt_, int M, int N, int K, int G_, int c_) { A = (const char*)A_; Bt = (const char*)Bt_; nM = M / BM; nN = N / BM; nwg = nM * nN; G = G_; c = c_; tstep = (size_t)BM * K * 2; }
    __device__ __forceinline__ bool next(int i, Unit& u) const {
        const long L = (long)i * G + c; if (L >= nwg) return false;
        int wgid = (int)L; { const int q = nwg / NXCD, r = nwg % NXCD, xcd = wgid % NXCD, off = wgid / NXCD; wgid = (xcd < r ? xcd * (q + 1) : r * (q + 1) + (xcd - r) * q) + off; }
        const int nig = WGM * nN, gid = wgid / nig, fm = gid * WGM, gsz = (nM - fm) < WGM ? (nM - fm) : WGM;
        u.pm = fm + ((wgid % nig) % gsz); u.pn = (wgid % nig) / gsz; u.e = 0; u.A = A + (size_t)u.pm * tstep; u.B = Bt + (size_t)u.pn * tstep; return true;
    }
    __device__ __forceinline__ unsigned rowoff(const Unit&, int) const { return 0u; }
};

template <class Epi, class Sched, bool GATHER>
__device__ __forceinline__ void gemm_phase(LAS unsigned char* lds, const int K, const Sched& S, const Epi& E, const int lda_ = 0) {
    int tid = threadIdx.x; asm volatile("" : "+v"(tid));
    const int wid = __builtin_amdgcn_readfirstlane(tid >> 6), lane = tid & 63, wr = wid >> 2, wc = wid & 3, fr = lane & 15, fq = lane >> 4;
    const int nt = K / BK, lda = lda_ ? lda_ : K;
    int sR[2], sC[2];
    unsigned voffA[2][2], nvoffA[2][2], voffB[2][2];
#pragma unroll
    for (int i = 0; i < 2; ++i) { int R, C; stage_rc(tid * 16 + i * 8192, R, C); sR[i] = R; sC[i] = C; const int Rb = 64 * (R >> 5) + perm32(R & 31);
        voffA[0][i] = (unsigned)(R * lda + C) * 2u; voffA[1][i] = (unsigned)((R + HALF) * lda + C) * 2u; voffB[0][i] = (unsigned)(Rb * K + C) * 2u; voffB[1][i] = (unsigned)((Rb + 32) * K + C) * 2u;
        nvoffA[0][i] = voffA[0][i]; nvoffA[1][i] = voffA[1][i]; }
    const size_t kstep = (size_t)(BK * 2);
    const unsigned ldsw = (unsigned)wid * 1024u;
    const int aoff = lds_byte(wr * 64 + fr, fq * 8), boff = lds_byte(wc * 32 + fr, fq * 8);
#define PG8_SA(b, h) (((b) * 2 + (h)) * HTB)
#define PG8_SB(b, h) ((4 + (b) * 2 + (h)) * HTB)
#define PG8_STAGE(bufoff, gbase, v0, v1) do { \
        __builtin_amdgcn_global_load_lds((const unsigned*)((const char*)(gbase) + (v0)), (LAS unsigned*)(lds + (bufoff) + ldsw), 16, 0, 0); \
        __builtin_amdgcn_global_load_lds((const unsigned*)((const char*)(gbase) + (v1)), (LAS unsigned*)(lds + (bufoff) + ldsw + 8192), 16, 0, 0); } while (0)
#define PG8_LDA(dst, b, h) do { _Pragma("unroll") for (int m = 0; m < 4; ++m) _Pragma("unroll") for (int k = 0; k < 2; ++k) dst[m][k] = *(const LAS bf16x8*)(lds + PG8_SA(b, h) + aoff + m * 2048 + k * 1024); } while (0)
#define PG8_LDB(dst, b, h) do { _Pragma("unroll") for (int n = 0; n < 2; ++n) _Pragma("unroll") for (int k = 0; k < 2; ++k) dst[n][k] = *(const LAS bf16x8*)(lds + PG8_SB(b, h) + boff + n * 2048 + k * 1024); } while (0)
#define PG8_MMA(ai, bj, At, Bt) do { __builtin_amdgcn_s_setprio(1); _Pragma("unroll") for (int m = 0; m < 4; ++m) _Pragma("unroll") for (int n = 0; n < 2; ++n) _Pragma("unroll") for (int k = 0; k < 2; ++k) \
        acc[ai][bj][m][n] = __builtin_amdgcn_mfma_f32_16x16x32_bf16(Bt[n][k], At[m][k], acc[ai][bj][m][n], 0, 0, 0); __builtin_amdgcn_s_setprio(0); } while (0)
#define PG8_WAIT_V(n) asm volatile("s_waitcnt vmcnt(" #n ")" ::: "memory")
#define PG8_WAIT_L(n) asm volatile("s_waitcnt lgkmcnt(" #n ")" ::: "memory")
#define PG8_BAR __builtin_amdgcn_s_barrier()
#define PG8_SCHED __builtin_amdgcn_sched_barrier(0)
    Unit cur, nxt; int ui = 0;
    if (!S.next(0, cur)) return;
    if constexpr (GATHER) {
#pragma unroll
        for (int h = 0; h < 2; ++h)
#pragma unroll
            for (int i = 0; i < 2; ++i) voffA[h][i] = S.rowoff(cur, h * HALF + sR[i]) + (unsigned)sC[i] * 2u;
    }
    f32x4 acc[2][2][4][2];
#pragma unroll
    for (int a = 0; a < 2; ++a)
#pragma unroll
        for (int b = 0; b < 2; ++b)
#pragma unroll
            for (int m = 0; m < 4; ++m)
#pragma unroll
                for (int n = 0; n < 2; ++n) acc[a][b][m][n] = (f32x4){0.f, 0.f, 0.f, 0.f};
    bf16x8 At[4][2], B0[2][2], B1[2][2];
    const char* cA = cur.A; const char* cB = cur.B;
    PG8_STAGE(PG8_SB(0, 0), cB, voffB[0][0], voffB[0][1]); PG8_STAGE(PG8_SB(0, 1), cB, voffB[1][0], voffB[1][1]); PG8_STAGE(PG8_SA(0, 0), cA, voffA[0][0], voffA[0][1]); PG8_STAGE(PG8_SA(0, 1), cA, voffA[1][0], voffA[1][1]);
    if (wr == 1) PG8_BAR;
    PG8_WAIT_V(2); PG8_BAR;
    PG8_STAGE(PG8_SB(1, 0), cB + kstep, voffB[0][0], voffB[0][1]); PG8_STAGE(PG8_SA(1, 0), cA + kstep, voffA[0][0], voffA[0][1]); PG8_STAGE(PG8_SB(1, 1), cB + kstep, voffB[1][0], voffB[1][1]);
    PG8_WAIT_V(6); PG8_BAR;
    for (;;) {
        const bool has_next = S.next(ui + 1, nxt);
        const char* nA = has_next ? nxt.A : cA; const char* nB = has_next ? nxt.B : cB;
        if constexpr (GATHER) {
            if (has_next) {
#pragma unroll
                for (int h = 0; h < 2; ++h)
#pragma unroll
                    for (int i = 0; i < 2; ++i) nvoffA[h][i] = S.rowoff(nxt, h * HALF + sR[i]) + (unsigned)sC[i] * 2u;
            } else {
#pragma unroll
                for (int h = 0; h < 2; ++h)
#pragma unroll
                    for (int i = 0; i < 2; ++i) nvoffA[h][i] = voffA[h][i];
            }
        }
        for (int t = 0; t < nt; t += 2) {
            const bool last = (t == nt - 2);
            const char* a1 = cA + (size_t)(t + 1) * kstep;
            const char* a2 = last ? nA : cA + (size_t)(t + 2) * kstep; const char* b2 = last ? nB : cB + (size_t)(t + 2) * kstep;
            const char* a3 = a2 + kstep; const char* b3 = b2 + kstep;
            unsigned w00, w01, w10, w11;
            if constexpr (GATHER) { w00 = last ? nvoffA[0][0] : voffA[0][0]; w01 = last ? nvoffA[0][1] : voffA[0][1]; w10 = last ? nvoffA[1][0] : voffA[1][0]; w11 = last ? nvoffA[1][1] : voffA[1][1]; }
            else { w00 = voffA[0][0]; w01 = voffA[0][1]; w10 = voffA[1][0]; w11 = voffA[1][1]; }
            PG8_LDB(B0, 0, 0); PG8_LDB(B1, 0, 1); PG8_SCHED; PG8_LDA(At, 0, 0); PG8_STAGE(PG8_SA(1, 1), a1, voffA[1][0], voffA[1][1]);
            PG8_WAIT_V(8); PG8_WAIT_L(0); PG8_BAR; PG8_MMA(0, 0, At, B0); PG8_MMA(0, 1, At, B1); PG8_BAR; PG8_SCHED;
            PG8_LDA(At, 0, 1); PG8_STAGE(PG8_SB(0, 0), b2, voffB[0][0], voffB[0][1]); PG8_STAGE(PG8_SB(0, 1), b2, voffB[1][0], voffB[1][1]); PG8_STAGE(PG8_SA(0, 0), a2, w00, w01);
            PG8_WAIT_V(8); PG8_WAIT_L(0); PG8_BAR; PG8_MMA(1, 0, At, B0); PG8_MMA(1, 1, At, B1); PG8_BAR; PG8_SCHED;
            PG8_LDB(B0, 1, 0); PG8_LDB(B1, 1, 1); PG8_SCHED; PG8_LDA(At, 1, 0); PG8_STAGE(PG8_SA(0, 1), a2, w10, w11);
            PG8_WAIT_V(8); PG8_WAIT_L(0); PG8_BAR; PG8_MMA(0, 0, At, B0); PG8_MMA(0, 1, At, B1); PG8_BAR; PG8_SCHED;
            PG8_LDA(At, 1, 1); PG8_STAGE(PG8_SB(1, 0), b3, voffB[0][0], voffB[0][1]); PG8_STAGE(PG8_SB(1, 1), b3, voffB[1][0], voffB[1][1]); PG8_STAGE(PG8_SA(1, 0), a3, w00, w01);
            PG8_WAIT_V(8); PG8_WAIT_L(0); PG8_BAR; PG8_MMA(1, 0, At, B0); PG8_MMA(1, 1, At, B1); PG8_BAR; PG8_SCHED;
        }
        if (wr == 0) PG8_BAR;
        E(acc, cur, wr, wc, fr, fq);
        if (!has_next) break;
#pragma unroll
        for (int a = 0; a < 2; ++a)
#pragma unroll
            for (int b = 0; b < 2; ++b)
#pragma unroll
                for (int m = 0; m < 4; ++m)
#pragma unroll
                    for (int n = 0; n < 2; ++n) acc[a][b][m][n] = (f32x4){0.f, 0.f, 0.f, 0.f};
        cur = nxt; cA = nA; cB = nB; ++ui;
        if constexpr (GATHER) {
#pragma unroll
            for (int h = 0; h < 2; ++h)
#pragma unroll
                for (int i = 0; i < 2; ++i) voffA[h][i] = nvoffA[h][i];
        }
        if (wr == 1) PG8_BAR;
    }
    PG8_WAIT_V(0);
    PG8_BAR;
#undef PG8_SA
#undef PG8_SB
#undef PG8_STAGE
#undef PG8_LDA
#undef PG8_LDB
#undef PG8_MMA
#undef PG8_WAIT_V
#undef PG8_WAIT_L
#undef PG8_BAR
#undef PG8_SCHED
}

struct NoData {};
template <int NB, class CP, class RP, class F> struct EpiRows {
    CP cp; RP rp; F f;
    __device__ __forceinline__ void operator()(const f32x4 (&acc)[2][2][4][2], const Unit& u, int wr, int wc, int fr, int fq) const {
        const int c8 = wc * 64 + 8 * fq;
        const auto cd = cp(u, c8);
#pragma unroll
        for (int ai = 0; ai < 2; ++ai)
#pragma unroll
            for (int mb = 0; mb < 4; mb += NB) {
                decltype(rp(u, 0, 0)) rd[NB];
#pragma unroll
                for (int m = 0; m < NB; ++m) rd[m] = rp(u, ai * HALF + wr * 64 + (mb + m) * 16 + fr, c8);
#pragma unroll
                for (int m = 0; m < NB; ++m) {
                    float v0[8], v1[8];
#pragma unroll
                    for (int j = 0; j < 4; ++j) { v0[j] = acc[ai][0][mb + m][0][j]; v0[4 + j] = acc[ai][0][mb + m][1][j]; v1[j] = acc[ai][1][mb + m][0][j]; v1[4 + j] = acc[ai][1][mb + m][1][j]; }
                    f(u, ai * HALF + wr * 64 + (mb + m) * 16 + fr, c8, v0, v1, cd, rd[m]);
                }
            }
    }
};
template <int NB = 4, class CP, class RP, class F> __device__ __forceinline__ EpiRows<NB, CP, RP, F> make_epi(CP cp, RP rp, F f) { return EpiRows<NB, CP, RP, F>{cp, rp, f}; }
struct F16 { float v[16]; };
__device__ __forceinline__ F16 ld16(const float* p0, const float* p1) { F16 r; const f32x4 a = *(const f32x4*)p0, b = *(const f32x4*)(p0 + 4), c = *(const f32x4*)p1, d = *(const f32x4*)(p1 + 4);
    r.v[0] = a.x; r.v[1] = a.y; r.v[2] = a.z; r.v[3] = a.w; r.v[4] = b.x; r.v[5] = b.y; r.v[6] = b.z; r.v[7] = b.w; r.v[8] = c.x; r.v[9] = c.y; r.v[10] = c.z; r.v[11] = c.w; r.v[12] = d.x; r.v[13] = d.y; r.v[14] = d.z; r.v[15] = d.w; return r; }
}

struct MoeOrder {
    const char* A; const char* Bt; const int* tile_e; const int* rowtok; int nt, npn, G, c, tpg, K; bool gather; size_t estride, tstep;
    __device__ __forceinline__ void init(const void* A_, const void* Bt_, const int* tile_e_, const int* rowtok_, int npn_, size_t estride_, int K_, int G_, int c_, bool gather_) {
        A = (const char*)A_; Bt = (const char*)Bt_; tile_e = tile_e_; rowtok = rowtok_; npn = npn_; estride = estride_; K = K_; G = G_; c = c_; gather = gather_;
        nt = tile_e_[1023]; tpg = (G / 8) / npn; tstep = (size_t)256 * K_ * 2;
    }
    __device__ __forceinline__ bool next(int i, pg8::Unit& u) const {
        const int xc = c & 7, ci = c >> 3, group = i * 8 + xc, tile = group * tpg + ci / npn;
        if (tile >= nt) return false;
        u.pm = tile; u.pn = ci % npn; u.e = tile_e[tile];
        u.A = gather ? A : A + (size_t)tile * tstep; u.B = Bt + (size_t)u.e * estride + (size_t)u.pn * tstep; return true;
    }
    __device__ __forceinline__ unsigned rowoff(const pg8::Unit& u, int r) const { const int rt = rowtok[u.pm * 256 + r]; return (unsigned)(rt < 0 ? 0 : (rt >> 2)) * (unsigned)(K * 2); }
};


struct S5Order {
    const char* A; const char* Bt; int npn, c, G; size_t bstride, btile;
    __device__ __forceinline__ void init(const void* A_, const void* Bt_, int npn_, size_t bstride_, size_t btile_, int G_, int c_) { A = (const char*)A_; Bt = (const char*)Bt_; npn = npn_; bstride = bstride_; btile = btile_; G = G_; c = c_; }
    __device__ __forceinline__ bool next(int i, pg8::Unit& u) const {
        if (i > 0) return false;
        const int xc = c & 7, ci = c >> 3, per = 4 * npn;
        if (ci >= 4 * per) return false;
        const int g = 4 * xc + ci / per, rem = ci % per;
        u.e = g; u.pm = rem / npn; u.pn = rem % npn;
        u.A = A + ((size_t)g * 1024 + (size_t)u.pm * 256) * 640 * 2; u.B = Bt + (size_t)g * bstride + (size_t)u.pn * btile; return true;
    }
    __device__ __forceinline__ unsigned rowoff(const pg8::Unit&, int) const { return 0u; }
};

struct EpiInProj {
    unsigned char* ws;
    __device__ __forceinline__ void operator()(const f32x4 (&acc)[2][2][4][2], const pg8::Unit& u, int wr, int wc, int fr, int fq) const {
        const int pn = u.pn;
        size_t boff; int ld, cb;
        if (pn < 8) { boff = WS_U + (size_t)(pn >> 1) * (32 * MiB); ld = 512; cb = 256 * (pn & 1); }
        else { boff = WS_GA + (size_t)((pn - 8) >> 2) * (64 * MiB); ld = 1024; cb = 256 * ((pn - 8) & 3); }
        const int c8 = wc * 64 + 8 * fq;
        const bool rot = (pn >= 2 && pn < 6), isk = (pn == 4 || pn == 5);
        const bool t1 = (fq == 0), t2 = (fq == 1);
        float cs0[8], cs1[8];
#pragma unroll
        for (int j = 0; j < 8; ++j) { cs0[j] = 0.f; cs1[j] = 0.f; }
#pragma unroll
        for (int ai = 0; ai < 2; ++ai)
#pragma unroll
            for (int m = 0; m < 4; ++m) {
                const int r = ai * 128 + wr * 64 + m * 16 + fr, row = u.pm * 256 + r;
                float v0[8], v1[8];
#pragma unroll
                for (int j = 0; j < 4; ++j) { v0[j] = acc[ai][0][m][0][j]; v0[4 + j] = acc[ai][0][m][1][j]; v1[j] = acc[ai][1][m][0][j]; v1[4 + j] = acc[ai][1][m][1][j]; }
                if (rot) {
                    float o0[8];
#pragma unroll
                    for (int j = 0; j < 8; ++j) o0[j] = __shfl_xor(v0[j], 16);
                    if (t1 || t2) {
                        const float kf[8] = {1.5915494309189535e-1f, 3.086376340470123e-2f, 5.985185712713705e-3f, 1.160663641240061e-3f, 2.2507907903927653e-4f, 4.364795279280289e-5f, 8.464330808241401e-6f, 1.6414262627950345e-6f};
                        const float pos = (float)(row & (SEQ - 1));
                        float cs[8], sn[8];
#pragma unroll
                        for (int j = 0; j < 8; ++j) { const float rev = __builtin_amdgcn_fractf(pos * kf[j]); cs[j] = __builtin_amdgcn_cosf(rev); sn[j] = __builtin_amdgcn_sinf(rev); }
#pragma unroll
                        for (int j = 0; j < 8; ++j) {
                            v0[j] = t1 ? (v0[j] * cs[j] - o0[j] * sn[j]) : (v0[j] * cs[j] + o0[j] * sn[j]);
                        }
                    }
                }
                if (isk) {
#pragma unroll
                    for (int j = 0; j < 8; ++j) { cs0[j] += v0[j]; cs1[j] += v1[j]; }
                }
                if (pn < 2) {
                    const int col = 256 * pn + c8, R = row >> 5, sl = row & 31;
                    bf16* ug = (bf16*)(ws + WS_UG);
                    *(v4u*)(ug + ((size_t)(col >> 4) * 1024 + R) * 640 + sl * 16 + (col & 15)) = pack8(v0);
                    *(v4u*)(ug + ((size_t)((col + 32) >> 4) * 1024 + R) * 640 + sl * 16 + (col & 15)) = pack8(v1);
                } else {
                    bf16* o = (bf16*)(ws + boff) + (size_t)row * ld + cb + c8;
                    *(v4u*)o = pack8(v0); *(v4u*)(o + 32) = pack8(v1);
                }
            }
        if (isk) {
#pragma unroll
            for (int j = 0; j < 8; ++j) {
#pragma unroll
                for (int o = 1; o < 16; o <<= 1) { cs0[j] += __shfl_xor(cs0[j], o); cs1[j] += __shfl_xor(cs1[j], o); }
            }
            if (fr == 0) {
                const int b = u.pm >> 5, jb = u.pm & 31, d = 8 * fq, h0 = 4 * (pn - 4) + wc;
                float* kp = (float*)(ws + WS_KMEAN) + (size_t)wr * (BATCH * NH * 32 * 64);
                float* p0 = kp + ((b * NH + h0) * 32 + jb) * 64 + d; float* p1 = p0 + 32;
                *(f32x4*)p0 = (f32x4){cs0[0], cs0[1], cs0[2], cs0[3]}; *(f32x4*)(p0 + 4) = (f32x4){cs0[4], cs0[5], cs0[6], cs0[7]};
                *(f32x4*)p1 = (f32x4){cs1[0], cs1[1], cs1[2], cs1[3]}; *(f32x4*)(p1 + 4) = (f32x4){cs1[4], cs1[5], cs1[6], cs1[7]};
            }
        }
    }
};

typedef short bf16x8_t __attribute__((ext_vector_type(8)));
typedef short v4i16_t __attribute__((ext_vector_type(4)));
constexpr int AT_STRIDE = 160, AT_K = 0, AT_V = 256 * AT_STRIDE, AT_PRE = 2 * 256 * AT_STRIDE, AT_CN = AT_PRE + 4096, AT_WT = AT_CN + 4096;

__device__ __forceinline__ void attn_load_kv(LAS unsigned char* lds, const bf16* Kb, const bf16* Vb, size_t row0, int h, int tid) {
    v4u kv[4], vv[4];
#pragma unroll
    for (int i = 0; i < 4; ++i) { const int ch = tid + 512 * i, row = ch >> 3, cc = ch & 7;
        kv[i] = *(const v4u*)(Kb + (row0 + row) * 512 + h * 64 + cc * 8); vv[i] = *(const v4u*)(Vb + (row0 + row) * 512 + h * 64 + cc * 8); }
#pragma unroll
    for (int i = 0; i < 4; ++i) { const int ch = tid + 512 * i, row = ch >> 3, cc = ch & 7;
        *(LAS v4u*)(lds + AT_K + row * AT_STRIDE + cc * 16) = kv[i]; *(LAS v4u*)(lds + AT_V + row * AT_STRIDE + cc * 16) = vv[i]; }
}
template <bool CAUSAL>
__device__ __forceinline__ void attn_tile(LAS unsigned char* lds, const bf16x8_t (&qf)[2], int qloc, int lane, f32x4 (&o)[4], float& mrow, float& lrow) {
    const int fr = lane & 15, fq = lane >> 4;
    f32x4 acc[16];
#pragma unroll
    for (int kb = 0; kb < 16; ++kb) {
        const LAS unsigned char* kp = lds + AT_K + (16 * kb + fr) * AT_STRIDE + fq * 16;
        const bf16x8_t a0 = *(const LAS bf16x8_t*)kp, a1 = *(const LAS bf16x8_t*)(kp + 64);
        f32x4 z = (f32x4){0.f, 0.f, 0.f, 0.f};
        z = __builtin_amdgcn_mfma_f32_16x16x32_bf16(a0, qf[0], z, 0, 0, 0);
        acc[kb] = __builtin_amdgcn_mfma_f32_16x16x32_bf16(a1, qf[1], z, 0, 0, 0);
    }
    if (CAUSAL) {
#pragma unroll
        for (int kb = 0; kb < 16; ++kb)
#pragma unroll
            for (int r = 0; r < 4; ++r) if (16 * kb + 4 * fq + r > qloc) acc[kb][r] = -1e30f;
    }
    float m = acc[0][0];
#pragma unroll
    for (int kb = 0; kb < 16; ++kb)
#pragma unroll
        for (int r = 0; r < 4; ++r) m = fmaxf(m, acc[kb][r]);
    m = fmaxf(m, __shfl_xor(m, 16)); m = fmaxf(m, __shfl_xor(m, 32));
    const float c = 0.125f * 1.4426950408889634f;
    float ls = 0.f;
#pragma unroll
    for (int kb = 0; kb < 16; ++kb)
#pragma unroll
        for (int r = 0; r < 4; ++r) { const float p = __builtin_amdgcn_exp2f((acc[kb][r] - m) * c); ls += p; acc[kb][r] = p; }
    ls += __shfl_xor(ls, 16); ls += __shfl_xor(ls, 32);
#pragma unroll
    for (int db = 0; db < 4; ++db) o[db] = (f32x4){0.f, 0.f, 0.f, 0.f};
    const LAS unsigned char* vbase = lds + AT_V + (4 * fq + (fr >> 2)) * AT_STRIDE + (fr & 3) * 8;
#pragma unroll
    for (int ks = 0; ks < 8; ++ks) {
        v4u pw; pw.x = cvtpk(acc[2 * ks][0], acc[2 * ks][1]); pw.y = cvtpk(acc[2 * ks][2], acc[2 * ks][3]); pw.z = cvtpk(acc[2 * ks + 1][0], acc[2 * ks + 1][1]); pw.w = cvtpk(acc[2 * ks + 1][2], acc[2 * ks + 1][3]);
        const bf16x8_t pf = __builtin_bit_cast(bf16x8_t, pw);
#pragma unroll
        for (int db = 0; db < 4; ++db) {
            const v4i16_t lo = __builtin_amdgcn_ds_read_tr16_b64_v4i16((LAS v4i16_t*)(vbase + (32 * ks) * AT_STRIDE + db * 32));
            const v4i16_t hi = __builtin_amdgcn_ds_read_tr16_b64_v4i16((LAS v4i16_t*)(vbase + (32 * ks + 16) * AT_STRIDE + db * 32));
            const bf16x8_t vt = (bf16x8_t){lo[0], lo[1], lo[2], lo[3], hi[0], hi[1], hi[2], hi[3]};
            o[db] = __builtin_amdgcn_mfma_f32_16x16x32_bf16(vt, pf, o[db], 0, 0, 0);
        }
    }
    mrow = m; lrow = ls;
}

__device__ __forceinline__ const void* ldptr(LAS unsigned char* lds, int i) {
    const unsigned long long v = ((volatile LAS unsigned long long*)(lds + LDS_PAR))[i];
    const unsigned lo = __builtin_amdgcn_readfirstlane((unsigned)v), hi = __builtin_amdgcn_readfirstlane((unsigned)(v >> 32));
    return (const void*)(const GAS void*)(((unsigned long long)hi << 32) | lo);
}
#define INP(i) ((const float*)ldptr(lds, (i)))
#define WSB() ((unsigned char*)ldptr(lds, 26))
__global__ void __launch_bounds__(NTHR, 2) mega_fwd(Params P) {
    extern __shared__ __attribute__((aligned(16))) unsigned char lds_raw[];
    LAS unsigned char* lds = (LAS unsigned char*)lds_raw;
    volatile LAS unsigned* MISC = (volatile LAS unsigned*)(lds + LDS_MISC);
    const int tid = threadIdx.x, lane = tid & 63, wave = __builtin_amdgcn_readfirstlane(tid >> 6);
    const int G = gridDim.x, bid = blockIdx.x;
    const int gw = bid * NWAVES + wave, NGW = G * NWAVES;
    if (tid < 128) MISC[tid] = 0u;
    if (tid < 25) ((LAS unsigned long long*)(lds + LDS_PAR))[tid] = (unsigned long long)P.in[tid];
    if (tid == 25) ((LAS unsigned long long*)(lds + LDS_PAR))[25] = (unsigned long long)P.out;
    if (tid == 26) ((LAS unsigned long long*)(lds + LDS_PAR))[26] = (unsigned long long)P.ws;
    __syncthreads();
    XcdBarrier bar = xcd_barrier_post((unsigned*)(P.ws + WS_CTL) + 1024, MISC + 8);

    {
        unsigned char* ws = WSB(); float* MOD = (float*)(ws + WS_MOD); float* ROT = (float*)(ws + WS_ROT);
        if (bid >= 64) {
            LAS float* cond = (LAS float*)lds;
            LAS float* red = cond + 4096;
            const float* c = INP(I_C);
            for (int i = tid; i < 4096; i += NTHR) { const float v = c[i]; cond[i] = v * sigm(v); }
            __syncthreads();
            const int hw = wave * 2 + (lane >> 5), col = (bid - 64) * 32 + (lane & 31);
            const float* w = INP(I_WADA) + (size_t)(hw * 64) * 6144 + col;
            float a0 = 0.f, a1 = 0.f, a2 = 0.f, a3 = 0.f;
#pragma unroll 16
            for (int k = 0; k < 64; ++k) { const float wv = w[(size_t)k * 6144]; const int kk = hw * 64 + k;
                a0 += cond[kk] * wv; a1 += cond[1024 + kk] * wv; a2 += cond[2048 + kk] * wv; a3 += cond[3072 + kk] * wv; }
            red[(hw * 4 + 0) * 32 + (lane & 31)] = a0; red[(hw * 4 + 1) * 32 + (lane & 31)] = a1; red[(hw * 4 + 2) * 32 + (lane & 31)] = a2; red[(hw * 4 + 3) * 32 + (lane & 31)] = a3;
            __syncthreads();
            if (tid < 128) { const int b = tid >> 5, cc = tid & 31; float a = 0.f;
#pragma unroll
                for (int h = 0; h < 16; ++h) a += red[(h * 4 + b) * 32 + cc];
                const int j = (bid - 64) * 32 + cc; MOD[b * 6144 + j] = a + INP(I_BADA)[j]; }
            __syncthreads();
        }
        if (bid >= 32 && bid < 64) {
            for (int i = (bid - 32) * NTHR + tid; i < SEQ * 8; i += 32 * NTHR) {
                const int s = i >> 3, d = i & 7;
                const float inv = 1.0f / powf(500000.0f, (float)(2 * d) / 16.0f);
                const float ang = (float)s * inv;
                float sn, cs; sincosf(ang, &sn, &cs);
                ROT[2 * i] = cs; ROT[2 * i + 1] = sn;
            }
            const float* wr = INP(I_WR); bf16* wrs = (bf16*)(ws + WS_WRS);
            for (int i = (bid - 32) * NTHR + tid; i < 32 * 1024; i += 32 * NTHR) { const int e = i >> 10, k = i & 1023; const float v = wr[k * 32 + e];
                const unsigned hb = f2bf(v); const float hv = bf2f((bf16)hb); wrs[i] = (bf16)hb; wrs[32768 + i] = (bf16)f2bf(v - hv); }
        }
        if (bid < NG) {
            const int g = bid;
            LAS float* APr = (LAS float*)lds;
            LAS float* APi = APr + 33 * 64;
            LAS float* BBr = APi + 33 * 64;
            LAS float* BBi = BBr + 1024;
            LAS float* CCr = BBi + 1024;
            LAS float* CCi = CCr + 1024;
            LAS float* KRN = CCi + 1024;
            const float dt = expf(INP(I_LOGDT)[g]);
            const float* are = INP(I_ARE) + g * 64; const float* aim = INP(I_AIM) + g * 64;
            for (int i = tid; i < 33 * 64; i += NTHR) { const int lag = i >> 6, p = i & 63; const float lr = are[p], li = aim[p];
                const float mg = expf(lr * dt * (float)lag); float sn, cs; sincosf(li * dt * (float)lag, &sn, &cs); APr[i] = mg * cs; APi[i] = mg * sn; }
            { const float* pbre = INP(I_BRE) + g * 1024; const float* pbim = INP(I_BIM) + g * 1024; const float* pcre = INP(I_CRE) + g * 1024; const float* pcim = INP(I_CIM) + g * 1024;
              for (int i = tid; i < 1024; i += NTHR) { const int p = i >> 4; const float lr = are[p], li = aim[p];
                const float mg = expf(lr * dt); float sn, cs; sincosf(li * dt, &sn, &cs); const float ar = mg * cs, ai = mg * sn, den = lr * lr + li * li;
                const float cfr = ((ar - 1.f) * lr + ai * li) / den, cfi = (ai * lr - (ar - 1.f) * li) / den;
                const float br = pbre[i], bi = pbim[i]; BBr[i] = cfr * br - cfi * bi; BBi[i] = cfr * bi + cfi * br;
                CCr[i] = pcre[i]; CCi[i] = pcim[i]; } }
            __syncthreads();
            for (int i = tid; i < 32 * 256; i += NTHR) { const int lag = i >> 8, co = (i >> 4) & 15, ci = i & 15; float a = 0.f;
                for (int p = 0; p < 64; ++p) { const float cr = CCr[co * 64 + p], cim = CCi[co * 64 + p], pr = APr[lag * 64 + p], pi = APi[lag * 64 + p];
                    const float car = cr * pr - cim * pi, cai = cr * pi + cim * pr; a += car * BBr[p * 16 + ci] - cai * BBi[p * 16 + ci]; }
                KRN[i] = a; }
            __syncthreads();
            bf16* T = (bf16*)(ws + WS_S5T) + (size_t)g * 512 * 640;
            for (int ch = tid; ch < 512 * 80; ch += NTHR) { const int row = ch / 80, col = (ch % 80) * 8, t = row >> 4, co = row & 15; float f[8];
                if (col < 512) { const int sx = col >> 4, ci0 = col & 15;
#pragma unroll
                    for (int j = 0; j < 8; ++j) f[j] = (sx <= t) ? KRN[((t - sx) * 16 + co) * 16 + ci0 + j] : 0.f; }
                else { const int cx = col - 512, ri = cx >> 6, p0 = cx & 63;
#pragma unroll
                    for (int j = 0; j < 8; ++j) { const int p = p0 + j; const float cr = CCr[co * 64 + p], cim = CCi[co * 64 + p], pr = APr[(t + 1) * 64 + p], pi = APi[(t + 1) * 64 + p];
                        f[j] = ri ? -(cr * pi + cim * pr) : (cr * pr - cim * pi); } }
                *(v4u*)(T + (size_t)row * 640 + col) = pack8(f); }
            bf16* W1 = (bf16*)(ws + WS_S5W) + (size_t)g * 256 * 512;
            for (int ch = tid; ch < 256 * 64; ch += NTHR) { const int row = ch >> 6, col = (ch & 63) * 8; float f[8];
                if (row < 128) { const int ri = row >> 6, p = row & 63, sx = col >> 4, ci0 = col & 15; const float pr = APr[(31 - sx) * 64 + p], pi = APi[(31 - sx) * 64 + p];
#pragma unroll
                    for (int j = 0; j < 8; ++j) { const float br = BBr[p * 16 + ci0 + j], bi = BBi[p * 16 + ci0 + j]; f[j] = ri ? (pr * bi + pi * br) : (pr * br - pi * bi); } }
                else {
#pragma unroll
                    for (int j = 0; j < 8; ++j) f[j] = 0.f; }
                *(v4u*)(W1 + (size_t)row * 512 + col) = pack8(f); }
            __syncthreads();
        }
        LAS float* scr = (LAS float*)(lds + wave * 16384);
        constexpr int I_IN = 16 * 128, I_GL = 8 * 64, I_AO = 8 * 32, I_OU = 16 * 32, I_GU1 = 16 * 64, I_D1 = 16 * 32;
        constexpr int NIT = I_IN + I_GL + I_AO + I_OU + NE * I_GU1 + NE * I_D1;
        int* qctr = (int*)(ws + WS_QCTR);
        for (;;) {
          int qb = 0; if (lane == 0) qb = atomicAdd(qctr, 4); qb = __builtin_amdgcn_readfirstlane(qb);
          if (qb >= NIT) break;
          for (int it = qb; it < qb + 4 && it < NIT; ++it) {
            int r = it;
            if (r < I_IN) { transpose_item(INP(I_WIN), 1024, 4096, (bf16*)(ws + WS_WIN), false, scr, r, lane); continue; } r -= I_IN;
            if (r < I_GL) { transpose_item(INP(I_WGLU), 512, 2048, (bf16*)(ws + WS_WGLU), true, scr, r, lane); continue; } r -= I_GL;
            if (r < I_AO) { transpose_item(INP(I_WAO), 512, 1024, (bf16*)(ws + WS_WAO), false, scr, r, lane); continue; } r -= I_AO;
            if (r < I_OU) { transpose_item(INP(I_WOUT), 1024, 1024, (bf16*)(ws + WS_WOUT), false, scr, r, lane); continue; } r -= I_OU;
            if (r < NE * I_GU1) { const int e = r / I_GU1; transpose_item(INP(I_WGU) + (size_t)e * 1024 * 2048, 1024, 2048, (bf16*)(ws + WS_WGU) + (size_t)e * 2048 * 1024, true, scr, r % I_GU1, lane); continue; } r -= NE * I_GU1;
            { const int e = r / I_D1; transpose_item(INP(I_WD) + (size_t)e * 1024 * 1024, 1024, 1024, (bf16*)(ws + WS_WD) + (size_t)e * 1024 * 1024, false, scr, r % I_D1, lane); }
          }
        }
    }
    xcd_barrier(bar);

    { unsigned char* ws = WSB(); const float* x = INP(I_X); const float* gmix = INP(I_GMIX); const float* MOD = (const float*)(ws + WS_MOD); bf16* Hb = (bf16*)(ws + WS_H);
      const int tpb = NTOK / G, b = (bid * tpb) >> 13;
      LAS float* gsL = (LAS float*)lds; LAS float* shL = gsL + 1024;
      for (int i = tid; i < 1024; i += NTHR) { gsL[i] = gmix[i] * (1.f + MOD[b * 6144 + 1024 + i]); shL[i] = MOD[b * 6144 + i]; }
      __syncthreads();
      f32x4 gv[4], sv[4];
#pragma unroll
      for (int j = 0; j < 4; ++j) { gv[j] = *(const LAS f32x4*)(gsL + 4 * lane + 256 * j); sv[j] = *(const LAS f32x4*)(shL + 4 * lane + 256 * j); }
      const int rpw = tpb / NWAVES;
      for (int r0 = 0; r0 < rpw; r0 += 4) {
          f32x4 v[4][4]; float ss[4];
#pragma unroll
          for (int rr = 0; rr < 4; ++rr) { const f32x4* xr = (const f32x4*)(x + (size_t)(bid * tpb + wave * rpw + r0 + rr) * DM) + lane;
#pragma unroll
              for (int j = 0; j < 4; ++j) v[rr][j] = xr[64 * j]; }
#pragma unroll
          for (int rr = 0; rr < 4; ++rr) { float t = 0.f;
#pragma unroll
              for (int j = 0; j < 4; ++j) t += (v[rr][j].x * v[rr][j].x + v[rr][j].y * v[rr][j].y) + (v[rr][j].z * v[rr][j].z + v[rr][j].w * v[rr][j].w);
              ss[rr] = t; }
#pragma unroll
          for (int o = 1; o < 64; o <<= 1) {
#pragma unroll
              for (int rr = 0; rr < 4; ++rr) ss[rr] += __shfl_xor(ss[rr], o); }
#pragma unroll
          for (int rr = 0; rr < 4; ++rr) { const float r = rsqrtf(ss[rr] * (1.f / DM) + RMS_EPS);
              v2u* o8 = (v2u*)(Hb + (size_t)(bid * tpb + wave * rpw + r0 + rr) * DM) + lane;
#pragma unroll
              for (int j = 0; j < 4; ++j) { const f32x4 t = v[rr][j] * r * gv[j] + sv[j]; v2u w; w.x = cvtpk(t.x, t.y); w.y = cvtpk(t.z, t.w); o8[64 * j] = w; } }
      }
    }
    xcd_barrier(bar);

    { unsigned char* ws = WSB();
      pg8::DenseOrder S; S.init(ws + WS_H, ws + WS_WIN, NTOK, INW, 1024, G, bid);
      EpiInProj E{ws};
      pg8::gemm_phase<EpiInProj, pg8::DenseOrder, false>(lds, 1024, S, E);
    }
    xcd_barrier(bar);

    { unsigned char* ws = WSB();
      S5Order S; S.init(ws + WS_UG, ws + WS_S5W, 1, (size_t)256 * 512 * 2, 0, G, bid);
      auto E = pg8::make_epi([=](const pg8::Unit&, int) { return pg8::NoData{}; }, [=](const pg8::Unit&, int, int) { return pg8::NoData{}; },
        [=](const pg8::Unit& u, int r, int c8, const float (&v0)[8], const float (&v1)[8], const pg8::NoData&, const pg8::NoData&) {
          if (c8 < 128) {
              float* xe = (float*)(ws + WS_XE) + ((size_t)u.e * 1024 + u.pm * 256 + r) * 128 + c8;
              *(f32x4*)xe = (f32x4){v0[0], v0[1], v0[2], v0[3]}; *(f32x4*)(xe + 4) = (f32x4){v0[4], v0[5], v0[6], v0[7]};
              *(f32x4*)(xe + 32) = (f32x4){v1[0], v1[1], v1[2], v1[3]}; *(f32x4*)(xe + 36) = (f32x4){v1[4], v1[5], v1[6], v1[7]};
          }
      });
      pg8::gemm_phase<decltype(E), S5Order, false>(lds, 512, S, E, 640);
    }
    { unsigned char* ws = WSB();
      const bf16* Qb_ = (const bf16*)(ws + WS_Q); const float* km0 = (const float*)(ws + WS_KMEAN);
      int* acnt = (int*)(ws + WS_ACNT); unsigned short* alist = (unsigned short*)(ws + WS_ALIST);
      for (int it = gw; it < BATCH * NH * 128; it += NGW) {
        const int b = it >> 10, h = (it >> 7) & 7, chk = it & 127, s_ = chk * 64 + lane, nb = chk >> 2;
        if (nb == 0) continue;
        const size_t qrow = (size_t)b * SEQ + s_;
        v4u qp[8];
#pragma unroll
        for (int i = 0; i < 8; ++i) qp[i] = ((const v4u*)(Qb_ + qrow * 512 + h * 64))[i];
        float g0 = -INFINITY, g1 = -INFINITY, g2 = -INFINITY; int s0 = 0, s1 = 0, s2 = 0;
        for (int j = 0; j < nb; ++j) {
            const float* km = km0 + ((b * NH + h) * 32 + j) * 64;
            float g = 0.f;
#pragma unroll
            for (int i = 0; i < 8; ++i) { float f[8]; unpack8(qp[i], f);
#pragma unroll
                for (int jj = 0; jj < 8; ++jj) g += f[jj] * (km[8 * i + jj] + km[BATCH * NH * 32 * 64 + 8 * i + jj]); }
            if (g > g0) { g2 = g1; s2 = s1; g1 = g0; s1 = s0; g0 = g; s0 = j; }
            else if (g > g1) { g2 = g1; s2 = s1; g1 = g; s1 = j; }
            else if (g > g2) { g2 = g; s2 = j; }
        }
        const int nsel = nb < 3 ? nb : 3;
        if (nsel < 2) s1 = -1;
        if (nsel < 3) s2 = -1;
        int myn = 0;
        for (int j = 0; j < nb; ++j) { const bool mt = (s0 == j) || (s1 == j) || (s2 == j); const unsigned long long mask = __ballot(mt); if (lane == j) myn = __popcll(mask); }
        int basev = 0;
        if (lane < nb && myn > 0) basev = atomicAdd(&acnt[(b * NH + h) * 32 + lane], myn);
        for (int j = 0; j < nb; ++j) {
            const bool mt = (s0 == j) || (s1 == j) || (s2 == j); const unsigned long long mask = __ballot(mt); const int base = __shfl(basev, j);
            if (mt) { const int slot = (s0 == j) ? 0 : ((s1 == j) ? 1 : 2); const int pos = base + __popcll(mask & ((1ull << lane) - 1ull));
                alist[(size_t)((b * NH + h) * 32 + j) * 8192 + pos] = (unsigned short)(s_ | (slot << 13)); }
        }
      }
    }
    xcd_barrier(bar);

    if (gw < BATCH * NG) {
        unsigned char* ws = WSB();
        const int b = gw >> 5, g = gw & 31, p = lane;
        const float lr = INP(I_ARE)[g * 64 + p], li = INP(I_AIM)[g * 64 + p], dt = expf(INP(I_LOGDT)[g]);
        const float mg = expf(lr * dt * 32.f); float sn, cs; sincosf(li * dt * 32.f, &sn, &cs);
        const float ar = mg * cs, ai = mg * sn;
        const float* xe = (const float*)(ws + WS_XE) + ((size_t)g * 1024 + b * 256) * 128 + p;
        bf16* xp = (bf16*)(ws + WS_UG) + ((size_t)g * 1024 + b * 256) * 640 + 512 + p;
        float xr = 0.f, xi = 0.f;
        for (int k0 = 0; k0 < 256; k0 += 8) {
            float er[8], ei[8];
#pragma unroll
            for (int k = 0; k < 8; ++k) { er[k] = xe[(size_t)(k0 + k) * 128]; ei[k] = xe[(size_t)(k0 + k) * 128 + 64]; }
#pragma unroll
            for (int k = 0; k < 8; ++k) {
                xp[(size_t)(k0 + k) * 640] = (bf16)f2bf(xr); xp[(size_t)(k0 + k) * 640 + 64] = (bf16)f2bf(xi);
                const float nr = ar * xr - ai * xi + er[k], ni = ar * xi + ai * xr + ei[k]; xr = nr; xi = ni;
            }
        }
    }
    { unsigned char* ws = WSB();
      const bf16* Qb_ = (const bf16*)(ws + WS_Q); const bf16* Kb_ = (const bf16*)(ws + WS_K); const bf16* Vb_ = (const bf16*)(ws + WS_V);
      const int* acnt = (const int*)(ws + WS_ACNT); const unsigned short* alist = (const unsigned short*)(ws + WS_ALIST);
      bf16* part = (bf16*)(ws + WS_PART); float* lsep = (float*)(ws + WS_LSE);
      LAS int* pre = (LAS int*)(lds + AT_PRE); LAS int* cn = (LAS int*)(lds + AT_CN); LAS int* wt = (LAS int*)(lds + AT_WT);
      __syncthreads();
      { const int c0 = acnt[2 * tid], c1 = acnt[2 * tid + 1]; cn[2 * tid] = c0; cn[2 * tid + 1] = c1;
        const int n0 = (c0 + 127) >> 7, n1 = (c1 + 127) >> 7; int v = n0 + n1;
#pragma unroll
        for (int o = 1; o < 64; o <<= 1) { const int t = __shfl_up(v, o); if (lane >= o) v += t; }
        if (lane == 63) wt[wave] = v;
        __syncthreads();
        int off = 0;
        for (int w = 0; w < wave; ++w) off += wt[w];
        pre[2 * tid] = off + v - n1; pre[2 * tid + 1] = off + v; }
      __syncthreads();
      const int total = pre[1023];
      for (int item = bid; item < total; item += G) {
          int lo = 0, hi = 1023;
          while (lo < hi) { const int mid = (lo + hi) >> 1; if (pre[mid] > item) hi = mid; else lo = mid + 1; }
          const int l = lo, seg = item - (l ? pre[l - 1] : 0), cnt = cn[l];
          const int b = l >> 8, h = (l >> 5) & 7, j = l & 31;
          __syncthreads();
          attn_load_kv(lds, Kb_, Vb_, (size_t)b * SEQ + (size_t)j * 256, h, tid);
          const int fr = lane & 15, fq = lane >> 4;
          const int idx = seg * 128 + wave * 16 + fr; const bool valid = idx < cnt;
          const unsigned e = alist[(size_t)l * 8192 + (valid ? idx : seg * 128)];
          const int s_ = e & 8191, slot = e >> 13; const size_t tok = (size_t)b * SEQ + s_;
          bf16x8_t qf[2];
          qf[0] = *(const bf16x8_t*)(Qb_ + tok * 512 + h * 64 + 8 * fq); qf[1] = *(const bf16x8_t*)(Qb_ + tok * 512 + h * 64 + 32 + 8 * fq);
          __syncthreads();
          f32x4 o[4]; float m, ls;
          attn_tile<false>(lds, qf, 0, lane, o, m, ls);
          if (valid) {
              const float il = 1.f / ls; const size_t pidx = (tok * 8 + h) * 3 + slot;
#pragma unroll
              for (int db = 0; db < 4; ++db) { v2u w; w.x = cvtpk(o[db][0] * il, o[db][1] * il); w.y = cvtpk(o[db][2] * il, o[db][3] * il); *(v2u*)(part + pidx * 64 + 16 * db + 4 * fq) = w; }
              if (fq == 0) lsep[pidx] = m * 0.125f + __logf(ls);
          }
      }
    }
    xcd_barrier(bar);

    { unsigned char* ws = WSB(); const float* dsk = INP(I_SD);
      S5Order S; S.init(ws + WS_UG, ws + WS_S5T, 2, (size_t)512 * 640 * 2, (size_t)256 * 640 * 2, G, bid);
      struct U2 { v4u a, b; };
      auto E = pg8::make_epi(
        [=](const pg8::Unit& u, int c8) { const int co = c8 & 15; return pg8::ld16(dsk + u.e * 16 + co, dsk + u.e * 16 + co); },
        [=](const pg8::Unit& u, int r, int c8) { const int n = 256 * u.pn + c8; const bf16* ug = (const bf16*)(ws + WS_UG) + ((size_t)u.e * 1024 + u.pm * 256 + r) * 640;
            U2 d; d.a = *(const v4u*)(ug + n); d.b = *(const v4u*)(ug + n + 32); return d; },
        [=](const pg8::Unit& u, int r, int c8, const float (&v0)[8], const float (&v1)[8], const pg8::F16& dd, const U2& ud) {
          const int g = u.e, R = u.pm * 256 + r;
#pragma unroll
          for (int h = 0; h < 2; ++h) {
              const int n = 256 * u.pn + 32 * h + c8, t = n >> 4, co = n & 15;
              float uu[8]; unpack8(h ? ud.b : ud.a, uu);
              float f[8];
#pragma unroll
              for (int j = 0; j < 8; ++j) { const float y = (h ? v1[j] : v0[j]) + dd.v[j] * uu[j]; f[j] = y * sigm(1.5957691216f * (y + 0.044715f * y * y * y)); }
              *(v4u*)((bf16*)(ws + WS_Y) + ((size_t)R * 32 + t) * 512 + g * 16 + co) = pack8(f);
          }
      });
      pg8::gemm_phase<decltype(E), S5Order, false>(lds, 640, S, E, 640);
    }
    { unsigned char* ws = WSB();
      const bf16* Qb_ = (const bf16*)(ws + WS_Q); const bf16* Kb_ = (const bf16*)(ws + WS_K); const bf16* Vb_ = (const bf16*)(ws + WS_V);
      const bf16* part = (const bf16*)(ws + WS_PART); const float* lsep = (const float*)(ws + WS_LSE); bf16* Ob_ = (bf16*)(ws + WS_O);
      for (int item = bid; item < BATCH * NH * 32 * 2; item += G) {
          const int l = item >> 1, half = item & 1, b = l >> 8, h = (l >> 5) & 7, nb = l & 31;
          __syncthreads();
          attn_load_kv(lds, Kb_, Vb_, (size_t)b * SEQ + (size_t)nb * 256, h, tid);
          const int fr = lane & 15, fq = lane >> 4;
          const int qloc = half * 128 + wave * 16 + fr; const size_t tok = (size_t)b * SEQ + nb * 256 + qloc;
          bf16x8_t qf[2];
          qf[0] = *(const bf16x8_t*)(Qb_ + tok * 512 + h * 64 + 8 * fq); qf[1] = *(const bf16x8_t*)(Qb_ + tok * 512 + h * 64 + 32 + 8 * fq);
          __syncthreads();
          f32x4 o[4]; float m, ls;
          attn_tile<true>(lds, qf, qloc, lane, o, m, ls);
          const int nsel = nb < 3 ? nb : 3;
          const float lse_own = m * 0.125f + __logf(ls);
          float lt[3]; float M = lse_own;
#pragma unroll
          for (int t = 0; t < 3; ++t) { lt[t] = (t < nsel) ? lsep[(tok * 8 + h) * 3 + t] : -1e30f; M = fmaxf(M, lt[t]); }
          const float w0 = __expf(lse_own - M); float den = w0;
          const float sc0 = w0 / ls;
#pragma unroll
          for (int db = 0; db < 4; ++db) o[db] = o[db] * sc0;
#pragma unroll
          for (int t = 0; t < 3; ++t) {
              if (t < nsel) {
                  const float w = __expf(lt[t] - M); den += w;
#pragma unroll
                  for (int db = 0; db < 4; ++db) { const v2u pw = *(const v2u*)(part + ((tok * 8 + h) * 3 + t) * 64 + 16 * db + 4 * fq);
                      o[db][0] += w * lo16(pw.x); o[db][1] += w * hi16(pw.x); o[db][2] += w * lo16(pw.y); o[db][3] += w * hi16(pw.y); }
              }
          }
          const float id = 1.f / den;
#pragma unroll
          for (int db = 0; db < 4; ++db) { v2u w; w.x = cvtpk(o[db][0] * id, o[db][1] * id); w.y = cvtpk(o[db][2] * id, o[db][3] * id); *(v2u*)(Ob_ + tok * 512 + h * 64 + 16 * db + 4 * fq) = w; }
      }
    }
    xcd_barrier(bar);

    { unsigned char* ws = WSB();
      pg8::DenseOrder S; S.init(ws + WS_Y, ws + WS_WGLU, NTOK, 2048, 512, G, bid);
      auto E = pg8::make_epi([=](const pg8::Unit&, int) { return pg8::NoData{}; },
        [=](const pg8::Unit& u, int r, int c8) { return *(const v4u*)((const bf16*)(ws + WS_GA) + (size_t)(u.pm * 256 + r) * 1024 + u.pn * 128 + (c8 >> 6) * 32 + (c8 & 31)); },
        [=](const pg8::Unit& u, int r, int c8, const float (&v0)[8], const float (&v1)[8], const pg8::NoData&, const v4u& gaw) {
          const size_t off = (size_t)(u.pm * 256 + r) * 1024 + u.pn * 128 + (c8 >> 6) * 32 + (c8 & 31);
          float ga[8]; unpack8(gaw, ga);
          float f[8];
#pragma unroll
          for (int j = 0; j < 8; ++j) f[j] = sigm(ga[j]) * v0[j] * sigm(v1[j]);
          *(v4u*)((bf16*)(ws + WS_MRG) + off) = pack8(f);
      });
      pg8::gemm_phase<decltype(E), pg8::DenseOrder, false>(lds, 512, S, E);
    }
    xcd_barrier(bar);

    { unsigned char* ws = WSB();
      pg8::DenseOrder S; S.init(ws + WS_O, ws + WS_WAO, NTOK, 1024, 512, G, bid);
      struct R4 { v4u g0, g1, m0, m1; };
      auto E = pg8::make_epi<2>([=](const pg8::Unit&, int) { return pg8::NoData{}; },
        [=](const pg8::Unit& u, int r, int c8) { const size_t off = (size_t)(u.pm * 256 + r) * 1024 + u.pn * 256 + c8;
            const bf16* GBb = (const bf16*)(ws + WS_GB); const bf16* MRG = (const bf16*)(ws + WS_MRG);
            R4 d; d.g0 = *(const v4u*)(GBb + off); d.g1 = *(const v4u*)(GBb + off + 32); d.m0 = *(const v4u*)(MRG + off); d.m1 = *(const v4u*)(MRG + off + 32); return d; },
        [=](const pg8::Unit& u, int r, int c8, const float (&v0)[8], const float (&v1)[8], const pg8::NoData&, const R4& d) {
          const size_t off = (size_t)(u.pm * 256 + r) * 1024 + u.pn * 256 + c8;
          bf16* MRG = (bf16*)(ws + WS_MRG);
          float gb[8], ma[8], f[8];
          unpack8(d.g0, gb); unpack8(d.m0, ma);
#pragma unroll
          for (int j = 0; j < 8; ++j) f[j] = ma[j] + sigm(gb[j]) * v0[j];
          *(v4u*)(MRG + off) = pack8(f);
          unpack8(d.g1, gb); unpack8(d.m1, ma);
#pragma unroll
          for (int j = 0; j < 8; ++j) f[j] = ma[j] + sigm(gb[j]) * v1[j];
          *(v4u*)(MRG + off + 32) = pack8(f);
      });
      pg8::gemm_phase<decltype(E), pg8::DenseOrder, false>(lds, 512, S, E);
    }
    xcd_barrier(bar);

    { unsigned char* ws = WSB(); const float* x = INP(I_X);
      pg8::DenseOrder S; S.init(ws + WS_MRG, ws + WS_WOUT, NTOK, 1024, 1024, G, bid);
      auto E = pg8::make_epi<2>(
        [=](const pg8::Unit& u, int c8) { const float* gt = (const float*)(ws + WS_MOD) + ((u.pm * 256) >> 13) * 6144 + 2048 + u.pn * 256 + c8; return pg8::ld16(gt, gt + 32); },
        [=](const pg8::Unit& u, int r, int c8) { const float* xp = x + (size_t)(u.pm * 256 + r) * 1024 + u.pn * 256 + c8; return pg8::ld16(xp, xp + 32); },
        [=](const pg8::Unit& u, int r, int c8, const float (&v0)[8], const float (&v1)[8], const pg8::F16& gt, const pg8::F16& xv) {
          const int row = u.pm * 256 + r, col = u.pn * 256 + c8;
          float* op = (float*)(ws + WS_X1) + (size_t)row * 1024 + col;
          float o[16]; float ss = 0.f;
#pragma unroll
          for (int j = 0; j < 8; ++j) { o[j] = xv.v[j] + gt.v[j] * v0[j]; o[8 + j] = xv.v[8 + j] + gt.v[8 + j] * v1[j]; }
#pragma unroll
          for (int j = 0; j < 16; ++j) ss += o[j] * o[j];
          *(f32x4*)op = (f32x4){o[0], o[1], o[2], o[3]}; *(f32x4*)(op + 4) = (f32x4){o[4], o[5], o[6], o[7]};
          *(f32x4*)(op + 32) = (f32x4){o[8], o[9], o[10], o[11]}; *(f32x4*)(op + 36) = (f32x4){o[12], o[13], o[14], o[15]};
          ss += __shfl_xor(ss, 16); ss += __shfl_xor(ss, 32);
          if ((c8 & 63) == 0) ((float*)(ws + WS_PSQ))[(size_t)row * 16 + u.pn * 4 + (c8 >> 6)] = ss;
      });
      pg8::gemm_phase<decltype(E), pg8::DenseOrder, false>(lds, 1024, S, E);
    }
    xcd_barrier(bar);

    {
        unsigned char* ws = WSB(); const float* X1 = (const float*)(ws + WS_X1); const float* MOD = (const float*)(ws + WS_MOD); bf16* Hb = (bf16*)(ws + WS_H);
        const float* gffn = INP(I_GFFN); const float* wrt = INP(I_WR); const float* brt = INP(I_BR);
        const bf16* wrs = (const bf16*)(ws + WS_WRS); const float* psq = (const float*)(ws + WS_PSQ);
        int* TOPI = (int*)(ws + WS_TOPI); float* TOPW = (float*)(ws + WS_TOPW); int* BLKCNT = (int*)(ws + WS_BLKCNT);
        constexpr int WLS = 2064, WLO = 32 * WLS;
        LAS float* gsL = (LAS float*)(lds + 2 * WLO); LAS float* shL = gsL + 1024; LAS float* cvec = shL + 1024; LAS int* cnt = (LAS int*)(cvec + 32); LAS float* red = (LAS float*)(cnt + 32);
        const int tpb = NTOK / G, b = (bid * tpb) >> 13;
        for (int i = tid; i < 8192; i += NTHR) { const int hl = i >> 12, row = (i >> 7) & 31, cc = i & 127;
            *(LAS v4u*)(lds + hl * WLO + row * WLS + cc * 16) = *(const v4u*)(wrs + hl * 32768 + row * 1024 + cc * 8); }
        for (int i = tid; i < 1024; i += NTHR) { gsL[i] = gffn[i] * (1.f + MOD[b * 6144 + 4096 + i]); shL[i] = MOD[b * 6144 + 3072 + i]; }
        if (tid < 32) cnt[tid] = 0;
        __syncthreads();
        { const int part = tid >> 5, e = tid & 31; float a = 0.f;
          for (int k = 0; k < 64; ++k) a += shL[64 * part + k] * wrt[(64 * part + k) * 32 + e];
          red[part * 32 + e] = a;
          __syncthreads();
          if (tid < 32) { float t = brt[tid];
#pragma unroll
              for (int p = 0; p < 16; ++p) t += red[p * 32 + tid];
              cvec[tid] = t; }
          __syncthreads(); }
        const int fr = lane & 15, kq = lane >> 4;
        const int m = bid * tpb + wave * 16 + fr;
        float r;
        { const f32x4* pq = (const f32x4*)(psq + (size_t)m * 16); const f32x4 p0 = pq[0], p1 = pq[1], p2 = pq[2], p3 = pq[3];
          const float ss = ((p0.x + p0.y) + (p0.z + p0.w)) + ((p1.x + p1.y) + (p1.z + p1.w)) + ((p2.x + p2.y) + (p2.z + p2.w)) + ((p3.x + p3.y) + (p3.z + p3.w));
          r = rsqrtf(ss * (1.f / DM) + RMS_EPS); }
        f32x4 acc[2]; acc[0] = (f32x4){0.f, 0.f, 0.f, 0.f}; acc[1] = acc[0];
        const float* xr = X1 + (size_t)m * DM + 8 * kq; bf16* hr = Hb + (size_t)m * DM + 8 * kq;
#pragma unroll 4
        for (int ks = 0; ks < 32; ++ks) {
            const f32x4 xa = *(const f32x4*)(xr + 32 * ks), xb = *(const f32x4*)(xr + 32 * ks + 4);
            const int k0 = 32 * ks + 8 * kq;
            const f32x4 ga = *(const LAS f32x4*)(gsL + k0), gb = *(const LAS f32x4*)(gsL + k0 + 4), sa = *(const LAS f32x4*)(shL + k0), sb = *(const LAS f32x4*)(shL + k0 + 4);
            const float y[8] = {xa.x * ga.x, xa.y * ga.y, xa.z * ga.z, xa.w * ga.w, xb.x * gb.x, xb.y * gb.y, xb.z * gb.z, xb.w * gb.w};
            const float sh[8] = {sa.x, sa.y, sa.z, sa.w, sb.x, sb.y, sb.z, sb.w};
            float hv[8], yl[8]; v4u yhw;
#pragma unroll
            for (int j = 0; j < 8; ++j) hv[j] = y[j] * r + sh[j];
            *(v4u*)(hr + 32 * ks) = pack8(hv);
            yhw = pack8(y);
            { float yh[8]; unpack8(yhw, yh);
#pragma unroll
              for (int j = 0; j < 8; ++j) yl[j] = y[j] - yh[j]; }
            const bf16x8_t fyh = __builtin_bit_cast(bf16x8_t, yhw), fyl = __builtin_bit_cast(bf16x8_t, pack8(yl));
#pragma unroll
            for (int nt = 0; nt < 2; ++nt) {
                const bf16x8_t wh = *(const LAS bf16x8_t*)(lds + (16 * nt + fr) * WLS + k0 * 2), wl = *(const LAS bf16x8_t*)(lds + WLO + (16 * nt + fr) * WLS + k0 * 2);
                acc[nt] = __builtin_amdgcn_mfma_f32_16x16x32_bf16(wh, fyh, acc[nt], 0, 0, 0);
                acc[nt] = __builtin_amdgcn_mfma_f32_16x16x32_bf16(wh, fyl, acc[nt], 0, 0, 0);
                acc[nt] = __builtin_amdgcn_mfma_f32_16x16x32_bf16(wl, fyh, acc[nt], 0, 0, 0);
            }
        }
        float lv[8];
#pragma unroll
        for (int nt = 0; nt < 2; ++nt)
#pragma unroll
            for (int j = 0; j < 4; ++j) lv[4 * nt + j] = r * acc[nt][j] + cvec[16 * nt + 4 * kq + j];
        float tv[4]; int ti[4];
#pragma unroll
        for (int k = 0; k < 4; ++k) {
            float bv = lv[0]; int bi = 4 * kq;
#pragma unroll
            for (int j = 1; j < 8; ++j) { const int e = 16 * (j >> 2) + 4 * kq + (j & 3); if (lv[j] > bv) { bv = lv[j]; bi = e; } }
#pragma unroll
            for (int o = 16; o < 64; o <<= 1) { const float ov = __shfl_xor(bv, o); const int oi = __shfl_xor(bi, o); if (ov > bv || (ov == bv && oi < bi)) { bv = ov; bi = oi; } }
            tv[k] = bv; ti[k] = bi;
#pragma unroll
            for (int j = 0; j < 8; ++j) { const int e = 16 * (j >> 2) + 4 * kq + (j & 3); if (e == bi) lv[j] = -INFINITY; }
        }
        const float e1 = __expf(tv[1] - tv[0]), e2 = __expf(tv[2] - tv[0]), e3 = __expf(tv[3] - tv[0]);
        const float inv = 1.f / (1.f + e1 + e2 + e3);
        if (kq == 0) {
            *(int4*)(TOPI + (size_t)m * 4) = make_int4(ti[0], ti[1], ti[2], ti[3]);
            *(f32x4*)(TOPW + (size_t)m * 4) = (f32x4){inv, e1 * inv, e2 * inv, e3 * inv};
            atomicAdd((int*)&cnt[ti[0]], 1); atomicAdd((int*)&cnt[ti[1]], 1); atomicAdd((int*)&cnt[ti[2]], 1); atomicAdd((int*)&cnt[ti[3]], 1);
        }
        __syncthreads();
        if (tid < 32) BLKCNT[bid * 32 + tid] = cnt[tid];
    }
    xcd_barrier(bar);

    {
        unsigned char* ws = WSB(); const int* TOPI = (const int*)(ws + WS_TOPI); const float* TOPW = (const float*)(ws + WS_TOPW); const int* BLKCNT = (const int*)(ws + WS_BLKCNT);
        int* ROWTOK = (int*)(ws + WS_ROWTOK); float* ROWW = (float*)(ws + WS_ROWW); int* TILEE = (int*)(ws + WS_TILEE);
        LAS int* tot = (LAS int*)lds;
        LAS int* mine = tot + 32;
        LAS int* pst = mine + 32;
        LAS int* wcn = pst + 64;
        LAS int* rt = wcn + 256;
        LAS int* rm = rt + 512;
        const int tpb = NTOK / G;
        { const int part = tid >> 5, e = tid & 31; int t = 0, mn = 0;
          for (int k = part * (G / 16); k < (part + 1) * (G / 16); ++k) { const int c = BLKCNT[k * 32 + e]; t += c; if (k < bid) mn += c; }
          rt[part * 32 + e] = t; rm[part * 32 + e] = mn; }
        const int ent = TOPI[bid * tpb * 4 + tid];
        __syncthreads();
        if (tid < 32) { int t = 0, mn = 0;
#pragma unroll
            for (int p = 0; p < 16; ++p) { t += rt[p * 32 + tid]; mn += rm[p * 32 + tid]; }
            tot[tid] = t; mine[tid] = mn; }
        int rk = 0;
        for (int ex = 0; ex < 32; ++ex) { const unsigned long long mask = __ballot(ent == ex); if (ent == ex) rk = __popcll(mask & ((1ull << lane) - 1ull)); if (lane == ex) wcn[wave * 32 + ex] = __popcll(mask); }
        __syncthreads();
        if (tid == 0) { int a = 0; for (int e = 0; e < 32; ++e) { pst[e] = a; a += (tot[e] + 255) & ~255; } pst[32] = a; }
        __syncthreads();
        { int woff = 0;
          for (int w = 0; w < wave; ++w) woff += wcn[w * 32 + ent];
          const int pos = pst[ent] + mine[ent] + woff + rk;
          ROWTOK[pos] = (bid * tpb + (tid >> 2)) * 4 + (tid & 3);
          ROWW[pos] = TOPW[bid * tpb * 4 + tid]; }
        if (bid < 32) { const int e = bid; for (int pos = pst[e] + tot[e] + tid; pos < pst[e + 1]; pos += NTHR) { ROWTOK[pos] = -1; ROWW[pos] = 0.f; } }
        if (bid == 32 % G) {
            const int nt = pst[32] >> 8;
            for (int t = tid; t < nt; t += NTHR) { int e = 0; for (int k = 0; k < 32; ++k) if ((t << 8) >= pst[k]) e = k; TILEE[t] = e; }
            if (tid == 0) TILEE[1023] = nt;
        }
    }
    xcd_barrier(bar);

    { unsigned char* ws = WSB(); const float* bgu = INP(I_BGU);
      MoeOrder S; S.init(ws + WS_H, ws + WS_WGU, (const int*)(ws + WS_TILEE), (const int*)(ws + WS_ROWTOK), 8, (size_t)2048 * 1024 * 2, 1024, G, bid, true);
      auto E = pg8::make_epi(
        [=](const pg8::Unit& u, int c8) { const float* bg = bgu + (size_t)u.e * 2048 + u.pn * 128 + (c8 >> 6) * 32 + (c8 & 31); return pg8::ld16(bg, bg + 1024); },
        [=](const pg8::Unit&, int, int) { return pg8::NoData{}; },
        [=](const pg8::Unit& u, int r, int c8, const float (&v0)[8], const float (&v1)[8], const pg8::F16& bb, const pg8::NoData&) {
          const int col = u.pn * 128 + (c8 >> 6) * 32 + (c8 & 31); float f[8];
#pragma unroll
          for (int j = 0; j < 8; ++j) {
              const float gt = fminf(v0[j] + bb.v[j], 7.f);
              const float up = fminf(fmaxf(v1[j] + bb.v[8 + j], -7.f), 7.f);
              f[j] = (up + 1.f) * gt * sigm(1.702f * gt);
          }
          *(v4u*)((bf16*)(ws + WS_ACT) + (size_t)(u.pm * 256 + r) * 1024 + col) = pack8(f);
      });
      pg8::gemm_phase<decltype(E), MoeOrder, true>(lds, 1024, S, E);
    }
    xcd_barrier(bar);

    { unsigned char* ws = WSB(); const float* bdn = INP(I_BD);
      MoeOrder S; S.init(ws + WS_ACT, ws + WS_WD, (const int*)(ws + WS_TILEE), (const int*)(ws + WS_ROWTOK), 4, (size_t)1024 * 1024 * 2, 1024, G, bid, false);
      struct RW { int rt; float w; };
      auto E = pg8::make_epi(
        [=](const pg8::Unit& u, int c8) { const float* bd = bdn + (size_t)u.e * 1024 + u.pn * 256 + c8; return pg8::ld16(bd, bd + 32); },
        [=](const pg8::Unit& u, int r, int c8) { RW d; d.rt = ((const int*)(ws + WS_ROWTOK))[u.pm * 256 + r]; d.w = ((const float*)(ws + WS_ROWW))[u.pm * 256 + r]; return d; },
        [=](const pg8::Unit& u, int r, int c8, const float (&v0)[8], const float (&v1)[8], const pg8::F16& bd, const RW& d) {
          if (d.rt >= 0) {
              const int col = u.pn * 256 + c8; float f[8];
              bf16* yp = (bf16*)(ws + WS_YS) + (size_t)d.rt * 1024 + col;
#pragma unroll
              for (int j = 0; j < 8; ++j) f[j] = (v0[j] + bd.v[j]) * d.w;
              *(v4u*)yp = pack8(f);
#pragma unroll
              for (int j = 0; j < 8; ++j) f[j] = (v1[j] + bd.v[8 + j]) * d.w;
              *(v4u*)(yp + 32) = pack8(f);
          }
      });
      pg8::gemm_phase<decltype(E), MoeOrder, false>(lds, 1024, S, E);
    }
    xcd_barrier(bar);

    { unsigned char* ws = WSB(); const float* X1 = (const float*)(ws + WS_X1); const float* MOD = (const float*)(ws + WS_MOD); const bf16* YS = (const bf16*)(ws + WS_YS); const float* gfin = INP(I_GFIN); float* outp = (float*)ldptr(lds, 25);
      int lane_ = lane, row0_ = bid * (NTOK / G) + wave * (NTOK / G / NWAVES); asm volatile("" : "+v"(lane_)); asm volatile("" : "+s"(row0_));
      const int tpb = NTOK / G, b = (bid * tpb) >> 13, rpw = tpb / NWAVES;
      f32x4 gt[4], gf[4];
#pragma unroll
      for (int j = 0; j < 4; ++j) { gt[j] = *(const f32x4*)(MOD + b * 6144 + 5120 + 4 * lane_ + 256 * j); gf[j] = *(const f32x4*)(gfin + 4 * lane_ + 256 * j); }
      for (int r0 = 0; r0 < rpw; r0 += 2) {
          f32x4 v[2][4]; v2u y[2][4][4]; float ss[2];
#pragma unroll
          for (int rr = 0; rr < 2; ++rr) { const size_t m = (size_t)(row0_ + r0 + rr);
#pragma unroll
              for (int j = 0; j < 4; ++j) { v[rr][j] = ((const f32x4*)(X1 + m * DM) + lane_)[64 * j];
#pragma unroll
                  for (int sl = 0; sl < 4; ++sl) y[rr][j][sl] = *(const v2u*)(YS + (m * 4 + sl) * 1024 + 4 * lane_ + 256 * j); } }
#pragma unroll
          for (int rr = 0; rr < 2; ++rr) { float t = 0.f;
#pragma unroll
              for (int j = 0; j < 4; ++j) { f32x4 a = (f32x4){0.f, 0.f, 0.f, 0.f};
#pragma unroll
                  for (int sl = 0; sl < 4; ++sl) { const v2u w = y[rr][j][sl]; a.x += lo16(w.x); a.y += hi16(w.x); a.z += lo16(w.y); a.w += hi16(w.y); }
                  v[rr][j] = v[rr][j] + gt[j] * a;
                  t += (v[rr][j].x * v[rr][j].x + v[rr][j].y * v[rr][j].y) + (v[rr][j].z * v[rr][j].z + v[rr][j].w * v[rr][j].w); }
              ss[rr] = t; }
#pragma unroll
          for (int o = 1; o < 64; o <<= 1) { ss[0] += __shfl_xor(ss[0], o); ss[1] += __shfl_xor(ss[1], o); }
#pragma unroll
          for (int rr = 0; rr < 2; ++rr) { const float r = rsqrtf(ss[rr] * (1.f / DM) + RMS_EPS);
              f32x4* op = (f32x4*)(outp + (size_t)(row0_ + r0 + rr) * DM) + lane_;
#pragma unroll
              for (int j = 0; j < 4; ++j) op[64 * j] = v[rr][j] * r * gf[j]; }
      }
    }
}

extern "C" void kernel_launch(void* const* d_in, const int* in_sizes, int n_in, void* d_out, int out_size, void* d_ws, size_t ws_size, hipStream_t stream) {
    static int grid = 0;
    if (grid == 0) {
        if (n_in != 25 || in_sizes[0] != NTOK * DM || out_size != NTOK * DM || ws_size < WS_END) {
            fprintf(stderr, "kernel_launch: unexpected shapes (n_in %d, in0 %d, out %d, ws %zu); nothing launched\n", n_in, n_in > 0 ? in_sizes[0] : -1, out_size, ws_size); grid = -1; return; }
        int dev = 0, cus = 0, per_cu = 0;
        if (hipGetDevice(&dev) != hipSuccess || hipDeviceGetAttribute(&cus, hipDeviceAttributeMultiprocessorCount, dev) != hipSuccess) { grid = -1; return; }
        if (hipFuncSetAttribute((const void*)mega_fwd, hipFuncAttributeMaxDynamicSharedMemorySize, LDS_BYTES) != hipSuccess) { fprintf(stderr, "kernel_launch: hipFuncSetAttribute failed\n"); grid = -1; return; }
        if (hipOccupancyMaxActiveBlocksPerMultiprocessor(&per_cu, (const void*)mega_fwd, NTHR, LDS_BYTES) != hipSuccess || per_cu < 1) {
            fprintf(stderr, "kernel_launch: occupancy query reports %d blocks per CU\n", per_cu); (void)hipGetLastError(); grid = -1; return; }
        grid = cus;
        if (NTOK % grid != 0) { fprintf(stderr, "kernel_launch: grid %d does not divide the token count\n", grid); grid = -1; return; }
    }
    if (grid < 0) return;
    (void)hipMemsetAsync((char*)d_ws + WS_CTL, 0, CTL_ZERO_BYTES, stream);
    Params p{};
    for (int i = 0; i < 25; ++i) p.in[i] = (const float*)d_in[i];
    p.out = (float*)d_out; p.ws = (unsigned char*)d_ws;
    hipLaunchKernelGGL(mega_fwd, dim3(grid), dim3(NTHR), LDS_BYTES, stream, p);
}
```

```cpp
#include <hip/hip_runtime.h>
#include <cstdio>
#include <cstdint>

#define GAS __attribute__((address_space(1)))
#define LAS __attribute__((address_space(3)))
typedef unsigned short bf16;
typedef unsigned v4u __attribute__((ext_vector_type(4)));
typedef unsigned v2u __attribute__((ext_vector_type(2)));
typedef float f32x4 __attribute__((ext_vector_type(4)));

constexpr int BATCH = 4, SEQ = 8192, DM = 1024, NTOK = BATCH * SEQ, INW = 4096;
constexpr int NH = 8, HD = 64, AW = 512, SW = 512, NG = 32, NP = 64, NC = 16;
constexpr int NE = 32, TOPK = 4, DFF = 1024, MAXTILES = 544, MAXROWS = MAXTILES * 256;
constexpr int NWAVES = 8, NTHR = 512;
constexpr float RMS_EPS = 1e-5f;

constexpr size_t MiB = 1u << 20;
constexpr size_t WS_CTL = 0, CTL_ZERO_BYTES = 64 * 1024;
constexpr size_t WS_MOD = 1 * MiB;
constexpr size_t WS_ROT = 2 * MiB;
constexpr size_t WS_KMEAN = 3 * MiB;
constexpr size_t WS_TOPI = 4 * MiB;
constexpr size_t WS_TOPW = 5 * MiB;
constexpr size_t WS_BLKCNT = 6 * MiB;
constexpr size_t WS_ROWTOK = 7 * MiB;
constexpr size_t WS_ROWW = 8 * MiB;
constexpr size_t WS_TILEE = 9 * MiB;
constexpr size_t WS_WIN = 16 * MiB, WS_WGLU = 24 * MiB, WS_WAO = 26 * MiB, WS_WOUT = 27 * MiB, WS_WGU = 32 * MiB, WS_WD = 160 * MiB;
constexpr size_t WS_X1 = 224 * MiB;
constexpr size_t WS_U = 352 * MiB, WS_Q = 384 * MiB, WS_K = 416 * MiB, WS_V = 448 * MiB, WS_GA = 480 * MiB, WS_GB = 544 * MiB, WS_O = 608 * MiB, WS_Y = 640 * MiB;
constexpr size_t WS_ACT = 352 * MiB;
constexpr size_t WS_H = 672 * MiB;
constexpr size_t WS_MRG = 736 * MiB;
constexpr size_t WS_YS = 672 * MiB;
constexpr size_t WS_ACNT = 32768;
constexpr size_t WS_LSE = 10 * MiB;
constexpr size_t WS_QCTR = 40960;
constexpr size_t WS_PSQ = 13 * MiB;
constexpr size_t WS_WRS = 15 * MiB;
constexpr size_t WS_ALIST = 352 * MiB;
constexpr size_t WS_PART = 800 * MiB;
constexpr size_t WS_S5T = 928 * MiB;
constexpr size_t WS_S5W = 952 * MiB;
constexpr size_t WS_XE = 960 * MiB;
constexpr size_t WS_UG = 976 * MiB;
constexpr size_t WS_END = 1016 * MiB;

constexpr int LDS_BYTES = 147456;
constexpr int LDS_MISC = 147456 - 512;
constexpr int LDS_TILE = 131072;
constexpr int LDS_PAR = 147456 - 1024;

__device__ __forceinline__ float bf2f(bf16 v) { return __builtin_bit_cast(float, (unsigned)v << 16); }
__device__ __forceinline__ unsigned f2bf(float f) { unsigned u = __builtin_bit_cast(unsigned, f); return (u + 0x7fffu + ((u >> 16) & 1u)) >> 16; }
__device__ __forceinline__ unsigned pk2(float lo, float hi) { return f2bf(lo) | (f2bf(hi) << 16); }
__device__ __forceinline__ float lo16(unsigned w) { return __builtin_bit_cast(float, w << 16); }
__device__ __forceinline__ float hi16(unsigned w) { return __builtin_bit_cast(float, w & 0xffff0000u); }
__device__ __forceinline__ float sigm(float x) { return __builtin_amdgcn_rcpf(1.f + __builtin_amdgcn_exp2f(-1.4426950408889634f * x)); }
__device__ __forceinline__ int lane_now() { int l; asm volatile("v_mbcnt_lo_u32_b32 %0, -1, 0\n\tv_mbcnt_hi_u32_b32 %0, -1, %0" : "=v"(l)); return l; }
__device__ __forceinline__ float shx(float v, int mask, int lane) { return __builtin_bit_cast(float, __builtin_amdgcn_ds_bpermute((lane ^ mask) << 2, __builtin_bit_cast(int, v))); }
__device__ __forceinline__ int shx(int v, int mask, int lane) { return __builtin_amdgcn_ds_bpermute((lane ^ mask) << 2, v); }
__device__ __forceinline__ int shfrom(int v, int src) { return __builtin_amdgcn_ds_bpermute(src << 2, v); }
__device__ __forceinline__ float wave_sum(float v) {
#pragma unroll
    for (int o = 1; o < 64; o <<= 1) v += __shfl_xor(v, o);
    return v;
}
__device__ __forceinline__ void unpack8(v4u w, float (&f)[8]) {
    f[0] = lo16(w.x); f[1] = hi16(w.x); f[2] = lo16(w.y); f[3] = hi16(w.y); f[4] = lo16(w.z); f[5] = hi16(w.z); f[6] = lo16(w.w); f[7] = hi16(w.w);
}
typedef float f32x2_t __attribute__((ext_vector_type(2))); typedef __bf16 bf16x2_t __attribute__((ext_vector_type(2)));
__device__ __forceinline__ unsigned cvtpk(float lo, float hi) { f32x2_t v = {lo, hi}; bf16x2_t b = __builtin_convertvector(v, bf16x2_t); return __builtin_bit_cast(unsigned, b); }
__device__ __forceinline__ v4u pack8(const float (&f)[8]) { v4u w; w.x = cvtpk(f[0], f[1]); w.y = cvtpk(f[2], f[3]); w.z = cvtpk(f[4], f[5]); w.w = cvtpk(f[6], f[7]); return w; }

#define XB_TMO      128
#define XB_XCNT(j)  (256  + 64 * (j))
#define XB_XSUB(j)  (1280 + 64 * (j))
#define XB_XGEN(j)  (2304 + 64 * (j))
#define XB_TOP      3328
#define XB_TOPGEN   3392
#define XCD_BAR_WORDS 3456
#define XB_SPIN_CAP (1u << 25)
__device__ __forceinline__ unsigned xb_ld(unsigned* p)              { return __hip_atomic_load(p, __ATOMIC_RELAXED, __HIP_MEMORY_SCOPE_AGENT); }
__device__ __forceinline__ unsigned xb_add(unsigned* p, unsigned v) { return __hip_atomic_fetch_add(p, v, __ATOMIC_RELAXED, __HIP_MEMORY_SCOPE_AGENT); }
__device__ __forceinline__ unsigned xb_xcc_id() { return (unsigned)__builtin_amdgcn_s_getreg((3 << 11) | 20) & 0xFu; }
#define XB_SPIN(cond, bar) do { unsigned _sp = 0; while (cond) { __builtin_amdgcn_s_sleep(1); \
    if ((++_sp & 255u) == 0u) { if (xb_ld(&(bar)[XB_TMO])) break; if (_sp > XB_SPIN_CAP) { atomicAdd(&(bar)[XB_TMO], 1u); break; } } } } while (0)
struct XcdBarrier { unsigned* bar; unsigned x; volatile LAS unsigned* st; };
__device__ __forceinline__ XcdBarrier xcd_barrier_post(unsigned* bar, volatile LAS unsigned* st, bool t0) {
    XcdBarrier b; b.bar = bar; b.x = xb_xcc_id(); b.st = st;
    if (t0) (void)xb_add(&bar[XB_XCNT(b.x)], 1u);
    return b;
}
__device__ __forceinline__ void xcd_barrier_complete(unsigned* bar, unsigned x, unsigned& nloc, unsigned& nx) {
    const unsigned G = gridDim.x * gridDim.y * gridDim.z;
    unsigned sum, cnt, mine, sp = 0u;
    for (;;) {
        sum = 0u; cnt = 0u; mine = 0u;
#pragma unroll
        for (unsigned j = 0; j < 16; ++j) { const unsigned c = xb_ld(&bar[XB_XCNT(j)]); sum += c; cnt += (c > 0u) ? 1u : 0u; mine = (j == x) ? c : mine; }
        if (sum == G) break;
        __builtin_amdgcn_s_sleep(1);
        if ((++sp & 255u) == 0u) { if (xb_ld(&bar[XB_TMO])) break; if (sp > XB_SPIN_CAP) { atomicAdd(&bar[XB_TMO], 1u); break; } }
    }
    nloc = mine > 0u ? mine : 1u; nx = cnt > 0u ? cnt : 1u;
}
__device__ __forceinline__ void xcd_barrier(const XcdBarrier& b, int wave0) {
    asm volatile("s_waitcnt vmcnt(0)" ::: "memory");
    __syncthreads();
    if (wave0 == 0 && lane_now() == 0) {
        unsigned* bar = b.bar;
        __builtin_amdgcn_s_waitcnt(0);
        unsigned nloc = b.st[0], nx = b.st[1];
        if (nloc == 0u) { xcd_barrier_complete(bar, b.x, nloc, nx); b.st[0] = nloc; b.st[1] = nx; }
        const unsigned old = xb_add(&bar[XB_XSUB(b.x)], 1u);
        const unsigned gen = old / nloc;
        if (old + 1u == (gen + 1u) * nloc) {
            __builtin_amdgcn_fence(__ATOMIC_RELEASE, "agent");
            asm volatile("s_waitcnt vmcnt(0)" ::: "memory");
            const unsigned og = xb_add(&bar[XB_TOP], 1u);
            const unsigned tg = og / nx;
            if (og + 1u == (tg + 1u) * nx) xb_add(&bar[XB_TOPGEN], 1u);
            else XB_SPIN(xb_ld(&bar[XB_TOPGEN]) == tg, bar);
            __builtin_amdgcn_fence(__ATOMIC_ACQUIRE, "agent");
            xb_add(&bar[XB_XGEN(b.x)], 1u);
            asm volatile("s_waitcnt vmcnt(0)" ::: "memory");
        } else {
            XB_SPIN(xb_ld(&bar[XB_XGEN(b.x)]) == gen, bar);
            __builtin_amdgcn_fence(__ATOMIC_ACQUIRE, "agent");
            asm volatile("s_waitcnt vmcnt(0)" ::: "memory");
        }
    }
    __syncthreads();
}

struct Params { const float* in[25]; float* out; unsigned char* ws; int rep[16]; };
enum { I_X = 0, I_C, I_WADA, I_BADA, I_GMIX, I_WIN, I_ARE, I_AIM, I_LOGDT, I_BRE, I_BIM, I_CRE, I_CIM, I_SD, I_WGLU, I_WAO, I_WOUT, I_GFFN, I_WR, I_BR, I_WGU, I_BGU, I_WD, I_BD, I_GFIN };

__device__ __forceinline__ int ilv(int n) { const int g = n >= 1024, m = n - 1024 * g; return (m >> 7) * 256 + ((m & 127) >> 5) * 64 + 32 * g + (m & 31); }

__device__ __forceinline__ void transpose_item(const float* W, int K, int N, bf16* WT, bool interleave, LAS float* scr, int item, int lane) {
    const int nblk = N / 32, kb = item / nblk, nb = item % nblk, k0 = 64 * kb, n0 = 32 * nb;
#pragma unroll 8
    for (int i = 0; i < 32; ++i) { const int kk = 2 * i + (lane >> 5); scr[kk * 33 + (lane & 31)] = W[(size_t)(k0 + kk) * N + n0 + (lane & 31)]; }
    asm volatile("s_waitcnt lgkmcnt(0)" ::: "memory");
    const int c = lane & 7;
    const int r0 = interleave ? ilv(n0) : n0;
#pragma unroll
    for (int j = 0; j < 4; ++j) { const int n = (lane >> 3) + 8 * j; const LAS float* s = scr + (8 * c) * 33 + n;
        v4u o; o.x = pk2(s[0 * 33], s[1 * 33]); o.y = pk2(s[2 * 33], s[3 * 33]); o.z = pk2(s[4 * 33], s[5 * 33]); o.w = pk2(s[6 * 33], s[7 * 33]);
        *(v4u*)(WT + (size_t)(r0 + n) * K + k0 + 8 * c) = o; }
    asm volatile("s_waitcnt lgkmcnt(0)" ::: "memory");
}

namespace pg8 {
typedef short bf16x8 __attribute__((ext_vector_type(8)));
constexpr int BM = 256, BK = 64, HALF = 128, HTB = HALF * BK * 2, STAGE_BYTES = 8 * HTB, NXCD = 8, WGM = 8;
__host__ __device__ __forceinline__ int lds_byte(int r, int c) { const int st = (r >> 4) * 2 + (c >> 5), rr = r & 15, cc = c & 31, ob = rr * 64 + cc * 2; return st * 1024 + (ob ^ (((ob >> 9) & 1) << 5)); }
__host__ __device__ __forceinline__ void stage_rc(int b, int& R, int& C) { const int st = b / 1024, sb = b % 1024, swz = sb ^ (((sb >> 9) & 1) << 5); R = (st >> 1) * 16 + swz / 64; C = (st & 1) * 32 + (swz % 64) / 2; }
__host__ __device__ __forceinline__ int perm32(int rho) { const int n = rho >> 4, i = rho & 15; return 8 * (i >> 2) + 4 * n + (i & 3); }
struct Unit { int pm, pn, e, pad; const char* A; const char* B; };

struct DenseOrder {
    const char* A; const char* Bt; int nM, nN, nwg, G, c; size_t tstep;
    __device__ __forceinline__ void init(const void* A_, const void* Bt_, int M, int N, int K, int G_, int c_) { A = (const char*)A_; Bt = (const char*)Bt_; nM = M / BM; nN = N / BM; nwg = nM * nN; G = G_; c = c_; tstep = (size_t)BM * K * 2; }
    __device__ __forceinline__ bool next(int i, Unit& u) const {
        const long L = (long)i * G + c; if (L >= nwg) return false;
        int wgid = (int)L; { const int q = nwg / NXCD, r = nwg % NXCD, xcd = wgid % NXCD, off = wgid / NXCD; wgid = (xcd < r ? xcd * (q + 1) : r * (q + 1) + (xcd - r) * q) + off; }
        const int nig = WGM * nN, gid = wgid / nig, fm = gid * WGM, gsz = (nM - fm) < WGM ? (nM - fm) : WGM;
        u.pm = fm + ((wgid % nig) % gsz); u.pn = (wgid % nig) / gsz; u.e = 0; u.A = A + (size_t)u.pm * tstep; u.B = Bt + (size_t)u.pn * tstep; return true;
    }
    __device__ __forceinline__ unsigned rowoff(const Unit&, int) const { return 0u; }
};

template <class Epi, class Sched, bool GATHER>
__device__ __forceinline__ void gemm_phase(LAS unsigned char* lds, const int K, const Sched& S, const Epi& E, const int wave0, const int lda_ = 0) {
    const int tid = wave0 * 64 + lane_now();
    const int wid = __builtin_amdgcn_readfirstlane(tid >> 6), lane = tid & 63, wr = wid >> 2, wc = wid & 3, fr = lane & 15, fq = lane >> 4;
    const int nt = K / BK, lda = lda_ ? lda_ : K;
    int sR[2], sC[2];
    unsigned voffA[2][2], nvoffA[2][2], voffB[2][2];
#pragma unroll
    for (int i = 0; i < 2; ++i) { int R, C; stage_rc(tid * 16 + i * 8192, R, C); sR[i] = R; sC[i] = C; const int Rb = 64 * (R >> 5) + perm32(R & 31);
        voffA[0][i] = (unsigned)(R * lda + C) * 2u; voffA[1][i] = (unsigned)((R + HALF) * lda + C) * 2u; voffB[0][i] = (unsigned)(Rb * K + C) * 2u; voffB[1][i] = (unsigned)((Rb + 32) * K + C) * 2u;
        nvoffA[0][i] = voffA[0][i]; nvoffA[1][i] = voffA[1][i]; }
    const size_t kstep = (size_t)(BK * 2);
    const unsigned ldsw = (unsigned)wid * 1024u;
    const int aoff = lds_byte(wr * 64 + fr, fq * 8), boff = lds_byte(wc * 32 + fr, fq * 8);
#define PG8_SA(b, h) (((b) * 2 + (h)) * HTB)
#define PG8_SB(b, h) ((4 + (b) * 2 + (h)) * HTB)
#define PG8_STAGE(bufoff, gbase, v0, v1) do { \
        __builtin_amdgcn_global_load_lds((const unsigned*)((const char*)(gbase) + (v0)), (LAS unsigned*)(lds + (bufoff) + ldsw), 16, 0, 0); \
        __builtin_amdgcn_global_load_lds((const unsigned*)((const char*)(gbase) + (v1)), (LAS unsigned*)(lds + (bufoff) + ldsw + 8192), 16, 0, 0); } while (0)
#define PG8_LDA(dst, b, h) do { _Pragma("unroll") for (int m = 0; m < 4; ++m) _Pragma("unroll") for (int k = 0; k < 2; ++k) dst[m][k] = *(const LAS bf16x8*)(lds + PG8_SA(b, h) + aoff + m * 2048 + k * 1024); } while (0)
#define PG8_LDB(dst, b, h) do { _Pragma("unroll") for (int n = 0; n < 2; ++n) _Pragma("unroll") for (int k = 0; k < 2; ++k) dst[n][k] = *(const LAS bf16x8*)(lds + PG8_SB(b, h) + boff + n * 2048 + k * 1024); } while (0)
#define PG8_MMA(ai, bj, At, Bt) do { __builtin_amdgcn_s_setprio(1); _Pragma("unroll") for (int m = 0; m < 4; ++m) _Pragma("unroll") for (int n = 0; n < 2; ++n) _Pragma("unroll") for (int k = 0; k < 2; ++k) \
        acc[ai][bj][m][n] = __builtin_amdgcn_mfma_f32_16x16x32_bf16(Bt[n][k], At[m][k], acc[ai][bj][m][n], 0, 0, 0); __builtin_amdgcn_s_setprio(0); } while (0)
#define PG8_WAIT_V(n) asm volatile("s_waitcnt vmcnt(" #n ")" ::: "memory")
#define PG8_WAIT_L(n) asm volatile("s_waitcnt lgkmcnt(" #n ")" ::: "memory")
#define PG8_BAR __builtin_amdgcn_s_barrier()
#define PG8_SCHED __builtin_amdgcn_sched_barrier(0)
    Unit cur, nxt; int ui = 0;
    if (!S.next(0, cur)) return;
    if constexpr (GATHER) {
#pragma unroll
        for (int h = 0; h < 2; ++h)
#pragma unroll
            for (int i = 0; i < 2; ++i) voffA[h][i] = S.rowoff(cur, h * HALF + sR[i]) + (unsigned)sC[i] * 2u;
    }
    f32x4 acc[2][2][4][2];
#pragma unroll
    for (int a = 0; a < 2; ++a)
#pragma unroll
        for (int b = 0; b < 2; ++b)
#pragma unroll
            for (int m = 0; m < 4; ++m)
#pragma unroll
                for (int n = 0; n < 2; ++n) acc[a][b][m][n] = (f32x4){0.f, 0.f, 0.f, 0.f};
    bf16x8 At[4][2], B0[2][2], B1[2][2];
    const char* cA = cur.A; const char* cB = cur.B;
    PG8_STAGE(PG8_SB(0, 0), cB, voffB[0][0], voffB[0][1]); PG8_STAGE(PG8_SB(0, 1), cB, voffB[1][0], voffB[1][1]); PG8_STAGE(PG8_SA(0, 0), cA, voffA[0][0], voffA[0][1]); PG8_STAGE(PG8_SA(0, 1), cA, voffA[1][0], voffA[1][1]);
    if (wr == 1) PG8_BAR;
    PG8_WAIT_V(2); PG8_BAR;
    PG8_STAGE(PG8_SB(1, 0), cB + kstep, voffB[0][0], voffB[0][1]); PG8_STAGE(PG8_SA(1, 0), cA + kstep, voffA[0][0], voffA[0][1]); PG8_STAGE(PG8_SB(1, 1), cB + kstep, voffB[1][0], voffB[1][1]);
    PG8_WAIT_V(6); PG8_BAR;
    for (;;) {
        const bool has_next = S.next(ui + 1, nxt);
        const char* nA = has_next ? nxt.A : cA; const char* nB = has_next ? nxt.B : cB;
        if constexpr (GATHER) {
            if (has_next) {
#pragma unroll
                for (int h = 0; h < 2; ++h)
#pragma unroll
                    for (int i = 0; i < 2; ++i) nvoffA[h][i] = S.rowoff(nxt, h * HALF + sR[i]) + (unsigned)sC[i] * 2u;
            } else {
#pragma unroll
                for (int h = 0; h < 2; ++h)
#pragma unroll
                    for (int i = 0; i < 2; ++i) nvoffA[h][i] = voffA[h][i];
            }
        }
        for (int t = 0; t < nt; t += 2) {
            const bool last = (t == nt - 2);
            const char* a1 = cA + (size_t)(t + 1) * kstep;
            const char* a2 = last ? nA : cA + (size_t)(t + 2) * kstep; const char* b2 = last ? nB : cB + (size_t)(t + 2) * kstep;
            const char* a3 = a2 + kstep; const char* b3 = b2 + kstep;
            unsigned w00, w01, w10, w11;
            if constexpr (GATHER) { w00 = last ? nvoffA[0][0] : voffA[0][0]; w01 = last ? nvoffA[0][1] : voffA[0][1]; w10 = last ? nvoffA[1][0] : voffA[1][0]; w11 = last ? nvoffA[1][1] : voffA[1][1]; }
            else { w00 = voffA[0][0]; w01 = voffA[0][1]; w10 = voffA[1][0]; w11 = voffA[1][1]; }
            PG8_LDB(B0, 0, 0); PG8_LDB(B1, 0, 1); PG8_SCHED; PG8_LDA(At, 0, 0); PG8_STAGE(PG8_SA(1, 1), a1, voffA[1][0], voffA[1][1]);
            PG8_WAIT_V(8); PG8_WAIT_L(0); PG8_BAR; PG8_MMA(0, 0, At, B0); PG8_MMA(0, 1, At, B1); PG8_BAR; PG8_SCHED;
            PG8_LDA(At, 0, 1); PG8_STAGE(PG8_SB(0, 0), b2, voffB[0][0], voffB[0][1]); PG8_STAGE(PG8_SB(0, 1), b2, voffB[1][0], voffB[1][1]); PG8_STAGE(PG8_SA(0, 0), a2, w00, w01);
            PG8_WAIT_V(8); PG8_WAIT_L(0); PG8_BAR; PG8_MMA(1, 0, At, B0); PG8_MMA(1, 1, At, B1); PG8_BAR; PG8_SCHED;
            PG8_LDB(B0, 1, 0); PG8_LDB(B1, 1, 1); PG8_SCHED; PG8_LDA(At, 1, 0); PG8_STAGE(PG8_SA(0, 1), a2, w10, w11);
            PG8_WAIT_V(8); PG8_WAIT_L(0); PG8_BAR; PG8_MMA(0, 0, At, B0); PG8_MMA(0, 1, At, B1); PG8_BAR; PG8_SCHED;
            PG8_LDA(At, 1, 1); PG8_STAGE(PG8_SB(1, 0), b3, voffB[0][0], voffB[0][1]); PG8_STAGE(PG8_SB(1, 1), b3, voffB[1][0], voffB[1][1]); PG8_STAGE(PG8_SA(1, 0), a3, w00, w01);
            PG8_WAIT_V(8); PG8_WAIT_L(0); PG8_BAR; PG8_MMA(1, 0, At, B0); PG8_MMA(1, 1, At, B1); PG8_BAR; PG8_SCHED;
        }
        if (wr == 0) PG8_BAR;
        E(acc, cur, wr, wc, fr, fq);
        if (!has_next) break;
#pragma unroll
        for (int a = 0; a < 2; ++a)
#pragma unroll
            for (int b = 0; b < 2; ++b)
#pragma unroll
                for (int m = 0; m < 4; ++m)
#pragma unroll
                    for (int n = 0; n < 2; ++n) acc[a][b][m][n] = (f32x4){0.f, 0.f, 0.f, 0.f};
        cur = nxt; cA = nA; cB = nB; ++ui;
        if constexpr (GATHER) {
#pragma unroll
            for (int h = 0; h < 2; ++h)
#pragma unroll
                for (int i = 0; i < 2; ++i) voffA[h][i] = nvoffA[h][i];
        }
        if (wr == 1) PG8_BAR;
    }
    PG8_WAIT_V(0);
    PG8_BAR;
#undef PG8_SA
#undef PG8_SB
#undef PG8_STAGE
#undef PG8_LDA
#undef PG8_LDB
#undef PG8_MMA
#undef PG8_WAIT_V
#undef PG8_WAIT_L
#undef PG8_BAR
#undef PG8_SCHED
}

struct NoData {};
template <int NB, class CP, class RP, class F> struct EpiRows {
    CP cp; RP rp; F f;
    __device__ __forceinline__ void operator()(const f32x4 (&acc)[2][2][4][2], const Unit& u, int wr, int wc, int fr, int fq) const {
        const int c8 = wc * 64 + 8 * fq, rbase = wr * 64 + fr;
        const auto cd = cp(u, c8);
        constexpr int NBAT = 8 / NB;
        decltype(rp(u, 0, 0)) rd[2][NB];
#pragma unroll
        for (int m = 0; m < NB; ++m) rd[0][m] = rp(u, (m >> 2) * HALF + rbase + (m & 3) * 16, c8);
#pragma unroll
        for (int k = 0; k < NBAT; ++k) {
            if (k + 1 < NBAT) {
#pragma unroll
                for (int m = 0; m < NB; ++m) { const int q = (k + 1) * NB + m; rd[(k + 1) & 1][m] = rp(u, (q >> 2) * HALF + rbase + (q & 3) * 16, c8); }
            }
#pragma unroll
            for (int m = 0; m < NB; ++m) {
                const int q = k * NB + m, ai = q >> 2, mm = q & 3;
                float v0[8], v1[8];
#pragma unroll
                for (int j = 0; j < 4; ++j) { v0[j] = acc[ai][0][mm][0][j]; v0[4 + j] = acc[ai][0][mm][1][j]; v1[j] = acc[ai][1][mm][0][j]; v1[4 + j] = acc[ai][1][mm][1][j]; }
                f(u, ai * HALF + rbase + mm * 16, c8, v0, v1, cd, rd[k & 1][m]);
            }
        }
    }
};
template <int NB = 4, class CP, class RP, class F> __device__ __forceinline__ EpiRows<NB, CP, RP, F> make_epi(CP cp, RP rp, F f) { return EpiRows<NB, CP, RP, F>{cp, rp, f}; }
struct F16 { float v[16]; };
__device__ __forceinline__ F16 ld16(const float* p0, const float* p1) { F16 r; const f32x4 a = *(const f32x4*)p0, b = *(const f32x4*)(p0 + 4), c = *(const f32x4*)p1, d = *(const f32x4*)(p1 + 4);
    r.v[0] = a.x; r.v[1] = a.y; r.v[2] = a.z; r.v[3] = a.w; r.v[4] = b.x; r.v[5] = b.y; r.v[6] = b.z; r.v[7] = b.w; r.v[8] = c.x; r.v[9] = c.y; r.v[10] = c.z; r.v[11] = c.w; r.v[12] = d.x; r.v[13] = d.y; r.v[14] = d.z; r.v[15] = d.w; return r; }
}

struct MoeOrder {
    const char* A; const char* Bt; const LAS int* tile_e; const int* rowtok; int nt, npn, G, c, tpg, K; bool gather; size_t estride, tstep;
    __device__ __forceinline__ void init(const void* A_, const void* Bt_, const LAS int* tile_e_, const int* rowtok_, int npn_, size_t estride_, int K_, int G_, int c_, bool gather_) {
        A = (const char*)A_; Bt = (const char*)Bt_; tile_e = tile_e_; rowtok = rowtok_; npn = npn_; estride = estride_; K = K_; G = G_; c = c_; gather = gather_;
        nt = tile_e_[1023]; tpg = (G / 8) / npn; tstep = (size_t)256 * K_ * 2;
    }
    __device__ __forceinline__ bool next(int i, pg8::Unit& u) const {
        const int xc = c & 7, ci = c >> 3, group = i * 8 + xc, tile = group * tpg + ci / npn;
        if (tile >= nt) return false;
        u.pm = tile; u.pn = ci % npn; u.e = tile_e[tile];
        u.A = gather ? A : A + (size_t)tile * tstep; u.B = Bt + (size_t)u.e * estride + (size_t)u.pn * tstep; return true;
    }
    __device__ __forceinline__ unsigned rowoff(const pg8::Unit& u, int r) const { const int rt = rowtok[u.pm * 256 + r]; return (unsigned)(rt < 0 ? 0 : (rt >> 2)) * (unsigned)(K * 2); }
};


struct S5Order {
    const char* A; const char* Bt; int npn, c, G; size_t bstride, btile;
    __device__ __forceinline__ void init(const void* A_, const void* Bt_, int npn_, size_t bstride_, size_t btile_, int G_, int c_) { A = (const char*)A_; Bt = (const char*)Bt_; npn = npn_; bstride = bstride_; btile = btile_; G = G_; c = c_; }
    __device__ __forceinline__ bool next(int i, pg8::Unit& u) const {
        if (i > 0) return false;
        const int xc = c & 7, ci = c >> 3, per = 4 * npn;
        if (ci >= 4 * per) return false;
        const int g = 4 * xc + ci / per, rem = ci % per;
        u.e = g; u.pm = rem / npn; u.pn = rem % npn;
        u.A = A + ((size_t)g * 1024 + (size_t)u.pm * 256) * 640 * 2; u.B = Bt + (size_t)g * bstride + (size_t)u.pn * btile; return true;
    }
    __device__ __forceinline__ unsigned rowoff(const pg8::Unit&, int) const { return 0u; }
};

struct EpiInProj {
    unsigned char* ws;
    __device__ __forceinline__ void operator()(const f32x4 (&acc)[2][2][4][2], const pg8::Unit& u, int wr, int wc, int fr, int fq) const {
        unsigned char* ws = this->ws; asm volatile("" : "+s"(ws));
        const int pn = u.pn;
        size_t boff; int ld, cb;
        if (pn < 8) { boff = WS_U + (size_t)(pn >> 1) * (32 * MiB); ld = 512; cb = 256 * (pn & 1); }
        else { boff = WS_GA + (size_t)((pn - 8) >> 2) * (64 * MiB); ld = 1024; cb = 256 * ((pn - 8) & 3); }
        const int c8 = wc * 64 + 8 * fq;
        const bool rot = (pn >= 2 && pn < 6), isk = (pn == 4 || pn == 5);
        const bool t1 = (fq == 0), t2 = (fq == 1);
        float cs0[8], cs1[8];
#pragma unroll
        for (int j = 0; j < 8; ++j) { cs0[j] = 0.f; cs1[j] = 0.f; }
#pragma unroll
        for (int ai = 0; ai < 2; ++ai)
#pragma unroll
            for (int m = 0; m < 4; ++m) {
                const int r = ai * 128 + wr * 64 + m * 16 + fr, row = u.pm * 256 + r;
                float v0[8], v1[8];
#pragma unroll
                for (int j = 0; j < 4; ++j) { v0[j] = acc[ai][0][m][0][j]; v0[4 + j] = acc[ai][0][m][1][j]; v1[j] = acc[ai][1][m][0][j]; v1[4 + j] = acc[ai][1][m][1][j]; }
                if (rot) {
                    float o0[8];
#pragma unroll
                    for (int j = 0; j < 8; ++j) o0[j] = shx(v0[j], 16, fr + 16 * fq);
                    if (t1 || t2) {
                        const float kf[8] = {1.5915494309189535e-1f, 3.086376340470123e-2f, 5.985185712713705e-3f, 1.160663641240061e-3f, 2.2507907903927653e-4f, 4.364795279280289e-5f, 8.464330808241401e-6f, 1.6414262627950345e-6f};
                        const float pos = (float)(row & (SEQ - 1));
                        float cs[8], sn[8];
#pragma unroll
                        for (int j = 0; j < 8; ++j) { const float rev = __builtin_amdgcn_fractf(pos * kf[j]); cs[j] = __builtin_amdgcn_cosf(rev); sn[j] = __builtin_amdgcn_sinf(rev); }
#pragma unroll
                        for (int j = 0; j < 8; ++j) {
                            v0[j] = t1 ? (v0[j] * cs[j] - o0[j] * sn[j]) : (v0[j] * cs[j] + o0[j] * sn[j]);
                        }
                    }
                }
                if (isk) {
#pragma unroll
                    for (int j = 0; j < 8; ++j) { cs0[j] += v0[j]; cs1[j] += v1[j]; }
                }
                if (pn < 2) {
                    const int col = 256 * pn + c8, R = row >> 5, sl = row & 31;
                    bf16* ug = (bf16*)(ws + WS_UG);
                    *(v4u*)(ug + ((size_t)(col >> 4) * 1024 + R) * 640 + sl * 16 + (col & 15)) = pack8(v0);
                    *(v4u*)(ug + ((size_t)((col + 32) >> 4) * 1024 + R) * 640 + sl * 16 + (col & 15)) = pack8(v1);
                } else {
                    bf16* o = (bf16*)(ws + boff) + (size_t)row * ld + cb + c8;
                    *(v4u*)o = pack8(v0); *(v4u*)(o + 32) = pack8(v1);
                }
            }
        if (isk) {
#pragma unroll
            for (int j = 0; j < 8; ++j) {
#pragma unroll
                for (int o = 1; o < 16; o <<= 1) { cs0[j] += shx(cs0[j], o, fr + 16 * fq); cs1[j] += shx(cs1[j], o, fr + 16 * fq); }
            }
            if (fr == 0) {
                const int b = u.pm >> 5, jb = u.pm & 31, d = 8 * fq, h0 = 4 * (pn - 4) + wc;
                float* kp = (float*)(ws + WS_KMEAN) + (size_t)wr * (BATCH * NH * 32 * 64);
                float* p0 = kp + ((b * NH + h0) * 32 + jb) * 64 + d; float* p1 = p0 + 32;
                *(f32x4*)p0 = (f32x4){cs0[0], cs0[1], cs0[2], cs0[3]}; *(f32x4*)(p0 + 4) = (f32x4){cs0[4], cs0[5], cs0[6], cs0[7]};
                *(f32x4*)p1 = (f32x4){cs1[0], cs1[1], cs1[2], cs1[3]}; *(f32x4*)(p1 + 4) = (f32x4){cs1[4], cs1[5], cs1[6], cs1[7]};
            }
        }
    }
};

typedef short bf16x8_t __attribute__((ext_vector_type(8)));
typedef short v4i16_t __attribute__((ext_vector_type(4)));
constexpr int AT_STRIDE = 160, AT_K = 0, AT_V = 256 * AT_STRIDE, AT_PRE = 2 * 256 * AT_STRIDE, AT_CN = AT_PRE + 4096, AT_WT = AT_CN + 4096;

struct KVRegs { v4u k[4], v[4]; };
__device__ __forceinline__ void attn_k_issue(KVRegs& r, const bf16* Kb, size_t row0, int h, int tid) {
    const bf16* p = Kb + (row0 + (tid >> 3)) * 512 + h * 64 + (tid & 7) * 8;
#pragma unroll
    for (int i = 0; i < 4; ++i) r.k[i] = *(const v4u*)(p + (size_t)i * 64 * 512);
}
__device__ __forceinline__ void attn_v_issue(KVRegs& r, const bf16* Vb, size_t row0, int h, int tid) {
    const bf16* p = Vb + (row0 + (tid >> 3)) * 512 + h * 64 + (tid & 7) * 8;
#pragma unroll
    for (int i = 0; i < 4; ++i) r.v[i] = *(const v4u*)(p + (size_t)i * 64 * 512);
}
__device__ __forceinline__ void attn_kv_issue(KVRegs& r, const bf16* Kb, const bf16* Vb, size_t row0, int h, int tid) { attn_k_issue(r, Kb, row0, h, tid); attn_v_issue(r, Vb, row0, h, tid); }
__device__ __forceinline__ void attn_kv_commit(LAS unsigned char* lds, const KVRegs& r, int tid) {
#pragma unroll
    for (int i = 0; i < 4; ++i) { const int ch = tid + 512 * i, row = ch >> 3, cc = ch & 7;
        *(LAS v4u*)(lds + AT_K + row * AT_STRIDE + cc * 16) = r.k[i]; *(LAS v4u*)(lds + AT_V + row * AT_STRIDE + cc * 16) = r.v[i]; }
}
template <bool CAUSAL>
__device__ __forceinline__ void attn_scores(LAS unsigned char* lds, const bf16x8_t (&qf)[2], int qloc, int lane, f32x4 (&acc)[16], float& mrow, float& lrow) {
    const int fr = lane & 15, fq = lane >> 4;
#pragma unroll
    for (int kb = 0; kb < 16; ++kb) {
        const LAS unsigned char* kp = lds + AT_K + (16 * kb + fr) * AT_STRIDE + fq * 16;
        const bf16x8_t a0 = *(const LAS bf16x8_t*)kp, a1 = *(const LAS bf16x8_t*)(kp + 64);
        f32x4 z = (f32x4){0.f, 0.f, 0.f, 0.f};
        z = __builtin_amdgcn_mfma_f32_16x16x32_bf16(a0, qf[0], z, 0, 0, 0);
        acc[kb] = __builtin_amdgcn_mfma_f32_16x16x32_bf16(a1, qf[1], z, 0, 0, 0);
    }
    if (CAUSAL) {
#pragma unroll
        for (int kb = 0; kb < 16; ++kb)
#pragma unroll
            for (int r = 0; r < 4; ++r) if (16 * kb + 4 * fq + r > qloc) acc[kb][r] = -1e30f;
    }
    float m = acc[0][0];
#pragma unroll
    for (int kb = 0; kb < 16; ++kb)
#pragma unroll
        for (int r = 0; r < 4; ++r) m = fmaxf(m, acc[kb][r]);
    m = fmaxf(m, shx(m, 16, lane)); m = fmaxf(m, shx(m, 32, lane));
    const float c = 0.125f * 1.4426950408889634f;
    float ls = 0.f;
#pragma unroll
    for (int kb = 0; kb < 16; ++kb)
#pragma unroll
        for (int r = 0; r < 4; ++r) { const float p = __builtin_amdgcn_exp2f((acc[kb][r] - m) * c); ls += p; acc[kb][r] = p; }
    ls += shx(ls, 16, lane); ls += shx(ls, 32, lane);
    mrow = m; lrow = ls;
}
__device__ __forceinline__ void attn_pv(LAS unsigned char* lds, const f32x4 (&acc)[16], int lane, f32x4 (&o)[4]) {
    const int fr = lane & 15, fq = lane >> 4;
#pragma unroll
    for (int db = 0; db < 4; ++db) o[db] = (f32x4){0.f, 0.f, 0.f, 0.f};
    const LAS unsigned char* vbase = lds + AT_V + (4 * fq + (fr >> 2)) * AT_STRIDE + (fr & 3) * 8;
#pragma unroll
    for (int ks = 0; ks < 8; ++ks) {
        v4u pw; pw.x = cvtpk(acc[2 * ks][0], acc[2 * ks][1]); pw.y = cvtpk(acc[2 * ks][2], acc[2 * ks][3]); pw.z = cvtpk(acc[2 * ks + 1][0], acc[2 * ks + 1][1]); pw.w = cvtpk(acc[2 * ks + 1][2], acc[2 * ks + 1][3]);
        const bf16x8_t pf = __builtin_bit_cast(bf16x8_t, pw);
#pragma unroll
        for (int db = 0; db < 4; ++db) {
            const v4i16_t lo = __builtin_amdgcn_ds_read_tr16_b64_v4i16((LAS v4i16_t*)(vbase + (32 * ks) * AT_STRIDE + db * 32));
            const v4i16_t hi = __builtin_amdgcn_ds_read_tr16_b64_v4i16((LAS v4i16_t*)(vbase + (32 * ks + 16) * AT_STRIDE + db * 32));
            const bf16x8_t vt = (bf16x8_t){lo[0], lo[1], lo[2], lo[3], hi[0], hi[1], hi[2], hi[3]};
            o[db] = __builtin_amdgcn_mfma_f32_16x16x32_bf16(vt, pf, o[db], 0, 0, 0);
        }
    }
}

__device__ __forceinline__ const void* ldptr(LAS unsigned char* lds, int i) {
    const unsigned long long v = ((volatile LAS unsigned long long*)(lds + LDS_PAR))[i];
    const unsigned lo = __builtin_amdgcn_readfirstlane((unsigned)v), hi = __builtin_amdgcn_readfirstlane((unsigned)(v >> 32));
    return (const void*)(const GAS void*)(((unsigned long long)hi << 32) | lo);
}
#define INP(i) ((const float*)ldptr(lds, (i)))
#define NREP(k) __builtin_amdgcn_readfirstlane(((volatile LAS int*)(lds + LDS_PAR + 256))[(k)])
#ifndef TS_A
#define TS_A 0
#define TS_B 0
#endif
#ifndef TIMING
#define TIMING 0
#endif
#if TIMING
#define STAMP(k) do { if (wave0 == 0 && lane_now() == 0) { const unsigned long long t_ = __builtin_amdgcn_s_memrealtime(); unsigned long long* ts_ = (unsigned long long*)((unsigned char*)bar.bar - 4096 + 49152); \
    __hip_atomic_fetch_max(ts_ + (k), t_, __ATOMIC_RELAXED, __HIP_MEMORY_SCOPE_AGENT); __hip_atomic_fetch_max(ts_ + 64 + (k), ~t_, __ATOMIC_RELAXED, __HIP_MEMORY_SCOPE_AGENT); } } while (0)
#else
#define STAMP(k) do {} while (0)
#endif
#ifndef PROBE_LOOPS
#define PROBE_LOOPS 0
#endif
#if PROBE_LOOPS
#define PHASE_BEGIN(k) for (int rep_ = 0, nrep_ = NREP(k); rep_ < nrep_; ++rep_) {
#else
#define PHASE_BEGIN(k) {
#endif
#define WSB() ((unsigned char*)ldptr(lds, 26))
__global__ void __launch_bounds__(NTHR, 2) mega_fwd(Params P) {
    extern __shared__ __attribute__((aligned(16))) unsigned char lds_raw[];
    LAS unsigned char* lds = (LAS unsigned char*)lds_raw;
    volatile LAS unsigned* MISC = (volatile LAS unsigned*)(lds + LDS_MISC);
    const int wave0 = __builtin_amdgcn_readfirstlane((int)threadIdx.x >> 6);
    const int tid = wave0 * 64 + lane_now(), lane = tid & 63, wave = wave0;
    const int G = gridDim.x, bid = blockIdx.x;
    const int gw = bid * NWAVES + wave, NGW = G * NWAVES;
    if (tid < 128) MISC[tid] = 0u;
    if (tid < 25) ((LAS unsigned long long*)(lds + LDS_PAR))[tid] = (unsigned long long)P.in[tid];
    if (tid == 25) ((LAS unsigned long long*)(lds + LDS_PAR))[25] = (unsigned long long)P.out;
    if (tid == 26) ((LAS unsigned long long*)(lds + LDS_PAR))[26] = (unsigned long long)P.ws;
    if (tid >= 32 && tid < 48) ((LAS int*)(lds + LDS_PAR + 256))[tid - 32] = P.rep[tid - 32];
    __syncthreads();
    XcdBarrier bar = xcd_barrier_post((unsigned*)(P.ws + WS_CTL) + 1024, MISC + 8, tid == 0);

    PHASE_BEGIN(0)
      int tid_o = wave0 * 64 + lane_now(), bid_o = blockIdx.x; asm volatile("" : "+s"(bid_o));
      const int tid = tid_o, lane = tid & 63, wave = wave0, bid = bid_o, gw = bid * NWAVES + wave; (void)tid; (void)lane; (void)wave; (void)gw;
      STAMP(0);
    {
        unsigned char* ws = WSB(); float* MOD = (float*)(ws + WS_MOD); float* ROT = (float*)(ws + WS_ROT);
        if (bid >= 64) {
            LAS float* cond = (LAS float*)lds;
            LAS float* red = cond + 4096;
            const float* c = INP(I_C);
            for (int i = tid; i < 4096; i += NTHR) { const float v = c[i]; cond[i] = v * sigm(v); }
            __syncthreads();
            const int hw = wave * 2 + (lane >> 5), col = (bid - 64) * 32 + (lane & 31);
            const float* w = INP(I_WADA) + (size_t)(hw * 64) * 6144 + col;
            float a0 = 0.f, a1 = 0.f, a2 = 0.f, a3 = 0.f;
#pragma unroll 16
            for (int k = 0; k < 64; ++k) { const float wv = w[(size_t)k * 6144]; const int kk = hw * 64 + k;
                a0 += cond[kk] * wv; a1 += cond[1024 + kk] * wv; a2 += cond[2048 + kk] * wv; a3 += cond[3072 + kk] * wv; }
            red[(hw * 4 + 0) * 32 + (lane & 31)] = a0; red[(hw * 4 + 1) * 32 + (lane & 31)] = a1; red[(hw * 4 + 2) * 32 + (lane & 31)] = a2; red[(hw * 4 + 3) * 32 + (lane & 31)] = a3;
            __syncthreads();
            if (tid < 128) { const int b = tid >> 5, cc = tid & 31; float a = 0.f;
#pragma unroll
                for (int h = 0; h < 16; ++h) a += red[(h * 4 + b) * 32 + cc];
                const int j = (bid - 64) * 32 + cc; MOD[b * 6144 + j] = a + INP(I_BADA)[j]; }
            __syncthreads();
        }
        if (bid >= 32 && bid < 64) {
            for (int i = (bid - 32) * NTHR + tid; i < SEQ * 8; i += 32 * NTHR) {
                const int s = i >> 3, d = i & 7;
                const float inv = 1.0f / powf(500000.0f, (float)(2 * d) / 16.0f);
                const float ang = (float)s * inv;
                float sn, cs; sincosf(ang, &sn, &cs);
                ROT[2 * i] = cs; ROT[2 * i + 1] = sn;
            }
            const float* wr = INP(I_WR); bf16* wrs = (bf16*)(ws + WS_WRS);
            for (int i = (bid - 32) * NTHR + tid; i < 32 * 1024; i += 32 * NTHR) { const int e = i >> 10, k = i & 1023; const float v = wr[k * 32 + e];
                const unsigned hb = f2bf(v); const float hv = bf2f((bf16)hb); wrs[i] = (bf16)hb; wrs[32768 + i] = (bf16)f2bf(v - hv); }
        }
        if (bid < NG) {
            const int g = bid;
            LAS float* APr = (LAS float*)lds;
            LAS float* APi = APr + 33 * 64;
            LAS float* BBr = APi + 33 * 64;
            LAS float* BBi = BBr + 1024;
            LAS float* CCr = BBi + 1024;
            LAS float* CCi = CCr + 1024;
            LAS float* KRN = CCi + 1024;
            const float dt = expf(INP(I_LOGDT)[g]);
            const float* are = INP(I_ARE) + g * 64; const float* aim = INP(I_AIM) + g * 64;
            for (int i = tid; i < 33 * 64; i += NTHR) { const int lag = i >> 6, p = i & 63; const float lr = are[p], li = aim[p];
                const float mg = expf(lr * dt * (float)lag); float sn, cs; sincosf(li * dt * (float)lag, &sn, &cs); APr[i] = mg * cs; APi[i] = mg * sn; }
            { const float* pbre = INP(I_BRE) + g * 1024; const float* pbim = INP(I_BIM) + g * 1024; const float* pcre = INP(I_CRE) + g * 1024; const float* pcim = INP(I_CIM) + g * 1024;
              for (int i = tid; i < 1024; i += NTHR) { const int p = i >> 4; const float lr = are[p], li = aim[p];
                const float mg = expf(lr * dt); float sn, cs; sincosf(li * dt, &sn, &cs); const float ar = mg * cs, ai = mg * sn, den = lr * lr + li * li;
                const float cfr = ((ar - 1.f) * lr + ai * li) / den, cfi = (ai * lr - (ar - 1.f) * li) / den;
                const float br = pbre[i], bi = pbim[i]; BBr[i] = cfr * br - cfi * bi; BBi[i] = cfr * bi + cfi * br;
                CCr[i] = pcre[i]; CCi[i] = pcim[i]; } }
            __syncthreads();
            for (int i = tid; i < 32 * 256; i += NTHR) { const int lag = i >> 8, co = (i >> 4) & 15, ci = i & 15; float a = 0.f;
                for (int p = 0; p < 64; ++p) { const float cr = CCr[co * 64 + p], cim = CCi[co * 64 + p], pr = APr[lag * 64 + p], pi = APi[lag * 64 + p];
                    const float car = cr * pr - cim * pi, cai = cr * pi + cim * pr; a += car * BBr[p * 16 + ci] - cai * BBi[p * 16 + ci]; }
                KRN[i] = a; }
            __syncthreads();
            bf16* T = (bf16*)(ws + WS_S5T) + (size_t)g * 512 * 640;
            for (int ch = tid; ch < 512 * 80; ch += NTHR) { const int row = ch / 80, col = (ch % 80) * 8, t = row >> 4, co = row & 15; float f[8];
                if (col < 512) { const int sx = col >> 4, ci0 = col & 15;
#pragma unroll
                    for (int j = 0; j < 8; ++j) f[j] = (sx <= t) ? KRN[((t - sx) * 16 + co) * 16 + ci0 + j] : 0.f; }
                else { const int cx = col - 512, ri = cx >> 6, p0 = cx & 63;
#pragma unroll
                    for (int j = 0; j < 8; ++j) { const int p = p0 + j; const float cr = CCr[co * 64 + p], cim = CCi[co * 64 + p], pr = APr[(t + 1) * 64 + p], pi = APi[(t + 1) * 64 + p];
                        f[j] = ri ? -(cr * pi + cim * pr) : (cr * pr - cim * pi); } }
                *(v4u*)(T + (size_t)row * 640 + col) = pack8(f); }
            bf16* W1 = (bf16*)(ws + WS_S5W) + (size_t)g * 256 * 512;
            for (int ch = tid; ch < 256 * 64; ch += NTHR) { const int row = ch >> 6, col = (ch & 63) * 8; float f[8];
                if (row < 128) { const int ri = row >> 6, p = row & 63, sx = col >> 4, ci0 = col & 15; const float pr = APr[(31 - sx) * 64 + p], pi = APi[(31 - sx) * 64 + p];
#pragma unroll
                    for (int j = 0; j < 8; ++j) { const float br = BBr[p * 16 + ci0 + j], bi = BBi[p * 16 + ci0 + j]; f[j] = ri ? (pr * bi + pi * br) : (pr * br - pi * bi); } }
                else {
#pragma unroll
                    for (int j = 0; j < 8; ++j) f[j] = 0.f; }
                *(v4u*)(W1 + (size_t)row * 512 + col) = pack8(f); }
            __syncthreads();
        }
        LAS float* scr = (LAS float*)(lds + wave * 16384);
        constexpr int I_IN = 16 * 128, I_GL = 8 * 64, I_AO = 8 * 32, I_OU = 16 * 32, I_GU1 = 16 * 64, I_D1 = 16 * 32;
        constexpr int NIT = I_IN + I_GL + I_AO + I_OU + NE * I_GU1 + NE * I_D1;
        int* qctr = (int*)(ws + WS_QCTR);
        for (;;) {
          int qb = 0; if (lane == 0) qb = atomicAdd(qctr, 4); qb = __builtin_amdgcn_readfirstlane(qb);
          if (qb >= NIT) break;
          for (int it = qb; it < qb + 4 && it < NIT; ++it) {
            int r = it;
            if (r < I_IN) { transpose_item(INP(I_WIN), 1024, 4096, (bf16*)(ws + WS_WIN), false, scr, r, lane); continue; } r -= I_IN;
            if (r < I_GL) { transpose_item(INP(I_WGLU), 512, 2048, (bf16*)(ws + WS_WGLU), true, scr, r, lane); continue; } r -= I_GL;
            if (r < I_AO) { transpose_item(INP(I_WAO), 512, 1024, (bf16*)(ws + WS_WAO), false, scr, r, lane); continue; } r -= I_AO;
            if (r < I_OU) { transpose_item(INP(I_WOUT), 1024, 1024, (bf16*)(ws + WS_WOUT), false, scr, r, lane); continue; } r -= I_OU;
            if (r < NE * I_GU1) { const int e = r / I_GU1; transpose_item(INP(I_WGU) + (size_t)e * 1024 * 2048, 1024, 2048, (bf16*)(ws + WS_WGU) + (size_t)e * 2048 * 1024, true, scr, r % I_GU1, lane); continue; } r -= NE * I_GU1;
            { const int e = r / I_D1; transpose_item(INP(I_WD) + (size_t)e * 1024 * 1024, 1024, 1024, (bf16*)(ws + WS_WD) + (size_t)e * 1024 * 1024, false, scr, r % I_D1, lane); }
          }
        }
    }
    STAMP(1);
    xcd_barrier(bar, wave0);
    }

    PHASE_BEGIN(1)
      int tid_o = wave0 * 64 + lane_now(), bid_o = blockIdx.x; asm volatile("" : "+s"(bid_o));
      const int tid = tid_o, lane = tid & 63, wave = wave0, bid = bid_o, gw = bid * NWAVES + wave; (void)tid; (void)lane; (void)wave; (void)gw;
      STAMP(2);
    { unsigned char* ws = WSB(); const float* x = INP(I_X); const float* gmix = INP(I_GMIX); const float* MOD = (const float*)(ws + WS_MOD); bf16* Hb = (bf16*)(ws + WS_H);
      const int tpb = NTOK / G, b = (bid * tpb) >> 13;
      LAS float* gsL = (LAS float*)lds; LAS float* shL = gsL + 1024;
      for (int i = tid; i < 1024; i += NTHR) { gsL[i] = gmix[i] * (1.f + MOD[b * 6144 + 1024 + i]); shL[i] = MOD[b * 6144 + i]; }
      __syncthreads();
      f32x4 gv[4], sv[4];
#pragma unroll
      for (int j = 0; j < 4; ++j) { gv[j] = *(const LAS f32x4*)(gsL + 4 * lane + 256 * j); sv[j] = *(const LAS f32x4*)(shL + 4 * lane + 256 * j); }
      const int rpw = tpb / NWAVES;
      for (int r0 = 0; r0 < rpw; r0 += 4) {
          f32x4 v[4][4]; float ss[4];
#pragma unroll
          for (int rr = 0; rr < 4; ++rr) { const f32x4* xr = (const f32x4*)(x + (size_t)(bid * tpb + wave * rpw + r0 + rr) * DM) + lane;
#pragma unroll
              for (int j = 0; j < 4; ++j) v[rr][j] = xr[64 * j]; }
#pragma unroll
          for (int rr = 0; rr < 4; ++rr) { float t = 0.f;
#pragma unroll
              for (int j = 0; j < 4; ++j) t += (v[rr][j].x * v[rr][j].x + v[rr][j].y * v[rr][j].y) + (v[rr][j].z * v[rr][j].z + v[rr][j].w * v[rr][j].w);
              ss[rr] = t; }
#pragma unroll
          for (int o = 1; o < 64; o <<= 1) {
#pragma unroll
              for (int rr = 0; rr < 4; ++rr) ss[rr] += shx(ss[rr], o, lane); }
#pragma unroll
          for (int rr = 0; rr < 4; ++rr) { const float r = rsqrtf(ss[rr] * (1.f / DM) + RMS_EPS);
              v2u* o8 = (v2u*)(Hb + (size_t)(bid * tpb + wave * rpw + r0 + rr) * DM) + lane;
#pragma unroll
              for (int j = 0; j < 4; ++j) { const f32x4 t = v[rr][j] * r * gv[j] + sv[j]; v2u w; w.x = cvtpk(t.x, t.y); w.y = cvtpk(t.z, t.w); o8[64 * j] = w; } }
      }
    }
    STAMP(3);
    xcd_barrier(bar, wave0);
    }

    PHASE_BEGIN(2)
      int tid_o = wave0 * 64 + lane_now(), bid_o = blockIdx.x; asm volatile("" : "+s"(bid_o));
      const int tid = tid_o, lane = tid & 63, wave = wave0, bid = bid_o, gw = bid * NWAVES + wave; (void)tid; (void)lane; (void)wave; (void)gw;
      STAMP(4);
    { unsigned char* ws = WSB();
      pg8::DenseOrder S; S.init(ws + WS_H, ws + WS_WIN, NTOK, INW, 1024, G, bid);
      EpiInProj E{ws};
      pg8::gemm_phase<EpiInProj, pg8::DenseOrder, false>(lds, 1024, S, E, wave0);
    }
    STAMP(5);
    xcd_barrier(bar, wave0);
    }

    {
      int tid_o = wave0 * 64 + lane_now(), bid_o = blockIdx.x; asm volatile("" : "+s"(bid_o));
      const int tid = tid_o, lane = tid & 63, wave = wave0, bid = bid_o, gw = bid * NWAVES + wave; (void)tid; (void)lane; (void)wave; (void)gw;
      STAMP(6);
    { unsigned char* ws = WSB();
      S5Order S; S.init(ws + WS_UG, ws + WS_S5W, 1, (size_t)256 * 512 * 2, 0, G, bid);
      auto E = pg8::make_epi([=](const pg8::Unit&, int) { return pg8::NoData{}; }, [=](const pg8::Unit&, int, int) { return pg8::NoData{}; },
        [=](const pg8::Unit& u, int r, int c8, const float (&v0)[8], const float (&v1)[8], const pg8::NoData&, const pg8::NoData&) {
          if (c8 < 128) {
              float* xe = (float*)(ws + WS_XE) + ((size_t)u.e * 1024 + u.pm * 256 + r) * 128 + c8;
              *(f32x4*)xe = (f32x4){v0[0], v0[1], v0[2], v0[3]}; *(f32x4*)(xe + 4) = (f32x4){v0[4], v0[5], v0[6], v0[7]};
              *(f32x4*)(xe + 32) = (f32x4){v1[0], v1[1], v1[2], v1[3]}; *(f32x4*)(xe + 36) = (f32x4){v1[4], v1[5], v1[6], v1[7]};
          }
      });
      pg8::gemm_phase<decltype(E), S5Order, false>(lds, 512, S, E, wave0, 640);
    }
    STAMP(30);
    { unsigned char* ws = WSB();
      const bf16* Qb_ = (const bf16*)(ws + WS_Q); const float* km0 = (const float*)(ws + WS_KMEAN);
      int* acnt = (int*)(ws + WS_ACNT); unsigned short* alist = (unsigned short*)(ws + WS_ALIST);
      for (int it = gw; it < BATCH * NH * 128; it += NGW) {
        const int b = it >> 10, h = (it >> 7) & 7, chk = it & 127, s_ = chk * 64 + lane, nb = chk >> 2;
        if (nb == 0) continue;
        const int fr = lane & 15, kq = lane >> 4;
        bf16x8_t kh[2][2], kl[2][2];
#pragma unroll
        for (int nt = 0; nt < 2; ++nt)
#pragma unroll
            for (int ks = 0; ks < 2; ++ks) {
                const float* kp = km0 + ((b * NH + h) * 32 + 16 * nt + fr) * 64 + 32 * ks + 8 * kq;
                const pg8::F16 pa = pg8::ld16(kp, kp + BATCH * NH * 32 * 64);
                float f[8], fl[8], fh[8];
#pragma unroll
                for (int j = 0; j < 8; ++j) f[j] = pa.v[j] + pa.v[8 + j];
                const v4u hw = pack8(f); unpack8(hw, fh);
#pragma unroll
                for (int j = 0; j < 8; ++j) fl[j] = f[j] - fh[j];
                kh[nt][ks] = __builtin_bit_cast(bf16x8_t, hw); kl[nt][ks] = __builtin_bit_cast(bf16x8_t, pack8(fl));
            }
        int s0 = 0, s1 = 0, s2 = 0;
#pragma unroll
        for (int t = 0; t < 4; ++t) {
            const bf16* qp = Qb_ + ((size_t)b * SEQ + chk * 64 + 16 * t + fr) * 512 + h * 64 + 8 * kq;
            const bf16x8_t q0 = *(const bf16x8_t*)qp, q1 = *(const bf16x8_t*)(qp + 32);
            float gv[8];
#pragma unroll
            for (int nt = 0; nt < 2; ++nt) {
                f32x4 a = (f32x4){0.f, 0.f, 0.f, 0.f};
                a = __builtin_amdgcn_mfma_f32_16x16x32_bf16(kh[nt][0], q0, a, 0, 0, 0); a = __builtin_amdgcn_mfma_f32_16x16x32_bf16(kh[nt][1], q1, a, 0, 0, 0);
                a = __builtin_amdgcn_mfma_f32_16x16x32_bf16(kl[nt][0], q0, a, 0, 0, 0); a = __builtin_amdgcn_mfma_f32_16x16x32_bf16(kl[nt][1], q1, a, 0, 0, 0);
#pragma unroll
                for (int r = 0; r < 4; ++r) gv[4 * nt + r] = (16 * nt + 4 * kq + r < nb) ? a[r] : -INFINITY;
            }
            int pick[3];
#pragma unroll
            for (int k = 0; k < 3; ++k) {
                float bv = gv[0]; int bi = 4 * kq;
#pragma unroll
                for (int j = 1; j < 8; ++j) { const int e = 16 * (j >> 2) + 4 * kq + (j & 3); if (gv[j] > bv) { bv = gv[j]; bi = e; } }
#pragma unroll
                for (int o = 16; o < 64; o <<= 1) { const float ov = shx(bv, o, lane); const int oi = shx(bi, o, lane); if (ov > bv || (ov == bv && oi < bi)) { bv = ov; bi = oi; } }
                pick[k] = bi;
#pragma unroll
                for (int j = 0; j < 8; ++j) { const int e = 16 * (j >> 2) + 4 * kq + (j & 3); if (e == bi) gv[j] = -INFINITY; }
            }
            if (kq == t) { s0 = pick[0]; s1 = pick[1]; s2 = pick[2]; }
        }
        const int nsel = nb < 3 ? nb : 3;
        if (nsel < 2) s1 = -1;
        if (nsel < 3) s2 = -1;
        int myn = 0;
        for (int j = 0; j < nb; ++j) { const bool mt = (s0 == j) || (s1 == j) || (s2 == j); const unsigned long long mask = __ballot(mt); if (lane == j) myn = __popcll(mask); }
        int basev = 0;
        if (lane < nb && myn > 0) basev = atomicAdd(&acnt[(b * NH + h) * 32 + lane], myn);
        for (int j = 0; j < nb; ++j) {
            const bool mt = (s0 == j) || (s1 == j) || (s2 == j); const unsigned long long mask = __ballot(mt); const int base = shfrom(basev, j);
            if (mt) { const int slot = (s0 == j) ? 0 : ((s1 == j) ? 1 : 2); const int pos = base + __popcll(mask & ((1ull << lane) - 1ull));
                alist[(size_t)((b * NH + h) * 32 + j) * 8192 + pos] = (unsigned short)(s_ | (slot << 13)); }
        }
      }
    }
    STAMP(7);
    xcd_barrier(bar, wave0);
    }

    PHASE_BEGIN(4)
      int tid_o = wave0 * 64 + lane_now(), bid_o = blockIdx.x; asm volatile("" : "+s"(bid_o));
      const int tid = tid_o, lane = tid & 63, wave = wave0, bid = bid_o, gw = bid * NWAVES + wave; (void)tid; (void)lane; (void)wave; (void)gw;
      STAMP(8);
    if (gw < BATCH * NG) {
        unsigned char* ws = WSB();
        const int b = gw >> 5, g = gw & 31, p = lane;
        const float lr = INP(I_ARE)[g * 64 + p], li = INP(I_AIM)[g * 64 + p], dt = expf(INP(I_LOGDT)[g]);
        const float mg = expf(lr * dt * 32.f); float sn, cs; sincosf(li * dt * 32.f, &sn, &cs);
        const float ar = mg * cs, ai = mg * sn;
        const float* xe = (const float*)(ws + WS_XE) + ((size_t)g * 1024 + b * 256) * 128 + p;
        bf16* xp = (bf16*)(ws + WS_UG) + ((size_t)g * 1024 + b * 256) * 640 + 512 + p;
        float xr = 0.f, xi = 0.f;
        float er[2][16], ei[2][16];
#pragma unroll
        for (int k = 0; k < 16; ++k) { er[0][k] = xe[(size_t)k * 128]; ei[0][k] = xe[(size_t)k * 128 + 64]; }
#pragma unroll 1
        for (int k0 = 0; k0 < 256; k0 += 32) {
#pragma unroll
            for (int hb = 0; hb < 2; ++hb) {
                const int kb = k0 + 16 * hb;
                if (kb + 16 < 256) {
#pragma unroll
                    for (int k = 0; k < 16; ++k) { er[hb ^ 1][k] = xe[(size_t)(kb + 16 + k) * 128]; ei[hb ^ 1][k] = xe[(size_t)(kb + 16 + k) * 128 + 64]; }
                }
#pragma unroll
                for (int k = 0; k < 16; ++k) {
                    xp[(size_t)(kb + k) * 640] = (bf16)f2bf(xr); xp[(size_t)(kb + k) * 640 + 64] = (bf16)f2bf(xi);
                    const float nr = ar * xr - ai * xi + er[hb][k], ni = ar * xi + ai * xr + ei[hb][k]; xr = nr; xi = ni;
                }
            }
        }
    }
    STAMP(31);
    { unsigned char* ws = WSB();
      const bf16* Qb_ = (const bf16*)(ws + WS_Q); const bf16* Kb_ = (const bf16*)(ws + WS_K); const bf16* Vb_ = (const bf16*)(ws + WS_V);
      const int* acnt = (const int*)(ws + WS_ACNT); const unsigned short* alist = (const unsigned short*)(ws + WS_ALIST);
      bf16* part = (bf16*)(ws + WS_PART); float* lsep = (float*)(ws + WS_LSE);
      LAS int* pre = (LAS int*)(lds + AT_PRE); LAS int* cn = (LAS int*)(lds + AT_CN); LAS int* wt = (LAS int*)(lds + AT_WT);
      __syncthreads();
      { const int c0 = acnt[2 * tid], c1 = acnt[2 * tid + 1]; cn[2 * tid] = c0; cn[2 * tid + 1] = c1;
        const int n0 = (c0 + 127) >> 7, n1 = (c1 + 127) >> 7; int v = n0 + n1;
#pragma unroll
        for (int o = 1; o < 64; o <<= 1) { const int t = shfrom(v, lane >= o ? lane - o : lane); if (lane >= o) v += t; }
        if (lane == 63) wt[wave] = v;
        __syncthreads();
        int off = 0;
        for (int w = 0; w < wave; ++w) off += wt[w];
        pre[2 * tid] = off + v - n1; pre[2 * tid + 1] = off + v; }
      __syncthreads();
      STAMP(33);
      const int CB = (BATCH * NG) / NWAVES, GA = G - CB;
      const int total = (bid >= CB) ? pre[1023] : 0, ab = (bid >= CB) ? bid - CB : 0;
      const int fr = lane & 15, fq = lane >> 4;
#define AT_FIND(item, l_, seg_) do { int lo_ = 0, hi_ = 1023; while (lo_ < hi_) { const int mid_ = (lo_ + hi_) >> 1; if (pre[mid_] > (item)) hi_ = mid_; else lo_ = mid_ + 1; } l_ = lo_; seg_ = (item) - (lo_ ? pre[lo_ - 1] : 0); } while (0)
#define AT_ENTRY(l_, seg_, e_, valid_) do { const int idx_ = (seg_) * 128 + wave * 16 + fr; valid_ = idx_ < cn[l_]; e_ = alist[(size_t)(l_) * 8192 + ((valid_) ? idx_ : (seg_) * 128)]; } while (0)
      int l0 = 0, sg0 = 0, l1 = 0, sg1 = 0; unsigned e0 = 0, e1 = 0; bool va0 = false, va1 = false;
      KVRegs kvr; bf16x8_t qn[2];
      if (ab < total) { AT_FIND(ab, l0, sg0); AT_ENTRY(l0, sg0, e0, va0);
          attn_kv_issue(kvr, Kb_, Vb_, (size_t)(l0 >> 8) * SEQ + (size_t)(l0 & 31) * 256, (l0 >> 5) & 7, tid);
          const size_t tok = (size_t)(l0 >> 8) * SEQ + (e0 & 8191); const int h = (l0 >> 5) & 7;
          qn[0] = *(const bf16x8_t*)(Qb_ + tok * 512 + h * 64 + 8 * fq); qn[1] = *(const bf16x8_t*)(Qb_ + tok * 512 + h * 64 + 32 + 8 * fq); }
      if (ab + GA < total) { AT_FIND(ab + GA, l1, sg1); AT_ENTRY(l1, sg1, e1, va1); }
      for (int item = ab; item < total; item += GA) {
          __syncthreads();
          attn_kv_commit(lds, kvr, tid);
          bf16x8_t qf[2]; qf[0] = qn[0]; qf[1] = qn[1];
          asm volatile("" : "+v"(qf[0]), "+v"(qf[1]));
          const int lc = l0; const unsigned ec = e0; const bool vc = va0;
          __syncthreads();
          int l2 = 0, sg2 = 0; unsigned e2 = 0; bool va2 = false;
          if (item + GA < total) {
              attn_k_issue(kvr, Kb_, (size_t)(l1 >> 8) * SEQ + (size_t)(l1 & 31) * 256, (l1 >> 5) & 7, tid);
              if (item + 2 * GA < total) { AT_FIND(item + 2 * GA, l2, sg2); AT_ENTRY(l2, sg2, e2, va2); }
          }
          f32x4 o[4]; float m, ls;
          { f32x4 acc[16];
            attn_scores<false>(lds, qf, 0, lane, acc, m, ls);
            if (item + GA < total) {
                attn_v_issue(kvr, Vb_, (size_t)(l1 >> 8) * SEQ + (size_t)(l1 & 31) * 256, (l1 >> 5) & 7, tid);
                const size_t tok = (size_t)(l1 >> 8) * SEQ + (e1 & 8191); const int h = (l1 >> 5) & 7;
                qn[0] = *(const bf16x8_t*)(Qb_ + tok * 512 + h * 64 + 8 * fq); qn[1] = *(const bf16x8_t*)(Qb_ + tok * 512 + h * 64 + 32 + 8 * fq); }
            attn_pv(lds, acc, lane, o); }
          if (vc) {
              const int b = lc >> 8, h = (lc >> 5) & 7; const size_t tok = (size_t)b * SEQ + (ec & 8191);
              const float il = 1.f / ls; const size_t pidx = (tok * 8 + h) * 3 + (ec >> 13);
#pragma unroll
              for (int db = 0; db < 4; ++db) { v2u w; w.x = cvtpk(o[db][0] * il, o[db][1] * il); w.y = cvtpk(o[db][2] * il, o[db][3] * il); *(v2u*)(part + pidx * 64 + 16 * db + 4 * fq) = w; }
              if (fq == 0) lsep[pidx] = m * 0.125f + __logf(ls);
          }
          l0 = l1; sg0 = sg1; e0 = e1; va0 = va1; l1 = l2; sg1 = sg2; e1 = e2; va1 = va2;
      }
#undef AT_FIND
#undef AT_ENTRY
    }
    STAMP(9);
    xcd_barrier(bar, wave0);
    }

    PHASE_BEGIN(5)
      int tid_o = wave0 * 64 + lane_now(), bid_o = blockIdx.x; asm volatile("" : "+s"(bid_o));
      const int tid = tid_o, lane = tid & 63, wave = wave0, bid = bid_o, gw = bid * NWAVES + wave; (void)tid; (void)lane; (void)wave; (void)gw;
      STAMP(10);
    { unsigned char* ws = WSB(); const float* dsk = INP(I_SD);
      S5Order S; S.init(ws + WS_UG, ws + WS_S5T, 2, (size_t)512 * 640 * 2, (size_t)256 * 640 * 2, G, bid);
      struct U2 { v4u a, b; };
      auto E = pg8::make_epi<2>(
        [=](const pg8::Unit& u, int c8) { const int co = c8 & 15; return pg8::ld16(dsk + u.e * 16 + co, dsk + u.e * 16 + co); },
        [=](const pg8::Unit& u, int r, int c8) { const int n = 256 * u.pn + c8; const bf16* ug = (const bf16*)(ws + WS_UG) + ((size_t)u.e * 1024 + u.pm * 256 + r) * 640;
            U2 d; d.a = *(const v4u*)(ug + n); d.b = *(const v4u*)(ug + n + 32); return d; },
        [=](const pg8::Unit& u, int r, int c8, const float (&v0)[8], const float (&v1)[8], const pg8::F16& dd, const U2& ud) {
          const int g = u.e, R = u.pm * 256 + r;
#pragma unroll
          for (int h = 0; h < 2; ++h) {
              const int n = 256 * u.pn + 32 * h + c8, t = n >> 4, co = n & 15;
              float uu[8]; unpack8(h ? ud.b : ud.a, uu);
              float f[8];
#pragma unroll
              for (int j = 0; j < 8; ++j) { const float y = (h ? v1[j] : v0[j]) + dd.v[j] * uu[j]; f[j] = y * sigm(1.5957691216f * (y + 0.044715f * y * y * y)); }
              *(v4u*)((bf16*)(ws + WS_Y) + ((size_t)R * 32 + t) * 512 + g * 16 + co) = pack8(f);
          }
      });
      pg8::gemm_phase<decltype(E), S5Order, false>(lds, 640, S, E, wave0, 640);
    }
    STAMP(32);
    { unsigned char* ws = WSB();
      const bf16* Qb_ = (const bf16*)(ws + WS_Q); const bf16* Kb_ = (const bf16*)(ws + WS_K); const bf16* Vb_ = (const bf16*)(ws + WS_V);
      const bf16* part = (const bf16*)(ws + WS_PART); const float* lsep = (const float*)(ws + WS_LSE); bf16* Ob_ = (bf16*)(ws + WS_O);
      const int fr = lane & 15, fq = lane >> 4;
      constexpr int NITEM = BATCH * NH * 32 * 2;
      KVRegs kvr; bf16x8_t qn[2];
      { const int l = bid >> 1, half = bid & 1, b = l >> 8, h = (l >> 5) & 7, nb = l & 31;
        attn_kv_issue(kvr, Kb_, Vb_, (size_t)b * SEQ + (size_t)nb * 256, h, tid);
        const size_t tok = (size_t)b * SEQ + nb * 256 + half * 128 + wave * 16 + fr;
        qn[0] = *(const bf16x8_t*)(Qb_ + tok * 512 + h * 64 + 8 * fq); qn[1] = *(const bf16x8_t*)(Qb_ + tok * 512 + h * 64 + 32 + 8 * fq); }
      for (int item = bid; item < NITEM; item += G) {
          const int l = item >> 1, half = item & 1, b = l >> 8, h = (l >> 5) & 7, nb = l & 31;
          __syncthreads();
          attn_kv_commit(lds, kvr, tid);
          bf16x8_t qf[2]; qf[0] = qn[0]; qf[1] = qn[1];
          __syncthreads();
          const int qloc = half * 128 + wave * 16 + fr; const size_t tok = (size_t)b * SEQ + nb * 256 + qloc;
          const int nsel = nb < 3 ? nb : 3;
          float lt[3]; v2u pw[3][4];
#pragma unroll
          for (int t = 0; t < 3; ++t) lt[t] = (t < nsel) ? lsep[(tok * 8 + h) * 3 + t] : -1e30f;
          if (item + G < NITEM) { const int i2 = item + G, l2 = i2 >> 1, b2 = l2 >> 8, h2 = (l2 >> 5) & 7, nb2 = l2 & 31;
              attn_k_issue(kvr, Kb_, (size_t)b2 * SEQ + (size_t)nb2 * 256, h2, tid); }
          f32x4 o[4]; float m, ls;
          { f32x4 acc[16];
            attn_scores<true>(lds, qf, qloc, lane, acc, m, ls);
#pragma unroll
            for (int t = 0; t < 3; ++t)
#pragma unroll
                for (int db = 0; db < 4; ++db) pw[t][db] = (t < nsel) ? *(const v2u*)(part + ((tok * 8 + h) * 3 + t) * 64 + 16 * db + 4 * fq) : (v2u){0u, 0u};
            if (item + G < NITEM) { const int i2 = item + G, l2 = i2 >> 1, half2 = i2 & 1, b2 = l2 >> 8, h2 = (l2 >> 5) & 7, nb2 = l2 & 31;
                attn_v_issue(kvr, Vb_, (size_t)b2 * SEQ + (size_t)nb2 * 256, h2, tid);
                const size_t tok2 = (size_t)b2 * SEQ + nb2 * 256 + half2 * 128 + wave * 16 + fr;
                qn[0] = *(const bf16x8_t*)(Qb_ + tok2 * 512 + h2 * 64 + 8 * fq); qn[1] = *(const bf16x8_t*)(Qb_ + tok2 * 512 + h2 * 64 + 32 + 8 * fq); }
            attn_pv(lds, acc, lane, o); }
          const float lse_own = m * 0.125f + __logf(ls);
          float M = lse_own;
#pragma unroll
          for (int t = 0; t < 3; ++t) M = fmaxf(M, lt[t]);
          const float w0 = __expf(lse_own - M); float den = w0;
          const float sc0 = w0 / ls;
#pragma unroll
          for (int db = 0; db < 4; ++db) o[db] = o[db] * sc0;
#pragma unroll
          for (int t = 0; t < 3; ++t) {
              const float w = __expf(lt[t] - M); den += w;
#pragma unroll
              for (int db = 0; db < 4; ++db) { o[db][0] += w * lo16(pw[t][db].x); o[db][1] += w * hi16(pw[t][db].x); o[db][2] += w * lo16(pw[t][db].y); o[db][3] += w * hi16(pw[t][db].y); }
          }
          const float id = 1.f / den;
#pragma unroll
          for (int db = 0; db < 4; ++db) { v2u w; w.x = cvtpk(o[db][0] * id, o[db][1] * id); w.y = cvtpk(o[db][2] * id, o[db][3] * id); *(v2u*)(Ob_ + tok * 512 + h * 64 + 16 * db + 4 * fq) = w; }
      }
    }
    STAMP(11);
    xcd_barrier(bar, wave0);
    }

    PHASE_BEGIN(6)
      int tid_o = wave0 * 64 + lane_now(), bid_o = blockIdx.x; asm volatile("" : "+s"(bid_o));
      const int tid = tid_o, lane = tid & 63, wave = wave0, bid = bid_o, gw = bid * NWAVES + wave; (void)tid; (void)lane; (void)wave; (void)gw;
      STAMP(12);
    { unsigned char* ws = WSB();
      pg8::DenseOrder S; S.init(ws + WS_Y, ws + WS_WGLU, NTOK, 2048, 512, G, bid);
      auto E = pg8::make_epi<8>([=](const pg8::Unit&, int) { return pg8::NoData{}; },
        [=](const pg8::Unit& u, int r, int c8) { return *(const v4u*)((const bf16*)(ws + WS_GA) + (size_t)(u.pm * 256 + r) * 1024 + u.pn * 128 + (c8 >> 6) * 32 + (c8 & 31)); },
        [=](const pg8::Unit& u, int r, int c8, const float (&v0)[8], const float (&v1)[8], const pg8::NoData&, const v4u& gaw) {
          const size_t off = (size_t)(u.pm * 256 + r) * 1024 + u.pn * 128 + (c8 >> 6) * 32 + (c8 & 31);
          float ga[8]; unpack8(gaw, ga);
          float f[8];
#pragma unroll
          for (int j = 0; j < 8; ++j) f[j] = sigm(ga[j]) * v0[j] * sigm(v1[j]);
          *(v4u*)((bf16*)(ws + WS_MRG) + off) = pack8(f);
      });
      pg8::gemm_phase<decltype(E), pg8::DenseOrder, false>(lds, 512, S, E, wave0);
    }
    STAMP(13);
    xcd_barrier(bar, wave0);
    }

    {
      int tid_o = wave0 * 64 + lane_now(), bid_o = blockIdx.x; asm volatile("" : "+s"(bid_o));
      const int tid = tid_o, lane = tid & 63, wave = wave0, bid = bid_o, gw = bid * NWAVES + wave; (void)tid; (void)lane; (void)wave; (void)gw;
      STAMP(14);
    { unsigned char* ws = WSB();
      pg8::DenseOrder S; S.init(ws + WS_O, ws + WS_WAO, NTOK, 1024, 512, G, bid);
      struct R4 { v4u g0, g1, m0, m1; };
      auto E = pg8::make_epi<1>([=](const pg8::Unit&, int) { return pg8::NoData{}; },
        [=](const pg8::Unit& u, int r, int c8) { const size_t off = (size_t)(u.pm * 256 + r) * 1024 + u.pn * 256 + c8;
            const bf16* GBb = (const bf16*)(ws + WS_GB); const bf16* MRG = (const bf16*)(ws + WS_MRG);
            R4 d; d.g0 = *(const v4u*)(GBb + off); d.g1 = *(const v4u*)(GBb + off + 32); d.m0 = *(const v4u*)(MRG + off); d.m1 = *(const v4u*)(MRG + off + 32); return d; },
        [=](const pg8::Unit& u, int r, int c8, const float (&v0)[8], const float (&v1)[8], const pg8::NoData&, const R4& d) {
          const size_t off = (size_t)(u.pm * 256 + r) * 1024 + u.pn * 256 + c8;
          bf16* MRG = (bf16*)(ws + WS_MRG);
          float gb[8], ma[8], f[8];
          unpack8(d.g0, gb); unpack8(d.m0, ma);
#pragma unroll
          for (int j = 0; j < 8; ++j) f[j] = ma[j] + sigm(gb[j]) * v0[j];
          *(v4u*)(MRG + off) = pack8(f);
          unpack8(d.g1, gb); unpack8(d.m1, ma);
#pragma unroll
          for (int j = 0; j < 8; ++j) f[j] = ma[j] + sigm(gb[j]) * v1[j];
          *(v4u*)(MRG + off + 32) = pack8(f);
      });
      pg8::gemm_phase<decltype(E), pg8::DenseOrder, false>(lds, 512, S, E, wave0);
    }
    STAMP(15);
    xcd_barrier(bar, wave0);
    }

    PHASE_BEGIN(8)
      int tid_o = wave0 * 64 + lane_now(), bid_o = blockIdx.x; asm volatile("" : "+s"(bid_o));
      const int tid = tid_o, lane = tid & 63, wave = wave0, bid = bid_o, gw = bid * NWAVES + wave; (void)tid; (void)lane; (void)wave; (void)gw;
      STAMP(16);
    { unsigned char* ws = WSB(); const float* x = INP(I_X);
      pg8::DenseOrder S; S.init(ws + WS_MRG, ws + WS_WOUT, NTOK, 1024, 1024, G, bid);
      auto E = pg8::make_epi<1>(
        [=](const pg8::Unit& u, int c8) { const float* gt = (const float*)(ws + WS_MOD) + ((u.pm * 256) >> 13) * 6144 + 2048 + u.pn * 256 + c8; return pg8::ld16(gt, gt + 32); },
        [=](const pg8::Unit& u, int r, int c8) { const float* xp = x + (size_t)(u.pm * 256 + r) * 1024 + u.pn * 256 + c8; return pg8::ld16(xp, xp + 32); },
        [=](const pg8::Unit& u, int r, int c8, const float (&v0)[8], const float (&v1)[8], const pg8::F16& gt, const pg8::F16& xv) {
          const int row = u.pm * 256 + r, col = u.pn * 256 + c8;
          float* op = (float*)(ws + WS_X1) + (size_t)row * 1024 + col;
          float o[16]; float ss = 0.f;
#pragma unroll
          for (int j = 0; j < 8; ++j) { o[j] = xv.v[j] + gt.v[j] * v0[j]; o[8 + j] = xv.v[8 + j] + gt.v[8 + j] * v1[j]; }
#pragma unroll
          for (int j = 0; j < 16; ++j) ss += o[j] * o[j];
          *(f32x4*)op = (f32x4){o[0], o[1], o[2], o[3]}; *(f32x4*)(op + 4) = (f32x4){o[4], o[5], o[6], o[7]};
          *(f32x4*)(op + 32) = (f32x4){o[8], o[9], o[10], o[11]}; *(f32x4*)(op + 36) = (f32x4){o[12], o[13], o[14], o[15]};
          { const int ln = (r & 15) + 2 * (c8 & 24); ss += shx(ss, 16, ln); ss += shx(ss, 32, ln); }
          if ((c8 & 63) == 0) ((float*)(ws + WS_PSQ))[(size_t)row * 16 + u.pn * 4 + (c8 >> 6)] = ss;
      });
      pg8::gemm_phase<decltype(E), pg8::DenseOrder, false>(lds, 1024, S, E, wave0);
    }
    STAMP(17);
    xcd_barrier(bar, wave0);
    }

    PHASE_BEGIN(9)
      int tid_o = wave0 * 64 + lane_now(), bid_o = blockIdx.x; asm volatile("" : "+s"(bid_o));
      const int tid = tid_o, lane = tid & 63, wave = wave0, bid = bid_o, gw = bid * NWAVES + wave; (void)tid; (void)lane; (void)wave; (void)gw;
      STAMP(18);
    {
        unsigned char* ws = WSB(); const float* X1 = (const float*)(ws + WS_X1); const float* MOD = (const float*)(ws + WS_MOD); bf16* Hb = (bf16*)(ws + WS_H);
        const float* gffn = INP(I_GFFN); const float* wrt = INP(I_WR); const float* brt = INP(I_BR);
        const bf16* wrs = (const bf16*)(ws + WS_WRS); const float* psq = (const float*)(ws + WS_PSQ);
        int* TOPI = (int*)(ws + WS_TOPI); float* TOPW = (float*)(ws + WS_TOPW); int* BLKCNT = (int*)(ws + WS_BLKCNT);
        constexpr int WLS = 2064, WLO = 32 * WLS;
        LAS float* gsL = (LAS float*)(lds + 2 * WLO); LAS float* shL = gsL + 1024; LAS float* cvec = shL + 1024; LAS int* cnt = (LAS int*)(cvec + 32); LAS float* red = (LAS float*)(cnt + 32);
        const int tpb = NTOK / G, b = (bid * tpb) >> 13;
        for (int i = tid; i < 8192; i += NTHR) { const int hl = i >> 12, row = (i >> 7) & 31, cc = i & 127;
            *(LAS v4u*)(lds + hl * WLO + row * WLS + cc * 16) = *(const v4u*)(wrs + hl * 32768 + row * 1024 + cc * 8); }
        for (int i = tid; i < 1024; i += NTHR) { gsL[i] = gffn[i] * (1.f + MOD[b * 6144 + 4096 + i]); shL[i] = MOD[b * 6144 + 3072 + i]; }
        if (tid < 32) cnt[tid] = 0;
        __syncthreads();
        { const int part = tid >> 5, e = tid & 31; float a = 0.f;
          for (int k = 0; k < 64; ++k) a += shL[64 * part + k] * wrt[(64 * part + k) * 32 + e];
          red[part * 32 + e] = a;
          __syncthreads();
          if (tid < 32) { float t = brt[tid];
#pragma unroll
              for (int p = 0; p < 16; ++p) t += red[p * 32 + tid];
              cvec[tid] = t; }
          __syncthreads(); }
        const int fr = lane & 15, kq = lane >> 4;
        const int m = bid * tpb + wave * 16 + fr;
        float r;
        { const f32x4* pq = (const f32x4*)(psq + (size_t)m * 16); const f32x4 p0 = pq[0], p1 = pq[1], p2 = pq[2], p3 = pq[3];
          const float ss = ((p0.x + p0.y) + (p0.z + p0.w)) + ((p1.x + p1.y) + (p1.z + p1.w)) + ((p2.x + p2.y) + (p2.z + p2.w)) + ((p3.x + p3.y) + (p3.z + p3.w));
          r = rsqrtf(ss * (1.f / DM) + RMS_EPS); }
        f32x4 acc[2]; acc[0] = (f32x4){0.f, 0.f, 0.f, 0.f}; acc[1] = acc[0];
        const float* xr = X1 + (size_t)m * DM + 8 * kq; bf16* hr = Hb + (size_t)m * DM + 8 * kq;
#pragma unroll 4
        for (int ks = 0; ks < 32; ++ks) {
            const f32x4 xa = *(const f32x4*)(xr + 32 * ks), xb = *(const f32x4*)(xr + 32 * ks + 4);
            const int k0 = 32 * ks + 8 * kq;
            const f32x4 ga = *(const LAS f32x4*)(gsL + k0), gb = *(const LAS f32x4*)(gsL + k0 + 4), sa = *(const LAS f32x4*)(shL + k0), sb = *(const LAS f32x4*)(shL + k0 + 4);
            const float y[8] = {xa.x * ga.x, xa.y * ga.y, xa.z * ga.z, xa.w * ga.w, xb.x * gb.x, xb.y * gb.y, xb.z * gb.z, xb.w * gb.w};
            const float sh[8] = {sa.x, sa.y, sa.z, sa.w, sb.x, sb.y, sb.z, sb.w};
            float hv[8], yl[8]; v4u yhw;
#pragma unroll
            for (int j = 0; j < 8; ++j) hv[j] = y[j] * r + sh[j];
            *(v4u*)(hr + 32 * ks) = pack8(hv);
            yhw = pack8(y);
            { float yh[8]; unpack8(yhw, yh);
#pragma unroll
              for (int j = 0; j < 8; ++j) yl[j] = y[j] - yh[j]; }
            const bf16x8_t fyh = __builtin_bit_cast(bf16x8_t, yhw), fyl = __builtin_bit_cast(bf16x8_t, pack8(yl));
#pragma unroll
            for (int nt = 0; nt < 2; ++nt) {
                const bf16x8_t wh = *(const LAS bf16x8_t*)(lds + (16 * nt + fr) * WLS + k0 * 2), wl = *(const LAS bf16x8_t*)(lds + WLO + (16 * nt + fr) * WLS + k0 * 2);
                acc[nt] = __builtin_amdgcn_mfma_f32_16x16x32_bf16(wh, fyh, acc[nt], 0, 0, 0);
                acc[nt] = __builtin_amdgcn_mfma_f32_16x16x32_bf16(wh, fyl, acc[nt], 0, 0, 0);
                acc[nt] = __builtin_amdgcn_mfma_f32_16x16x32_bf16(wl, fyh, acc[nt], 0, 0, 0);
            }
        }
        float lv[8];
#pragma unroll
        for (int nt = 0; nt < 2; ++nt)
#pragma unroll
            for (int j = 0; j < 4; ++j) lv[4 * nt + j] = r * acc[nt][j] + cvec[16 * nt + 4 * kq + j];
        float tv[4]; int ti[4];
#pragma unroll
        for (int k = 0; k < 4; ++k) {
            float bv = lv[0]; int bi = 4 * kq;
#pragma unroll
            for (int j = 1; j < 8; ++j) { const int e = 16 * (j >> 2) + 4 * kq + (j & 3); if (lv[j] > bv) { bv = lv[j]; bi = e; } }
#pragma unroll
            for (int o = 16; o < 64; o <<= 1) { const float ov = shx(bv, o, lane); const int oi = shx(bi, o, lane); if (ov > bv || (ov == bv && oi < bi)) { bv = ov; bi = oi; } }
            tv[k] = bv; ti[k] = bi;
#pragma unroll
            for (int j = 0; j < 8; ++j) { const int e = 16 * (j >> 2) + 4 * kq + (j & 3); if (e == bi) lv[j] = -INFINITY; }
        }
        const float e1 = __expf(tv[1] - tv[0]), e2 = __expf(tv[2] - tv[0]), e3 = __expf(tv[3] - tv[0]);
        const float inv = 1.f / (1.f + e1 + e2 + e3);
        if (kq == 0) {
            *(int4*)(TOPI + (size_t)m * 4) = make_int4(ti[0], ti[1], ti[2], ti[3]);
            *(f32x4*)(TOPW + (size_t)m * 4) = (f32x4){inv, e1 * inv, e2 * inv, e3 * inv};
            atomicAdd((int*)&cnt[ti[0]], 1); atomicAdd((int*)&cnt[ti[1]], 1); atomicAdd((int*)&cnt[ti[2]], 1); atomicAdd((int*)&cnt[ti[3]], 1);
        }
        __syncthreads();
        if (tid < 32) BLKCNT[bid * 32 + tid] = cnt[tid];
    }
    STAMP(19);
    xcd_barrier(bar, wave0);
    }

    PHASE_BEGIN(10)
      int tid_o = wave0 * 64 + lane_now(), bid_o = blockIdx.x; asm volatile("" : "+s"(bid_o));
      const int tid = tid_o, lane = tid & 63, wave = wave0, bid = bid_o, gw = bid * NWAVES + wave; (void)tid; (void)lane; (void)wave; (void)gw;
      STAMP(20);
    {
        unsigned char* ws = WSB(); const int* TOPI = (const int*)(ws + WS_TOPI); const float* TOPW = (const float*)(ws + WS_TOPW); const int* BLKCNT = (const int*)(ws + WS_BLKCNT);
        int* ROWTOK = (int*)(ws + WS_ROWTOK); float* ROWW = (float*)(ws + WS_ROWW); int* TILEE = (int*)(ws + WS_TILEE);
        LAS int* tot = (LAS int*)lds;
        LAS int* mine = tot + 32;
        LAS int* pst = mine + 32;
        LAS int* wcn = pst + 64;
        LAS int* rt = wcn + 256;
        LAS int* rm = rt + 512;
        const int tpb = NTOK / G;
        { const int part = tid >> 5, e = tid & 31; int t = 0, mn = 0;
          for (int k = part * (G / 16); k < (part + 1) * (G / 16); ++k) { const int c = BLKCNT[k * 32 + e]; t += c; if (k < bid) mn += c; }
          rt[part * 32 + e] = t; rm[part * 32 + e] = mn; }
        const int ent = TOPI[bid * tpb * 4 + tid];
        __syncthreads();
        if (tid < 32) { int t = 0, mn = 0;
#pragma unroll
            for (int p = 0; p < 16; ++p) { t += rt[p * 32 + tid]; mn += rm[p * 32 + tid]; }
            tot[tid] = t; mine[tid] = mn; }
        int rk = 0;
        for (int ex = 0; ex < 32; ++ex) { const unsigned long long mask = __ballot(ent == ex); if (ent == ex) rk = __popcll(mask & ((1ull << lane) - 1ull)); if (lane == ex) wcn[wave * 32 + ex] = __popcll(mask); }
        __syncthreads();
        if (tid == 0) { int a = 0; for (int e = 0; e < 32; ++e) { pst[e] = a; a += (tot[e] + 255) & ~255; } pst[32] = a; }
        __syncthreads();
        { int woff = 0;
          for (int w = 0; w < wave; ++w) woff += wcn[w * 32 + ent];
          const int pos = pst[ent] + mine[ent] + woff + rk;
          ROWTOK[pos] = (bid * tpb + (tid >> 2)) * 4 + (tid & 3);
          ROWW[pos] = TOPW[bid * tpb * 4 + tid]; }
        if (bid < 32) { const int e = bid; for (int pos = pst[e] + tot[e] + tid; pos < pst[e + 1]; pos += NTHR) { ROWTOK[pos] = -1; ROWW[pos] = 0.f; } }
        if (bid == 32 % G) {
            const int nt = pst[32] >> 8;
            for (int t = tid; t < nt; t += NTHR) { int e = 0; for (int k = 0; k < 32; ++k) if ((t << 8) >= pst[k]) e = k; TILEE[t] = e; }
            if (tid == 0) TILEE[1023] = nt;
        }
    }
    STAMP(21);
    xcd_barrier(bar, wave0);
    }

    PHASE_BEGIN(11)
      int tid_o = wave0 * 64 + lane_now(), bid_o = blockIdx.x; asm volatile("" : "+s"(bid_o));
      const int tid = tid_o, lane = tid & 63, wave = wave0, bid = bid_o, gw = bid * NWAVES + wave; (void)tid; (void)lane; (void)wave; (void)gw;
      STAMP(22);
    { unsigned char* ws = WSB(); const float* bgu = INP(I_BGU);
      LAS int* tl = (LAS int*)(lds + LDS_TILE); for (int i = tid; i < 1024; i += NTHR) tl[i] = ((const int*)(ws + WS_TILEE))[i]; __syncthreads();
      MoeOrder S; S.init(ws + WS_H, ws + WS_WGU, tl, (const int*)(ws + WS_ROWTOK), 8, (size_t)2048 * 1024 * 2, 1024, G, bid, true);
      auto E = pg8::make_epi(
        [=](const pg8::Unit& u, int c8) { const float* bg = bgu + (size_t)u.e * 2048 + u.pn * 128 + (c8 >> 6) * 32 + (c8 & 31); return pg8::ld16(bg, bg + 1024); },
        [=](const pg8::Unit&, int, int) { return pg8::NoData{}; },
        [=](const pg8::Unit& u, int r, int c8, const float (&v0)[8], const float (&v1)[8], const pg8::F16& bb, const pg8::NoData&) {
          const int col = u.pn * 128 + (c8 >> 6) * 32 + (c8 & 31); float f[8];
#pragma unroll
          for (int j = 0; j < 8; ++j) {
              const float gt = fminf(v0[j] + bb.v[j], 7.f);
              const float up = fminf(fmaxf(v1[j] + bb.v[8 + j], -7.f), 7.f);
              f[j] = (up + 1.f) * gt * sigm(1.702f * gt);
          }
          *(v4u*)((bf16*)(ws + WS_ACT) + (size_t)(u.pm * 256 + r) * 1024 + col) = pack8(f);
      });
      pg8::gemm_phase<decltype(E), MoeOrder, true>(lds, 1024, S, E, wave0);
    }
    STAMP(23);
    xcd_barrier(bar, wave0);
    }

    PHASE_BEGIN(12)
      int tid_o = wave0 * 64 + lane_now(), bid_o = blockIdx.x; asm volatile("" : "+s"(bid_o));
      const int tid = tid_o, lane = tid & 63, wave = wave0, bid = bid_o, gw = bid * NWAVES + wave; (void)tid; (void)lane; (void)wave; (void)gw;
      STAMP(24);
    { unsigned char* ws = WSB(); const float* bdn = INP(I_BD);
      LAS int* tl = (LAS int*)(lds + LDS_TILE); for (int i = tid; i < 1024; i += NTHR) tl[i] = ((const int*)(ws + WS_TILEE))[i]; __syncthreads();
      MoeOrder S; S.init(ws + WS_ACT, ws + WS_WD, tl, (const int*)(ws + WS_ROWTOK), 4, (size_t)1024 * 1024 * 2, 1024, G, bid, false);
      struct RW { int rt; float w; };
      auto E = pg8::make_epi<8>(
        [=](const pg8::Unit& u, int c8) { const float* bd = bdn + (size_t)u.e * 1024 + u.pn * 256 + c8; return pg8::ld16(bd, bd + 32); },
        [=](const pg8::Unit& u, int r, int c8) { RW d; d.rt = ((const int*)(ws + WS_ROWTOK))[u.pm * 256 + r]; d.w = ((const float*)(ws + WS_ROWW))[u.pm * 256 + r]; return d; },
        [=](const pg8::Unit& u, int r, int c8, const float (&v0)[8], const float (&v1)[8], const pg8::F16& bd, const RW& d) {
          if (d.rt >= 0) {
              const int col = u.pn * 256 + c8; float f[8];
              bf16* yp = (bf16*)(ws + WS_YS) + (size_t)d.rt * 1024 + col;
#pragma unroll
              for (int j = 0; j < 8; ++j) f[j] = (v0[j] + bd.v[j]) * d.w;
              *(v4u*)yp = pack8(f);
#pragma unroll
              for (int j = 0; j < 8; ++j) f[j] = (v1[j] + bd.v[8 + j]) * d.w;
              *(v4u*)(yp + 32) = pack8(f);
          }
      });
      pg8::gemm_phase<decltype(E), MoeOrder, false>(lds, 1024, S, E, wave0);
    }
    STAMP(25);
    xcd_barrier(bar, wave0);
    }

    PHASE_BEGIN(13)
      int tid_o = wave0 * 64 + lane_now(), bid_o = blockIdx.x; asm volatile("" : "+s"(bid_o));
      const int tid = tid_o, lane = tid & 63, wave = wave0, bid = bid_o, gw = bid * NWAVES + wave; (void)tid; (void)lane; (void)wave; (void)gw;
      STAMP(26);
    { unsigned char* ws = WSB(); const float* X1 = (const float*)(ws + WS_X1); const float* MOD = (const float*)(ws + WS_MOD); const bf16* YS = (const bf16*)(ws + WS_YS); const float* gfin = INP(I_GFIN); float* outp = (float*)ldptr(lds, 25);
      int lane_ = lane, row0_ = bid * (NTOK / G) + wave * (NTOK / G / NWAVES); asm volatile("" : "+v"(lane_)); asm volatile("" : "+s"(row0_));
      const int tpb = NTOK / G, b = (bid * tpb) >> 13, rpw = tpb / NWAVES;
      f32x4 gt[4], gf[4];
#pragma unroll
      for (int j = 0; j < 4; ++j) { gt[j] = *(const f32x4*)(MOD + b * 6144 + 5120 + 4 * lane_ + 256 * j); gf[j] = *(const f32x4*)(gfin + 4 * lane_ + 256 * j); }
      for (int r0 = 0; r0 < rpw; r0 += 2) {
          f32x4 v[2][4]; v2u y[2][4][4]; float ss[2];
#pragma unroll
          for (int rr = 0; rr < 2; ++rr) { const size_t m = (size_t)(row0_ + r0 + rr);
#pragma unroll
              for (int j = 0; j < 4; ++j) { v[rr][j] = ((const f32x4*)(X1 + m * DM) + lane_)[64 * j];
#pragma unroll
                  for (int sl = 0; sl < 4; ++sl) y[rr][j][sl] = *(const v2u*)(YS + (m * 4 + sl) * 1024 + 4 * lane_ + 256 * j); } }
#pragma unroll
          for (int rr = 0; rr < 2; ++rr) { float t = 0.f;
#pragma unroll
              for (int j = 0; j < 4; ++j) { f32x4 a = (f32x4){0.f, 0.f, 0.f, 0.f};
#pragma unroll
                  for (int sl = 0; sl < 4; ++sl) { const v2u w = y[rr][j][sl]; a.x += lo16(w.x); a.y += hi16(w.x); a.z += lo16(w.y); a.w += hi16(w.y); }
                  v[rr][j] = v[rr][j] + gt[j] * a;
                  t += (v[rr][j].x * v[rr][j].x + v[rr][j].y * v[rr][j].y) + (v[rr][j].z * v[rr][j].z + v[rr][j].w * v[rr][j].w); }
              ss[rr] = t; }
#pragma unroll
          for (int o = 1; o < 64; o <<= 1) { ss[0] += shx(ss[0], o, lane_); ss[1] += shx(ss[1], o, lane_); }
#pragma unroll
          for (int rr = 0; rr < 2; ++rr) { const float r = rsqrtf(ss[rr] * (1.f / DM) + RMS_EPS);
              f32x4* op = (f32x4*)(outp + (size_t)(row0_ + r0 + rr) * DM) + lane_;
#pragma unroll
              for (int j = 0; j < 4; ++j) op[64 * j] = v[rr][j] * r * gf[j]; }
      }
    }
    STAMP(27);
    }
#if TIMING
    xcd_barrier(bar, wave0);
    if (blockIdx.x == 0 && wave0 == 0 && lane_now() == 0) {
        const unsigned long long* ts_ = (const unsigned long long*)((unsigned char*)bar.bar - 4096 + 49152);
        const int ca = NREP(14), cb = NREP(15);
        unsigned long long a = __hip_atomic_load(ts_ + (ca & 127), __ATOMIC_RELAXED, __HIP_MEMORY_SCOPE_AGENT), b = __hip_atomic_load(ts_ + (cb & 127), __ATOMIC_RELAXED, __HIP_MEMORY_SCOPE_AGENT);
        if (ca & 64) a = ~a; if (cb & 64) b = ~b;
        const unsigned long long d = (a > b) ? (a - b) * 8ull : 0ull, t0 = __builtin_amdgcn_s_memrealtime();
        while (__builtin_amdgcn_s_memrealtime() - t0 < d) __builtin_amdgcn_s_sleep(16);
    }
#endif
}

extern "C" void kernel_launch(void* const* d_in, const int* in_sizes, int n_in, void* d_out, int out_size, void* d_ws, size_t ws_size, hipStream_t stream) {
    static int grid = 0;
    if (grid == 0) {
        if (n_in != 25 || in_sizes[0] != NTOK * DM || out_size != NTOK * DM || ws_size < WS_END) {
            fprintf(stderr, "kernel_launch: unexpected shapes (n_in %d, in0 %d, out %d, ws %zu); nothing launched\n", n_in, n_in > 0 ? in_sizes[0] : -1, out_size, ws_size); grid = -1; return; }
        int dev = 0, cus = 0, per_cu = 0;
        if (hipGetDevice(&dev) != hipSuccess || hipDeviceGetAttribute(&cus, hipDeviceAttributeMultiprocessorCount, dev) != hipSuccess) { grid = -1; return; }
        if (hipFuncSetAttribute((const void*)mega_fwd, hipFuncAttributeMaxDynamicSharedMemorySize, LDS_BYTES) != hipSuccess) { fprintf(stderr, "kernel_launch: hipFuncSetAttribute failed\n"); grid = -1; return; }
        if (hipOccupancyMaxActiveBlocksPerMultiprocessor(&per_cu, (const void*)mega_fwd, NTHR, LDS_BYTES) != hipSuccess || per_cu < 1) {
            fprintf(stderr, "kernel_launch: occupancy query reports %d blocks per CU\n", per_cu); (void)hipGetLastError(); grid = -1; return; }
        grid = cus;
        if (NTOK % grid != 0) { fprintf(stderr, "kernel_launch: grid %d does not divide the token count\n", grid); grid = -1; return; }
    }
    if (grid < 0) return;
    (void)hipMemsetAsync((char*)d_ws + WS_CTL, 0, CTL_ZERO_BYTES, stream);
    Params p{};
    for (int i = 0; i < 25; ++i) p.in[i] = (const float*)d_in[i];
    p.out = (float*)d_out; p.ws = (unsigned char*)d_ws;
    for (int i = 0; i < 16; ++i) p.rep[i] = 1;
    p.rep[14] = TS_A; p.rep[15] = TS_B;
    hipLaunchKernelGGL(mega_fwd, dim3(grid), dim3(NTHR), LDS_BYTES, stream, p);
}
```
